# Optimizing an MI355X kernel written in HIP

```python
import math
import jax, jax.numpy as jnp
from jax import lax
import numpy as np

D_MODEL = 1024
BATCH = 2
SEQ = 8192
DEPTH = 4

D_MIX = 2 * D_MODEL
D_BRANCH = D_MIX // 4
CONV_W = 4
EPS = 1e-6

LRU_HEADS = 8
LRU_HDIM = D_BRANCH // LRU_HEADS
LRU_C = 8.0
S5_GROUP = 16
S5_GROUPS = D_BRANCH // S5_GROUP
S5_STATE = 64
GLA_HEADS = 4
GLA_DK = D_BRANCH // 2
GLA_HK = GLA_DK // GLA_HEADS
GLA_HV = D_BRANCH // GLA_HEADS
GLA_RANK = 16
GLA_TAU = 16.0
GLA_CHUNK = 64
SSD_HDIM = 64
SSD_HEADS = D_BRANCH // SSD_HDIM
SSD_GROUPS = 2
SSD_HPG = SSD_HEADS // SSD_GROUPS
SSD_STATE = 128
SSD_CHUNK = 64
SSD_CONV_DIM = D_BRANCH + 2 * SSD_GROUPS * SSD_STATE

IN_SIZES = (
    D_BRANCH, D_BRANCH,
    D_BRANCH, D_BRANCH,
    GLA_DK, GLA_DK, D_BRANCH, D_BRANCH, GLA_RANK,
    D_BRANCH, SSD_CONV_DIM, SSD_HEADS,
)
D_IN = sum(IN_SIZES)

kernel_name = "hybrid_parallel_rglru_s5_gla_ssd"

F32 = jnp.float32


def rmsnorm(x, w):
    xf = x.astype(F32)
    y = xf * lax.rsqrt(jnp.mean(xf * xf, axis=-1, keepdims=True) + EPS)
    return (y * w.astype(F32)).astype(x.dtype)


def causal_dwconv(x, w, b):
    c = x.shape[-1]
    y = lax.conv_general_dilated(x, w[:, None, :].astype(x.dtype), window_strides=(1,),
                                 padding=[(CONV_W - 1, 0)],
                                 dimension_numbers=("NWC", "WIO", "NWC"),
                                 feature_group_count=c)
    return y + b.astype(x.dtype)


def _linear_combine(e1, e2):
    a1, b1 = e1
    a2, b2 = e2
    return a1 * a2, a2 * b1 + b2


def _complex_linear_combine(e1, e2):
    a1r, a1i, b1r, b1i = e1
    a2r, a2i, b2r, b2i = e2
    return (a2r * a1r - a2i * a1i, a2r * a1i + a2i * a1r,
            a2r * b1r - a2i * b1i + b2r, a2r * b1i + a2i * b1r + b2i)


def rglru_mixer(xa, za, conv_w, conv_b, w_r, b_r, w_i, b_i, lru_l):
    bsz, s, _ = xa.shape
    u = causal_dwconv(xa, conv_w, conv_b).astype(F32)
    uh = u.reshape(bsz, s, LRU_HEADS, LRU_HDIM)
    r = jax.nn.sigmoid(jnp.einsum("bshi,hij->bshj", uh, w_r.astype(F32)).reshape(bsz, s, D_BRANCH) + b_r.astype(F32))
    i = jax.nn.sigmoid(jnp.einsum("bshi,hij->bshj", uh, w_i.astype(F32)).reshape(bsz, s, D_BRANCH) + b_i.astype(F32))
    log_a = -LRU_C * r * jax.nn.softplus(-lru_l.astype(F32))
    a = jnp.exp(log_a)
    mult = jnp.sqrt(-jnp.expm1(2.0 * log_a))
    _, h = lax.associative_scan(_linear_combine, (a, mult * i * u), axis=1)
    return h * jax.nn.silu(za.astype(F32))


def s5_mixer(ub, zb, lam_re, lam_im, log_dt, b_re, b_im, c_re, c_im, d_skip, glu_w, glu_b):
    bsz, s, _ = ub.shape
    u = ub.astype(F32)
    ug = u.reshape(bsz, s, S5_GROUPS, S5_GROUP)
    lr = lam_re.astype(F32)
    li = lam_im.astype(F32)
    dt = jnp.exp(log_dt.astype(F32))[:, None]
    mag = jnp.exp(lr * dt)
    ab_re = mag * jnp.cos(li * dt)
    ab_im = mag * jnp.sin(li * dt)
    den = lr * lr + li * li
    nr = ab_re - 1.0
    coef_re = (nr * lr + ab_im * li) / den
    coef_im = (ab_im * lr - nr * li) / den
    br = b_re.astype(F32)
    bi = b_im.astype(F32)
    bb_re = coef_re[..., None] * br - coef_im[..., None] * bi
    bb_im = coef_re[..., None] * bi + coef_im[..., None] * br
    bu_re = jnp.einsum("bsgp,gnp->bsgn", ug, bb_re)
    bu_im = jnp.einsum("bsgp,gnp->bsgn", ug, bb_im)
    a_re = jnp.broadcast_to(ab_re, bu_re.shape)
    a_im = jnp.broadcast_to(ab_im, bu_re.shape)
    _, _, st_re, st_im = lax.associative_scan(_complex_linear_combine, (a_re, a_im, bu_re, bu_im), axis=1)
    y = (jnp.einsum("bsgn,gpn->bsgp", st_re, c_re.astype(F32))
         - jnp.einsum("bsgn,gpn->bsgp", st_im, c_im.astype(F32)))
    y = y.reshape(bsz, s, D_BRANCH) + d_skip.astype(F32) * u
    y = jax.nn.gelu(y)
    y = y * jax.nn.sigmoid(y @ glu_w.astype(F32) + glu_b.astype(F32))
    return y * jax.nn.silu(zb.astype(F32))


def gla_mixer(q, k, v, zc, g_low, w_gate, b_gate, norm_w):
    bsz, s, _ = q.shape
    nc = s // GLA_CHUNK
    shp = (bsz, nc, GLA_CHUNK, GLA_HEADS, -1)
    q = q.astype(F32).reshape(shp) * (GLA_HK ** -0.5)
    k = k.astype(F32).reshape(shp)
    v = v.astype(F32).reshape(shp)
    logits = g_low.astype(F32) @ w_gate.astype(F32) + b_gate.astype(F32)
    g = (jax.nn.log_sigmoid(logits) / GLA_TAU).reshape(shp)
    gc = jnp.cumsum(g, axis=2)
    g_last = gc[:, :, -1:]
    q_dec = q * jnp.exp(gc)
    k_inv = k * jnp.exp(-gc)
    k_end = k * jnp.exp(g_last - gc)
    mask = jnp.tril(jnp.ones((GLA_CHUNK, GLA_CHUNK), dtype=bool))
    scores = jnp.where(mask, jnp.einsum("bnihd,bnjhd->bnhij", q_dec, k_inv), 0.0)
    o_intra = jnp.einsum("bnhij,bnjhe->bnihe", scores, v)
    chunk_kv = jnp.einsum("bnjhd,bnjhe->bnhde", k_end, v)
    decay = jnp.exp(g_last[:, :, 0])

    def step(state, inp):
        dec, kv = inp
        return dec[..., None] * state + kv, state

    init = jnp.zeros((bsz, GLA_HEADS, GLA_HK, GLA_HV), F32)
    _, prev = lax.scan(step, init, (jnp.moveaxis(decay, 1, 0), jnp.moveaxis(chunk_kv, 1, 0)))
    prev = jnp.moveaxis(prev, 0, 1)
    o = o_intra + jnp.einsum("bnihd,bnhde->bnihe", q_dec, prev)
    o = o * lax.rsqrt(jnp.mean(o * o, axis=-1, keepdims=True) + EPS) * norm_w.astype(F32)
    o = o.reshape(bsz, s, D_BRANCH)
    return o * jax.nn.silu(zc.astype(F32))


def ssd_mixer(zd, xbc, dt_raw, conv_w, conv_b, dt_bias, a_log, d_skip, norm_w):
    bsz, s, _ = zd.shape
    nc = s // SSD_CHUNK
    xbc = jax.nn.silu(causal_dwconv(xbc, conv_w, conv_b).astype(F32))
    xs, bm, cm = jnp.split(xbc, [D_BRANCH, D_BRANCH + SSD_GROUPS * SSD_STATE], axis=-1)
    x = xs.reshape(bsz, nc, SSD_CHUNK, SSD_GROUPS, SSD_HPG, SSD_HDIM)
    bm = bm.reshape(bsz, nc, SSD_CHUNK, SSD_GROUPS, SSD_STATE)
    cm = cm.reshape(bsz, nc, SSD_CHUNK, SSD_GROUPS, SSD_STATE)
    dt = jax.nn.softplus(dt_raw.astype(F32) + dt_bias.astype(F32))
    a = -jnp.exp(a_log.astype(F32))
    dt_t = jnp.moveaxis((dt).reshape(bsz, nc, SSD_CHUNK, SSD_GROUPS, SSD_HPG), 2, -1)
    a_cum = jnp.cumsum(jnp.moveaxis((dt * a).reshape(bsz, nc, SSD_CHUNK, SSD_GROUPS, SSD_HPG), 2, -1), axis=-1)
    mask = jnp.tril(jnp.ones((SSD_CHUNK, SSD_CHUNK), dtype=bool))
    diff = a_cum[..., :, None] - a_cum[..., None, :]
    seg = jnp.where(mask, jnp.exp(jnp.where(mask, diff, 0.0)), 0.0)
    cb = jnp.einsum("bnigs,bnjgs->bngij", cm, bm)
    m = cb[:, :, :, None] * seg * dt_t[..., None, :]
    y_diag = jnp.einsum("bnghij,bnjghp->bnighp", m, x)
    decay_end = jnp.exp(a_cum[..., -1:] - a_cum) * dt_t
    states = jnp.einsum("bnjgs,bnghj,bnjghp->bnghps", bm, decay_end, x)
    chunk_decay = jnp.exp(a_cum[..., -1])

    def step(state, inp):
        dec, st = inp
        return dec[..., None, None] * state + st, state

    init = jnp.zeros((bsz, SSD_GROUPS, SSD_HPG, SSD_HDIM, SSD_STATE), F32)
    _, prev = lax.scan(step, init, (jnp.moveaxis(chunk_decay, 1, 0), jnp.moveaxis(states, 1, 0)))
    prev = jnp.moveaxis(prev, 0, 1)
    y_off = jnp.einsum("bnigs,bnghps,bnghi->bnighp", cm, prev, jnp.exp(a_cum))
    y = y_diag + y_off + d_skip.astype(F32).reshape(SSD_GROUPS, SSD_HPG)[:, :, None] * x
    y = y.reshape(bsz, s, D_BRANCH) * jax.nn.silu(zd.astype(F32))
    y = y * lax.rsqrt(jnp.mean(y * y, axis=-1, keepdims=True) + EPS) * norm_w.astype(F32)
    return y


def setup_inputs(seed: int = 0) -> dict:
    key = jax.random.key(seed)
    ks = jax.random.split(key, 40)
    nrm = lambda k, shape, scale: jax.random.normal(k, shape, F32) * scale
    uni = lambda k, shape, lo, hi: jax.random.uniform(k, shape, F32, lo, hi)
    L = DEPTH
    x = jax.random.normal(ks[0], (BATCH, SEQ, D_MODEL), F32)
    norm_w = 1.0 + nrm(ks[1], (L, D_MODEL), 0.02)
    w_in = nrm(ks[2], (L, D_MODEL, D_IN), D_MODEL ** -0.5)
    lru_conv_w = nrm(ks[3], (L, CONV_W, D_BRANCH), CONV_W ** -0.5)
    lru_conv_b = nrm(ks[4], (L, D_BRANCH), 0.02)
    lru_w_r = nrm(ks[5], (L, LRU_HEADS, LRU_HDIM, LRU_HDIM), LRU_HDIM ** -0.5)
    lru_b_r = nrm(ks[6], (L, D_BRANCH), 0.02)
    lru_w_i = nrm(ks[7], (L, LRU_HEADS, LRU_HDIM, LRU_HDIM), LRU_HDIM ** -0.5)
    lru_b_i = nrm(ks[8], (L, D_BRANCH), 0.02)
    p = uni(ks[9], (L, D_BRANCH), 0.9, 0.999) ** (1.0 / LRU_C)
    lru_l = jnp.log(p) - jnp.log1p(-p)
    n_idx = jnp.arange(S5_STATE, dtype=F32)
    s5_lam_re = -0.5 + nrm(ks[10], (L, S5_GROUPS, S5_STATE), 0.01)
    s5_lam_im = math.pi * n_idx + nrm(ks[11], (L, S5_GROUPS, S5_STATE), 0.01)
    s5_log_dt = uni(ks[12], (L, S5_GROUPS), math.log(1e-3), math.log(1e-1))
    s5_b_re = nrm(ks[13], (L, S5_GROUPS, S5_STATE, S5_GROUP), (2.0 * S5_GROUP) ** -0.5)
    s5_b_im = nrm(ks[14], (L, S5_GROUPS, S5_STATE, S5_GROUP), (2.0 * S5_GROUP) ** -0.5)
    s5_c_re = nrm(ks[15], (L, S5_GROUPS, S5_GROUP, S5_STATE), (2.0 * S5_STATE) ** -0.5)
    s5_c_im = nrm(ks[16], (L, S5_GROUPS, S5_GROUP, S5_STATE), (2.0 * S5_STATE) ** -0.5)
    s5_d = nrm(ks[17], (L, D_BRANCH), 1.0)
    s5_glu_w = nrm(ks[18], (L, D_BRANCH, D_BRANCH), D_BRANCH ** -0.5)
    s5_glu_b = nrm(ks[19], (L, D_BRANCH), 0.02)
    gla_w_gate = nrm(ks[20], (L, GLA_RANK, GLA_DK), GLA_RANK ** -0.5)
    gla_b_gate = nrm(ks[21], (L, GLA_DK), 0.1)
    gla_norm_w = 1.0 + nrm(ks[22], (L, GLA_HV), 0.02)
    ssd_conv_w = nrm(ks[23], (L, CONV_W, SSD_CONV_DIM), CONV_W ** -0.5)
    ssd_conv_b = nrm(ks[24], (L, SSD_CONV_DIM), 0.02)
    dt0 = jnp.exp(uni(ks[25], (L, SSD_HEADS), math.log(1e-3), math.log(1e-1)))
    ssd_dt_bias = dt0 + jnp.log(-jnp.expm1(-dt0))
    ssd_a_log = jnp.log(uni(ks[26], (L, SSD_HEADS), 1.0, 16.0))
    ssd_d = 1.0 + nrm(ks[27], (L, SSD_HEADS), 0.1)
    ssd_norm_w = 1.0 + nrm(ks[28], (L, D_BRANCH), 0.02)
    w_out = nrm(ks[29], (L, D_MIX, D_MODEL), D_MIX ** -0.5)
    norm_f_w = 1.0 + nrm(ks[30], (D_MODEL,), 0.02)
    return {
        "x": x, "norm_w": norm_w, "w_in": w_in,
        "lru_conv_w": lru_conv_w, "lru_conv_b": lru_conv_b, "lru_w_r": lru_w_r, "lru_b_r": lru_b_r,
        "lru_w_i": lru_w_i, "lru_b_i": lru_b_i, "lru_l": lru_l,
        "s5_lam_re": s5_lam_re, "s5_lam_im": s5_lam_im, "s5_log_dt": s5_log_dt,
        "s5_b_re": s5_b_re, "s5_b_im": s5_b_im, "s5_c_re": s5_c_re, "s5_c_im": s5_c_im,
        "s5_d": s5_d, "s5_glu_w": s5_glu_w, "s5_glu_b": s5_glu_b,
        "gla_w_gate": gla_w_gate, "gla_b_gate": gla_b_gate, "gla_norm_w": gla_norm_w,
        "ssd_conv_w": ssd_conv_w, "ssd_conv_b": ssd_conv_b, "ssd_dt_bias": ssd_dt_bias,
        "ssd_a_log": ssd_a_log, "ssd_d": ssd_d, "ssd_norm_w": ssd_norm_w,
        "w_out": w_out, "norm_f_w": norm_f_w,
    }


def reference(x, norm_w, w_in, lru_conv_w, lru_conv_b, lru_w_r, lru_b_r, lru_w_i, lru_b_i, lru_l,
              s5_lam_re, s5_lam_im, s5_log_dt, s5_b_re, s5_b_im, s5_c_re, s5_c_im, s5_d, s5_glu_w, s5_glu_b,
              gla_w_gate, gla_b_gate, gla_norm_w,
              ssd_conv_w, ssd_conv_b, ssd_dt_bias, ssd_a_log, ssd_d, ssd_norm_w,
              w_out, norm_f_w):
    split_idx = np.cumsum(IN_SIZES)[:-1].tolist()
    for l in range(DEPTH):
        h = rmsnorm(x, norm_w[l])
        proj = h @ w_in[l]
        (a_x, a_z, b_u, b_z, c_q, c_k, c_v, c_z, c_g, d_z, d_xbc, d_dt) = jnp.split(proj, split_idx, axis=-1)
        y_a = rglru_mixer(a_x, a_z, lru_conv_w[l], lru_conv_b[l], lru_w_r[l], lru_b_r[l],
                          lru_w_i[l], lru_b_i[l], lru_l[l])
        y_b = s5_mixer(b_u, b_z, s5_lam_re[l], s5_lam_im[l], s5_log_dt[l], s5_b_re[l], s5_b_im[l],
                       s5_c_re[l], s5_c_im[l], s5_d[l], s5_glu_w[l], s5_glu_b[l])
        y_c = gla_mixer(c_q, c_k, c_v, c_z, c_g, gla_w_gate[l], gla_b_gate[l], gla_norm_w[l])
        y_d = ssd_mixer(d_z, d_xbc, d_dt, ssd_conv_w[l], ssd_conv_b[l], ssd_dt_bias[l],
                        ssd_a_log[l], ssd_d[l], ssd_norm_w[l])
        y = jnp.concatenate([y_a, y_b, y_c, y_d], axis=-1).astype(x.dtype)
        x = x + y @ w_out[l]
    return rmsnorm(x, norm_f_w)
```

```cpp
#include <hip/hip_runtime.h>
#include <hip/hip_cooperative_groups.h>
#include <cstdio>
#include <cstdint>
namespace cg = cooperative_groups;

#ifndef DBG_MASK
#define DBG_MASK 0xFFF
#endif
#ifndef PROBE_DUP
#define PROBE_DUP 0
#endif
#ifndef PROBE_MIX
#define PROBE_MIX 0
#endif
#ifndef MK_PER_PHASE
#define MK_PER_PHASE 0
#endif

namespace pg8 {
#define PG8_LAS __attribute__((address_space(3)))
typedef unsigned short bf16_t;
typedef short bf16x8 __attribute__((ext_vector_type(8)));
typedef float f32x4 __attribute__((ext_vector_type(4)));
typedef unsigned u32x4 __attribute__((ext_vector_type(4)));
typedef unsigned u32x2 __attribute__((ext_vector_type(2)));
constexpr int BM = 256, BK = 64, HALF = 128, HTB = HALF * BK * 2, STAGE_BYTES = 8 * HTB, NXCD = 8, WGM = 8;

__host__ __device__ __forceinline__ int lds_byte(int r, int c) { const int st = (r >> 4) * 2 + (c >> 5), rr = r & 15, cc = c & 31, ob = rr * 64 + cc * 2; return st * 1024 + (ob ^ (((ob >> 9) & 1) << 5)); }
__host__ __device__ __forceinline__ void stage_rc(int b, int& R, int& C) { const int st = b / 1024, sb = b % 1024, swz = sb ^ (((sb >> 9) & 1) << 5); R = (st >> 1) * 16 + swz / 64; C = (st & 1) * 32 + (swz % 64) / 2; }
__host__ __device__ __forceinline__ int perm32(int rho) { const int n = rho >> 4, i = rho & 15; return 8 * (i >> 2) + 4 * n + (i & 3); }

struct Unit { int pm, pn; };
struct Gemm { const bf16_t* A; const bf16_t* Bt; int M, N, K, lda, segcols; };

struct StaticOrder {
    int nM, nN, nwg, G, c;
    __host__ __device__ void init(int M, int N, int G_, int c_) { nM = M / BM; nN = N / BM; nwg = nM * nN; G = G_; c = c_; }
    __host__ __device__ bool next(int i, Unit& u) const {
        const long L = (long)i * G + c; if (L >= nwg) return false;
        int wgid = (int)L; { const int q = nwg / NXCD, r = nwg % NXCD, xcd = wgid % NXCD, off = wgid / NXCD; wgid = (xcd < r ? xcd * (q + 1) : r * (q + 1) + (xcd - r) * q) + off; }
        const int nig = WGM * nN, gid = wgid / nig, fm = gid * WGM, gsz = (nM - fm) < WGM ? (nM - fm) : WGM;
        u.pm = fm + ((wgid % nig) % gsz); u.pn = (wgid % nig) / gsz; return true;
    }
};

__device__ __forceinline__ unsigned cvt_pk_bf16(float lo, float hi) { unsigned r; asm volatile("v_cvt_pk_bf16_f32 %0, %1, %2" : "=v"(r) : "v"(lo), "v"(hi)); return r; }

struct EpiProj {
    static constexpr bool PERM = true;
    bf16_t* P; float* EX; const float* rowss; int pj;
    __device__ __forceinline__ void operator()(const f32x4 (&acc)[2][2][4][2], const Unit& u, int wr, int wc, int fr, int fq) const {
        const int row0 = u.pm * BM + wr * 64 + fr;
#pragma unroll
        for (int ai = 0; ai < 2; ++ai)
#pragma unroll
            for (int m = 0; m < 4; ++m) {
                const int row = row0 + ai * HALF + m * 16;
                const f32x4* pp = (const f32x4*)(rowss + (size_t)row * 16); const f32x4 p0 = pp[0], p1 = pp[1], p2 = pp[2], p3 = pp[3];
                const float rsum = (((p0[0] + p0[1]) + (p0[2] + p0[3])) + ((p1[0] + p1[1]) + (p1[2] + p1[3]))) + (((p2[0] + p2[1]) + (p2[2] + p2[3])) + ((p3[0] + p3[1]) + (p3[2] + p3[3])));
                const float rstd = 1.0f / sqrtf(rsum * (1.0f / 1024.0f) + 1e-6f);
                if (u.pn < 20) {
                    bf16_t* rowp = P + (size_t)row * pj + u.pn * BM + wc * 32 + 8 * fq;
#pragma unroll
                    for (int bj = 0; bj < 2; ++bj) { const f32x4 v0 = acc[ai][bj][m][0] * rstd, v1 = acc[ai][bj][m][1] * rstd;
                        u32x4 w; w.x = cvt_pk_bf16(v0[0], v0[1]); w.y = cvt_pk_bf16(v0[2], v0[3]); w.z = cvt_pk_bf16(v1[0], v1[1]); w.w = cvt_pk_bf16(v1[2], v1[3]);
                        *(u32x4*)(rowp + bj * HALF) = w; }
                } else if (wc == 0) {
                    float* ep = EX + (size_t)row * 32 + 8 * fq;
                    *(f32x4*)(ep) = acc[ai][0][m][0] * rstd; *(f32x4*)(ep + 4) = acc[ai][0][m][1] * rstd;
                }
            }
    }
};
struct EpiOut {
    static constexpr bool PERM = false;
    const float* Xf; const bf16_t* XBin; bf16_t* XBout; float* rowss_next;
    __device__ __forceinline__ void operator()(const f32x4 (&acc)[2][2][4][2], const Unit& u, int wr, int wc, int fr, int fq) const {
        const int row0 = u.pm * BM + wr * 64 + fr, col0 = u.pn * BM + wc * 32 + 4 * fq;
#pragma unroll
        for (int ai = 0; ai < 2; ++ai)
#pragma unroll
            for (int mh = 0; mh < 2; ++mh) {
                f32x4 xo[2][2][2];
                if (Xf) {
#pragma unroll
                    for (int m = 0; m < 2; ++m)
#pragma unroll
                        for (int bj = 0; bj < 2; ++bj)
#pragma unroll
                            for (int n = 0; n < 2; ++n) xo[m][bj][n] = *(const f32x4*)(Xf + (size_t)(row0 + ai * HALF + (2 * mh + m) * 16) * 1024 + col0 + bj * HALF + n * 16);
                } else {
#pragma unroll
                    for (int m = 0; m < 2; ++m)
#pragma unroll
                        for (int bj = 0; bj < 2; ++bj)
#pragma unroll
                            for (int n = 0; n < 2; ++n) { const u32x2 w = *(const u32x2*)(XBin + (size_t)(row0 + ai * HALF + (2 * mh + m) * 16) * 1024 + col0 + bj * HALF + n * 16);
                                xo[m][bj][n] = (f32x4){__builtin_bit_cast(float, w.x << 16), __builtin_bit_cast(float, w.x & 0xffff0000u), __builtin_bit_cast(float, w.y << 16), __builtin_bit_cast(float, w.y & 0xffff0000u)}; }
                }
#pragma unroll
                for (int m = 0; m < 2; ++m) {
                    const int mm = 2 * mh + m, row = row0 + ai * HALF + mm * 16; float ss = 0.f;
#pragma unroll
                    for (int bj = 0; bj < 2; ++bj)
#pragma unroll
                        for (int n = 0; n < 2; ++n) { const size_t off = (size_t)row * 1024 + col0 + bj * HALF + n * 16;
                            const f32x4 xn = xo[m][bj][n] + acc[ai][bj][mm][n];
                            u32x2 w; w.x = cvt_pk_bf16(xn[0], xn[1]); w.y = cvt_pk_bf16(xn[2], xn[3]); *(u32x2*)(XBout + off) = w;
                            ss += (xn[0] * xn[0] + xn[1] * xn[1]) + (xn[2] * xn[2] + xn[3] * xn[3]); }
                    ss += __shfl_xor(ss, 16); ss += __shfl_xor(ss, 32);
                    if (fq == 0) rowss_next[(size_t)row * 16 + u.pn * 4 + wc] = ss;
                }
            }
    }
};

__device__ __forceinline__ int opaque_tid() { int t = threadIdx.x; asm volatile("" : "+v"(t)); return t; }
template <class Epi, class Sched, bool ALIGN_EPI = false, bool SP2 = false>
__device__ __forceinline__ void gemm_phase(PG8_LAS unsigned char* lds, const Gemm g, const Sched& S, const Epi& E) {
    const int tid = opaque_tid(), wid = __builtin_amdgcn_readfirstlane(tid >> 6), lane = tid & 63, wr = wid >> 2, wc = wid & 3, fr = lane & 15, fq = lane >> 4;
    const int K = g.K, nt = K / BK, lda = g.lda;
    unsigned voffA[2], voffB[2];
#pragma unroll
    for (int i = 0; i < 2; ++i) { int R, C; stage_rc(tid * 16 + i * 8192, R, C); const int Rb = Epi::PERM ? ((R & ~31) + perm32(R & 31)) : R;
        voffA[i] = (unsigned)(R * lda + C) * 2u; voffB[i] = (unsigned)(Rb * K + C) * 2u; }
    const size_t kstep = (size_t)(BK * 2);
    const size_t segB = (size_t)g.segcols * 2;
    const size_t hstepA = (size_t)HALF * lda * 2, hstepB = (size_t)HALF * K * 2;
    const size_t tstepA = 2 * hstepA, tstepB = 2 * hstepB;
    const unsigned ldsw = (unsigned)wid * 1024u;
    const int aoff = lds_byte(wr * 64 + fr, fq * 8), boff = lds_byte(wc * 32 + fr, fq * 8);
#define PG8_KA(t) ((size_t)((t) >> 3) * segB + (size_t)((t) & 7) * kstep)
#define PG8_SA(b, h) (((b) * 2 + (h)) * HTB)
#define PG8_SB(b, h) ((4 + (b) * 2 + (h)) * HTB)
#define PG8_STAGE(bufoff, gbase, voff) do { _Pragma("unroll") for (int _i = 0; _i < 2; ++_i) \
        __builtin_amdgcn_global_load_lds((const unsigned*)((const char*)(gbase) + (voff)[_i]), (PG8_LAS unsigned*)(lds + (bufoff) + ldsw + _i * 8192), 16, 0, 0); } while (0)
#define PG8_LDA(dst, b, h) do { _Pragma("unroll") for (int m = 0; m < 4; ++m) _Pragma("unroll") for (int k = 0; k < 2; ++k) dst[m][k] = *(const PG8_LAS bf16x8*)(lds + PG8_SA(b, h) + aoff + m * 2048 + k * 1024); } while (0)
#define PG8_LDB(dst, b, h) do { _Pragma("unroll") for (int n = 0; n < 2; ++n) _Pragma("unroll") for (int k = 0; k < 2; ++k) dst[n][k] = *(const PG8_LAS bf16x8*)(lds + PG8_SB(b, h) + boff + n * 2048 + k * 1024); } while (0)
#define PG8_MMA(ai, bj, At, Bt) do { __builtin_amdgcn_s_setprio(1); _Pragma("unroll") for (int m = 0; m < 4; ++m) _Pragma("unroll") for (int n = 0; n < 2; ++n) _Pragma("unroll") for (int k = 0; k < 2; ++k) \
        acc[ai][bj][m][n] = __builtin_amdgcn_mfma_f32_16x16x32_bf16(Bt[n][k], At[m][k], acc[ai][bj][m][n], 0, 0, 0); __builtin_amdgcn_s_setprio(0); } while (0)
#define PG8_WAIT_V(n) asm volatile("s_waitcnt vmcnt(" #n ")" ::: "memory")
#define PG8_WAIT_L(n) asm volatile("s_waitcnt lgkmcnt(" #n ")" ::: "memory")
#define PG8_BAR __builtin_amdgcn_s_barrier()
#define PG8_SCHED __builtin_amdgcn_sched_barrier(0)
    Unit cur, nxt; int ui = 0;
    if (!S.next(0, cur)) return;
    f32x4 acc[2][2][4][2];
#pragma unroll
    for (int a = 0; a < 2; ++a)
#pragma unroll
        for (int b = 0; b < 2; ++b)
#pragma unroll
            for (int m = 0; m < 4; ++m)
#pragma unroll
                for (int n = 0; n < 2; ++n) acc[a][b][m][n] = (f32x4){0.f, 0.f, 0.f, 0.f};
    bf16x8 At[4][2], B0[2][2], B1[2][2];
    const char* cA = (const char*)g.A + (size_t)cur.pm * tstepA; const char* cB = (const char*)g.Bt + (size_t)cur.pn * tstepB;
    if constexpr (SP2) {
        PG8_STAGE(PG8_SB(0, 0), cB, voffB); PG8_STAGE(PG8_SB(0, 1), cB + hstepB, voffB); PG8_STAGE(PG8_SA(0, 0), cA, voffA); PG8_STAGE(PG8_SA(0, 1), cA + hstepA, voffA);
        if (wr == 1) PG8_BAR;
        PG8_WAIT_V(2); PG8_BAR;
        PG8_STAGE(PG8_SB(1, 0), cB + kstep, voffB); PG8_STAGE(PG8_SA(1, 0), cA + kstep, voffA); PG8_STAGE(PG8_SB(1, 1), cB + hstepB + kstep, voffB);
        PG8_WAIT_V(6); PG8_BAR;
    } else {
        PG8_STAGE(PG8_SB(0, 0), cB, voffB); PG8_STAGE(PG8_SA(0, 0), cA, voffA); PG8_STAGE(PG8_SB(0, 1), cB + hstepB, voffB); PG8_STAGE(PG8_SA(0, 1), cA + hstepA, voffA);
        if (wr == 1) PG8_BAR;
        PG8_WAIT_V(4); PG8_BAR;
        PG8_STAGE(PG8_SB(1, 0), cB + kstep, voffB); PG8_STAGE(PG8_SA(1, 0), cA + kstep, voffA); PG8_STAGE(PG8_SB(1, 1), cB + hstepB + kstep, voffB);
        PG8_WAIT_V(6); PG8_BAR;
    }
    for (;;) {
        const bool has_next = S.next(ui + 1, nxt);
        const char* nA = has_next ? (const char*)g.A + (size_t)nxt.pm * tstepA : cA; const char* nB = has_next ? (const char*)g.Bt + (size_t)nxt.pn * tstepB : cB;
        for (int t = 0; t < nt; t += 2) {
            const bool last = (t == nt - 2);
            const char* a1 = cA + PG8_KA(t + 1);
            const char* a2 = last ? nA : cA + PG8_KA(t + 2); const char* b2 = last ? nB : cB + (size_t)(t + 2) * kstep;
            const char* a3 = a2 + kstep; const char* b3 = b2 + kstep;
            if constexpr (SP2) {
            PG8_LDB(B0, 0, 0); PG8_LDB(B1, 0, 1); PG8_SCHED; PG8_LDA(At, 0, 0); PG8_STAGE(PG8_SA(1, 1), a1 + hstepA, voffA);
            PG8_WAIT_V(8); PG8_WAIT_L(0); PG8_BAR; PG8_MMA(0, 0, At, B0); PG8_MMA(0, 1, At, B1); PG8_BAR; PG8_SCHED;
            PG8_LDA(At, 0, 1); PG8_STAGE(PG8_SB(0, 0), b2, voffB); PG8_STAGE(PG8_SB(0, 1), b2 + hstepB, voffB); PG8_STAGE(PG8_SA(0, 0), a2, voffA);
            PG8_WAIT_V(8); PG8_WAIT_L(0); PG8_BAR; PG8_MMA(1, 0, At, B0); PG8_MMA(1, 1, At, B1); PG8_BAR; PG8_SCHED;
            PG8_LDB(B0, 1, 0); PG8_LDB(B1, 1, 1); PG8_SCHED; PG8_LDA(At, 1, 0); PG8_STAGE(PG8_SA(0, 1), a2 + hstepA, voffA);
            PG8_WAIT_V(8); PG8_WAIT_L(0); PG8_BAR; PG8_MMA(0, 0, At, B0); PG8_MMA(0, 1, At, B1); PG8_BAR; PG8_SCHED;
            PG8_LDA(At, 1, 1); PG8_STAGE(PG8_SB(1, 0), b3, voffB); PG8_STAGE(PG8_SB(1, 1), b3 + hstepB, voffB); PG8_STAGE(PG8_SA(1, 0), a3, voffA);
            PG8_WAIT_V(8); PG8_WAIT_L(0); PG8_BAR; PG8_MMA(1, 0, At, B0); PG8_MMA(1, 1, At, B1); PG8_BAR; PG8_SCHED;
            } else {
            PG8_LDB(B0, 0, 0); PG8_SCHED; PG8_LDA(At, 0, 0); PG8_STAGE(PG8_SA(1, 1), a1 + hstepA, voffA);
            PG8_WAIT_L(8); PG8_BAR; PG8_WAIT_L(0); PG8_MMA(0, 0, At, B0); PG8_BAR; PG8_SCHED;
            PG8_LDB(B1, 0, 1); PG8_STAGE(PG8_SB(0, 0), b2, voffB);
            PG8_BAR; PG8_WAIT_L(0); PG8_MMA(0, 1, At, B1); PG8_BAR;
            PG8_LDA(At, 0, 1); PG8_STAGE(PG8_SA(0, 0), a2, voffA);
            PG8_BAR; PG8_WAIT_L(0); PG8_MMA(1, 0, At, B0); PG8_BAR; PG8_SCHED;
            PG8_STAGE(PG8_SB(0, 1), b2 + hstepB, voffB);
            PG8_WAIT_V(6); PG8_BAR; PG8_MMA(1, 1, At, B1); PG8_BAR;
            PG8_LDB(B0, 1, 0); PG8_SCHED; PG8_LDA(At, 1, 0); PG8_STAGE(PG8_SA(0, 1), a2 + hstepA, voffA);
            PG8_WAIT_L(8); PG8_BAR; PG8_WAIT_L(0); PG8_MMA(0, 0, At, B0); PG8_BAR; PG8_SCHED;
            PG8_LDB(B1, 1, 1); PG8_STAGE(PG8_SB(1, 0), b3, voffB);
            PG8_BAR; PG8_WAIT_L(0); PG8_MMA(0, 1, At, B1); PG8_BAR;
            PG8_LDA(At, 1, 1); PG8_STAGE(PG8_SA(1, 0), a3, voffA);
            PG8_BAR; PG8_WAIT_L(0); PG8_MMA(1, 0, At, B0); PG8_BAR; PG8_SCHED;
            PG8_STAGE(PG8_SB(1, 1), b3 + hstepB, voffB);
            PG8_WAIT_V(6); PG8_BAR; PG8_MMA(1, 1, At, B1); PG8_BAR;
            }
        }
        if constexpr (ALIGN_EPI) { if (wr == 0) PG8_BAR; }
        E(acc, cur, wr, wc, fr, fq);
        if (!has_next) break;
#pragma unroll
        for (int a = 0; a < 2; ++a)
#pragma unroll
            for (int b = 0; b < 2; ++b)
#pragma unroll
                for (int m = 0; m < 4; ++m)
#pragma unroll
                    for (int n = 0; n < 2; ++n) acc[a][b][m][n] = (f32x4){0.f, 0.f, 0.f, 0.f};
        cur = nxt; cA = nA; cB = nB; ++ui;
        if constexpr (ALIGN_EPI) { if (wr == 1) PG8_BAR; }
    }
    PG8_WAIT_V(0);
    if constexpr (!ALIGN_EPI) { if (wr == 0) PG8_BAR; }
    PG8_BAR;
#undef PG8_KA
#undef PG8_SA
#undef PG8_SB
#undef PG8_STAGE
#undef PG8_LDA
#undef PG8_LDB
#undef PG8_MMA
#undef PG8_WAIT_V
#undef PG8_WAIT_L
#undef PG8_BAR
#undef PG8_SCHED
}
}

constexpr int NWAVES = 8, NTHR = 512;
constexpr int DM = 1024, BATCH = 2, SEQ = 8192, DEPTH = 4, T = BATCH * SEQ;
constexpr int DIN = 5144, PJ = 5120, NPAD = 5152, NCHUNK = T / 64, CPB = SEQ / 64;
constexpr float EPS = 1e-6f;
constexpr int A_Z = 0, A_X = 512, C_Q = 1024, B_Z = 1280, B_U = 1792, C_K = 2304, C_Z = 2560, C_V = 3072, D_CM = 3584, D_Z = 3840, D_XS = 4352, D_BM = 4864;
constexpr int O_AX = 0, O_AZ = 512, O_BU = 1024, O_BZ = 1536, O_CQ = 2048, O_CK = 2304, O_CV = 2560, O_CZ = 3072, O_CG = 3584, O_DZ = 3600, O_DXBC = 4112, O_DDT = 5136;
__host__ __device__ __forceinline__ int orig_col(int j) {
    if (j < 512) return O_AZ + j;
    if (j < 1024) return O_AX + (j - 512);
    if (j < 1280) return O_CQ + (j - 1024);
    if (j < 1792) return O_BZ + (j - 1280);
    if (j < 2304) return O_BU + (j - 1792);
    if (j < 2560) return O_CK + (j - 2304);
    if (j < 3072) return O_CZ + (j - 2560);
    if (j < 3584) return O_CV + (j - 3072);
    if (j < 3840) return O_DXBC + 768 + (j - 3584);
    if (j < 4352) return O_DZ + (j - 3840);
    if (j < 4864) return O_DXBC + (j - 4352);
    if (j < 5120) return O_DXBC + 512 + (j - 4864);
    if (j < 5136) return O_CG + (j - 5120);
    if (j < 5144) return O_DDT + (j - 5136);
    return -1;
}
constexpr size_t MiB = 1u << 20;
constexpr size_t WS_CTL = 0, CTL_ZERO_BYTES = 1 * MiB;
constexpr size_t CTL_ROWSS = 512 * 1024;
constexpr size_t WS_WIN = 1 * MiB;
constexpr size_t WS_WOUT = 43 * MiB;
constexpr size_t WS_S5T = 59 * MiB;
constexpr size_t WS_PROJ = 75 * MiB;
constexpr size_t WS_EX = 235 * MiB;
constexpr size_t WS_GLA = 237 * MiB;
constexpr size_t WS_SSD = 253 * MiB;
constexpr size_t WS_XBF = WS_SSD;
constexpr size_t WS_S5ST = 285 * MiB;
constexpr size_t WS_LRUE = 289 * MiB;
constexpr size_t WS_LRUH = 290 * MiB;
constexpr size_t WS_GDEC = 291 * MiB;
constexpr size_t WS_SDEC = 292 * MiB;
constexpr size_t WS_PART = 293 * MiB;
constexpr size_t WS_GLUT = 298 * MiB;
constexpr size_t WS_LRW = 300 * MiB;
constexpr size_t WS_END = 301 * MiB;
constexpr size_t S5T_AB = 0;
constexpr size_t S5T_A64 = 16384;
constexpr size_t S5T_BC = 65536;
constexpr size_t S5T_CC = 196608;
constexpr size_t S5T_PW = 327680;
constexpr size_t S5T_KT = 1048576;
constexpr size_t S5T_LAYER = 4 * MiB;

constexpr int LDS_BYTES = 155648;

#define GAS __attribute__((address_space(1)))
#define LAS __attribute__((address_space(3)))
typedef unsigned short bf16;
typedef unsigned v4u __attribute__((ext_vector_type(4)));
typedef float f32x4 __attribute__((ext_vector_type(4)));

__device__ __forceinline__ unsigned f2bf(float f) { unsigned u = __builtin_bit_cast(unsigned, f); return (u + 0x7fffu + ((u >> 16) & 1u)) >> 16; }
__device__ __forceinline__ unsigned pk2(float lo, float hi) { return f2bf(lo) | (f2bf(hi) << 16); }
__device__ __forceinline__ float bf2f(unsigned h) { return __builtin_bit_cast(float, (h & 0xffffu) << 16); }
__device__ __forceinline__ float bflo(unsigned w) { return __builtin_bit_cast(float, w << 16); }
__device__ __forceinline__ float bfhi(unsigned w) { return __builtin_bit_cast(float, w & 0xffff0000u); }
__device__ __forceinline__ float fexp(float x) { return __builtin_amdgcn_exp2f(x * 1.4426950408889634f); }
__device__ __forceinline__ float frcp(float x) { return __builtin_amdgcn_rcpf(x); }
__device__ __forceinline__ float sigm(float x) { return frcp(1.0f + fexp(-x)); }
__device__ __forceinline__ float silu(float x) { return x * frcp(1.0f + fexp(-x)); }
__device__ __forceinline__ float softplus(float x) { return fmaxf(x, 0.f) + __builtin_amdgcn_logf(1.0f + fexp(-fabsf(x))) * 0.6931471805599453f; }
__device__ __forceinline__ float gelu_tanh(float x) { const float u = 0.7978845608028654f * (x + 0.044715f * x * x * x); return x * frcp(1.0f + fexp(-2.0f * u)); }
__device__ __forceinline__ float neg_expm1(float x) { const float s = -x * (1.0f + x * (0.5f + x * (0.16666667f + x * 0.041666668f))); const float d = 1.0f - fexp(x); return fabsf(x) < 0.03f ? s : d; }
__device__ __forceinline__ float fsqrt(float x) { return __builtin_amdgcn_sqrtf(x); }
__device__ __forceinline__ float frsq(float x) { return __builtin_amdgcn_rsqf(x); }
__device__ __forceinline__ float wave_sum(float v) {
#pragma unroll
    for (int o = 1; o < 64; o <<= 1) v += __shfl_xor(v, o);
    return v;
}

__device__ __forceinline__ int opaque_tid() { int t = threadIdx.x; asm volatile("" : "+v"(t)); return t; }
typedef short bf16x8 __attribute__((ext_vector_type(8)));
typedef short bf16x4 __attribute__((ext_vector_type(4)));
typedef float f32x2 __attribute__((ext_vector_type(2)));
typedef unsigned v2u __attribute__((ext_vector_type(2)));
__device__ __forceinline__ f32x4 mfma32(bf16x8 x, bf16x8 y, f32x4 c) { return __builtin_amdgcn_mfma_f32_16x16x32_bf16(x, y, c, 0, 0, 0); }
__device__ __forceinline__ f32x4 mfma16(bf16x4 x, bf16x4 y, f32x4 c) { return __builtin_amdgcn_mfma_f32_16x16x16bf16_1k(x, y, c, 0, 0, 0); }
typedef short v4i16_t __attribute__((ext_vector_type(4)));
__device__ __forceinline__ bf16x8 tr_frag(const LAS bf16* p, int pitch) {
    const v4i16_t x = __builtin_amdgcn_ds_read_tr16_b64_v4i16((LAS v4i16_t*)p), y = __builtin_amdgcn_ds_read_tr16_b64_v4i16((LAS v4i16_t*)(p + 4 * pitch));
    return (bf16x8){x[0], x[1], x[2], x[3], y[0], y[1], y[2], y[3]};
}
#define PIN_MEM() asm volatile("" ::: "memory")
struct Args { const float* in[31]; float* out; unsigned char* ws; int ph_lo, ph_hi; };
enum { I_X = 0, I_NORMW, I_WIN, I_LCW, I_LCB, I_LWR, I_LBR, I_LWI, I_LBI, I_LL, I_SLR, I_SLI, I_SLDT, I_SBR, I_SBI, I_SCR, I_SCI, I_SD, I_SGW, I_SGB,
       I_GWG, I_GBG, I_GNW, I_DCW, I_DCB, I_DDTB, I_DALOG, I_DD, I_DNW, I_WOUT, I_NFW };

template <bool MAPPED>
__device__ __forceinline__ void p0_transpose_item(const float* W, int K, int ldw, int nblk, const float* kscale, bf16* WT, LAS float* scr, int item, int lane) {
    const int kb = item / nblk, nb = item % nblk, k0 = 64 * kb, n0 = 32 * nb;
    const int myc = n0 + (lane & 31); const int oc = MAPPED ? orig_col(myc) : myc;
    const int c = lane & 7; float ksc[8];
    { float vv[32]; const int occ = oc >= 0 ? oc : 0;
#pragma unroll
      for (int i = 0; i < 32; ++i) { const int kk = 2 * i + (lane >> 5); vv[i] = W[(size_t)(k0 + kk) * ldw + occ]; }
#pragma unroll
      for (int q = 0; q < 8; ++q) ksc[q] = kscale ? kscale[k0 + 8 * c + q] : 1.0f;
      PIN_MEM();
#pragma unroll
      for (int i = 0; i < 32; ++i) { const int kk = 2 * i + (lane >> 5); scr[kk * 33 + (lane & 31)] = oc >= 0 ? vv[i] : 0.f; } }
    asm volatile("s_waitcnt lgkmcnt(0)" ::: "memory");
#pragma unroll
    for (int j = 0; j < 4; ++j) { const int n = (lane >> 3) + 8 * j; const LAS float* s = scr + (8 * c) * 33 + n;
        v4u o; o.x = pk2(s[0 * 33] * ksc[0], s[1 * 33] * ksc[1]); o.y = pk2(s[2 * 33] * ksc[2], s[3 * 33] * ksc[3]); o.z = pk2(s[4 * 33] * ksc[4], s[5 * 33] * ksc[5]); o.w = pk2(s[6 * 33] * ksc[6], s[7 * 33] * ksc[7]);
        *(GAS v4u*)(WT + (size_t)(n0 + n) * K + k0 + 8 * c) = o; }
    asm volatile("s_waitcnt lgkmcnt(0)" ::: "memory");
}

__device__ __forceinline__ void p0_s5_tables(const Args& a, LAS unsigned char* lds, int item) {
    const int tid = opaque_tid(); const int l = item >> 6, g = (item >> 1) & 31, dh = item & 1;
    LAS f32x2* P = (LAS f32x2*)lds;
    LAS f32x2* BL = P + 32 * 64;
    LAS f32x2* CL = BL + 64 * 16;
    unsigned char* tb = a.ws + WS_S5T + (size_t)l * S5T_LAYER;
    const float dt = expf(a.in[I_SLDT][l * 32 + g]);
    const float* LR = a.in[I_SLR] + l * 2048 + g * 64; const float* LI = a.in[I_SLI] + l * 2048 + g * 64;
    for (int idx = tid; idx < 2048; idx += NTHR) { const int dd = idx >> 6, n = idx & 63, d = dh * 32 + dd;
        const float m = expf(LR[n] * dt * (float)d), ang = LI[n] * dt * (float)d; const f32x2 v = {m * cosf(ang), m * sinf(ang)}; P[dd * 64 + n] = v;
        if (dh == 0 && d <= 16) ((f32x2*)(tb + S5T_PW))[(g * 64 + n) * 17 + d] = v;
        if (dh == 0 && d == 1) ((f32x2*)(tb + S5T_AB))[g * 64 + n] = v; }
    for (int idx = tid; idx < 1024; idx += NTHR) { const int n = idx >> 4, q = idx & 15; const float lr = LR[n], li = LI[n];
        const float mag = expf(lr * dt), abr = mag * cosf(li * dt), abi = mag * sinf(li * dt), den = lr * lr + li * li, nr = abr - 1.0f;
        const float cr = (nr * lr + abi * li) / den, ci = (abi * lr - nr * li) / den;
        const float br = a.in[I_SBR][((size_t)(l * 32 + g) * 64 + n) * 16 + q], bi = a.in[I_SBI][((size_t)(l * 32 + g) * 64 + n) * 16 + q];
        const f32x2 v = {cr * br - ci * bi, cr * bi + ci * br}; BL[n * 16 + q] = v;
        if (dh == 0) { bf16* BC = (bf16*)(tb + S5T_BC); BC[(g * 128 + n) * 16 + q] = (bf16)f2bf(v.x); BC[(g * 128 + 64 + n) * 16 + q] = (bf16)f2bf(v.y); } }
    for (int idx = tid; idx < 1024; idx += NTHR) { const int p = idx >> 6, n = idx & 63;
        const f32x2 v = {a.in[I_SCR][((size_t)(l * 32 + g) * 16 + p) * 64 + n], a.in[I_SCI][((size_t)(l * 32 + g) * 16 + p) * 64 + n]}; CL[p * 64 + n] = v;
        if (dh == 0) { bf16* CC = (bf16*)(tb + S5T_CC); CC[(g * 16 + p) * 128 + 2 * n] = (bf16)f2bf(v.x); CC[(g * 16 + p) * 128 + 2 * n + 1] = (bf16)f2bf(-v.y); } }
    if (dh == 0 && tid < 64) { const float m64 = expf(64.0f * LR[tid] * dt), ang = 64.0f * LI[tid] * dt; const f32x2 v = {m64 * cosf(ang), m64 * sinf(ang)}; ((f32x2*)(tb + S5T_A64))[g * 64 + tid] = v; }
    __syncthreads();
    { const int pq = tid & 255, p = pq >> 4, q = pq & 15, dq = tid >> 8; float s[16];
#pragma unroll
      for (int i = 0; i < 16; ++i) s[i] = 0.f;
#pragma unroll 1
      for (int nh = 0; nh < 4; ++nh) { float cbr[16], cbi[16];
#pragma unroll
          for (int n = 0; n < 16; ++n) { const f32x2 cv = CL[p * 64 + nh * 16 + n], bv = BL[(nh * 16 + n) * 16 + q]; cbr[n] = cv.x * bv.x - cv.y * bv.y; cbi[n] = cv.x * bv.y + cv.y * bv.x; }
#pragma unroll
          for (int i = 0; i < 16; ++i) { const LAS f32x2* pp = P + (dq * 16 + i) * 64 + nh * 16; float t = 0.f;
#pragma unroll
              for (int n = 0; n < 16; ++n) { const f32x2 pw = pp[n]; t += cbr[n] * pw.x - cbi[n] * pw.y; }
              s[i] += t; } }
      bf16* KT = (bf16*)(tb + S5T_KT);
#pragma unroll
      for (int i = 0; i < 16; ++i) KT[((size_t)(g * 64 + dh * 32 + dq * 16 + i) * 16 + p) * 16 + q] = (bf16)f2bf(s[i]); }
    __syncthreads();
}

__device__ __forceinline__ void p0_prologue(const Args& a, LAS unsigned char* lds, int vcu, int G) {
    const int tid = opaque_tid(), lane = tid & 63, wave = __builtin_amdgcn_readfirstlane(tid >> 6);
    for (int item = vcu; item < DEPTH * 64; item += G) p0_s5_tables(a, lds, item);
    for (int idx = vcu * NTHR + tid; idx < DEPTH * 2 * 8 * 64 * 64; idx += G * NTHR) { const int i = idx & 63, j = (idx >> 6) & 63, h = (idx >> 12) & 7, gate = (idx >> 15) & 1, l = idx >> 16;
        ((bf16*)(a.ws + WS_LRW))[idx] = (bf16)f2bf(a.in[gate ? I_LWI : I_LWR][((size_t)(l * 8 + h) * 64 + i) * 64 + j]); }
    LAS float* scr = (LAS float*)(lds + wave * 16384);
    const int gw = vcu * NWAVES + wave, NGW = G * NWAVES;
    for (int it = gw; it < DEPTH * 128; it += NGW) { const int l = it >> 7;
        p0_transpose_item<false>(a.in[I_SGW] + (size_t)l * 512 * 512, 512, 512, 16, nullptr, (bf16*)(a.ws + WS_GLUT) + (size_t)l * 512 * 512, scr, it & 127, lane); }
    constexpr int I_IN = (DM / 64) * (NPAD / 32), I_OUT = (2048 / 64) * (DM / 32);
    for (int it = gw; it < DEPTH * (I_IN + I_OUT); it += NGW) {
        const int l = it / (I_IN + I_OUT); int r = it % (I_IN + I_OUT);
        if (r < I_IN) p0_transpose_item<true>(a.in[I_WIN] + (size_t)l * DM * DIN, DM, DIN, NPAD / 32, a.in[I_NORMW] + l * DM, (bf16*)(a.ws + WS_WIN) + (size_t)l * NPAD * DM, scr, r, lane);
        else p0_transpose_item<false>(a.in[I_WOUT] + (size_t)l * 2048 * DM, 2048, DM, DM / 32, nullptr, (bf16*)(a.ws + WS_WOUT) + (size_t)l * DM * 2048, scr, r - I_IN, lane);
    }
    float* rowss0 = (float*)(a.ws + WS_PART);
    for (int m0 = gw; m0 < T; m0 += 4 * NGW) {
        f32x4 v[4][4];
#pragma unroll
        for (int r = 0; r < 4; ++r)
#pragma unroll
            for (int j = 0; j < 4; ++j) v[r][j] = ((const GAS f32x4*)(a.in[I_X] + (size_t)(m0 + r * NGW) * DM) + lane)[64 * j];
        PIN_MEM();
#pragma unroll
        for (int r = 0; r < 4; ++r) { const int m = m0 + r * NGW; float s = 0.f;
            GAS unsigned long long* o8 = (GAS unsigned long long*)((bf16*)a.out + (size_t)m * DM) + lane;
#pragma unroll
            for (int j = 0; j < 4; ++j) { const f32x4 x = v[r][j]; s += (x.x * x.x + x.y * x.y) + (x.z * x.z + x.w * x.w);
                o8[64 * j] = (unsigned long long)pk2(x.x, x.y) | ((unsigned long long)pk2(x.z, x.w) << 32); }
            s = wave_sum(s); if (lane < 16) rowss0[(size_t)m * 16 + lane] = lane == 0 ? s : 0.f; }
    }
}

__device__ __forceinline__ void ex_chunk(const Args& a, int l, int c) {
    const int tid = opaque_tid(), lane = tid & 63, w = __builtin_amdgcn_readfirstlane(tid >> 6), l15 = lane & 15, lq = lane >> 4;
    const int nt = w & 1, tt = w >> 1, t = c * 64 + 16 * tt + l15;
    const bf16* wp = (const bf16*)(a.ws + WS_WIN) + ((size_t)l * NPAD + PJ + 16 * nt + l15) * DM + 8 * lq;
    const bf16* xp = (const bf16*)a.out + (size_t)t * DM + 8 * lq;
    const float* rs = (const float*)(a.ws + WS_PART) + (size_t)l * T * 16 + (size_t)t * 16;
    const f32x4 p0 = *(const GAS f32x4*)(rs), p1 = *(const GAS f32x4*)(rs + 4), p2 = *(const GAS f32x4*)(rs + 8), p3 = *(const GAS f32x4*)(rs + 12);
    f32x4 acc = (f32x4){0.f, 0.f, 0.f, 0.f};
#pragma unroll 1
    for (int kb = 0; kb < 4; ++kb) { bf16x8 xf[8], yf[8];
#pragma unroll
        for (int k8 = 0; k8 < 8; ++k8) { xf[k8] = *(const GAS bf16x8*)(wp + 32 * (kb * 8 + k8)); yf[k8] = *(const GAS bf16x8*)(xp + 32 * (kb * 8 + k8)); }
        PIN_MEM();
#pragma unroll
        for (int k8 = 0; k8 < 8; ++k8) acc = mfma32(xf[k8], yf[k8], acc); }
    const float rsum = (((p0[0] + p0[1]) + (p0[2] + p0[3])) + ((p1[0] + p1[1]) + (p1[2] + p1[3]))) + (((p2[0] + p2[1]) + (p2[2] + p2[3])) + ((p3[0] + p3[1]) + (p3[2] + p3[3])));
    const float rstd = frsq(rsum * (1.0f / 1024.0f) + EPS);
    *(GAS f32x4*)((float*)(a.ws + WS_EX) + (size_t)t * 32 + 16 * nt + 4 * lq) = acc * rstd;
}

template <int CTRL> __device__ __forceinline__ float dppf(float old, float v) { return __builtin_bit_cast(float, __builtin_amdgcn_update_dpp(__builtin_bit_cast(int, old), __builtin_bit_cast(int, v), CTRL, 0xF, 0xF, false)); }
#define LRU_SCAN_STEP(CTRL) do { const float Ap = dppf<CTRL>(1.0f, A[mt]), Bp = dppf<CTRL>(0.0f, B[mt]); B[mt] = A[mt] * Bp + B[mt]; A[mt] = A[mt] * Ap; } while (0)
__device__ __forceinline__ void lru_chunk(const Args& a, int l, int c, bool fin, LAS unsigned char* lds, bool dry = false, bool conv_only = false) {
    const int tid = opaque_tid(), lane = tid & 63, h = __builtin_amdgcn_readfirstlane(tid >> 6), l15 = lane & 15, lq = lane >> 4;
    const int t0 = c * 64; const bool hp = (c % CPB) != 0;
    bf16* PR = (bf16*)(a.ws + WS_PROJ);
    bf16x8 yf[4][2];
#pragma unroll
    for (int ks = 0; ks < 2; ++ks) {
        const int i0 = h * 64 + 32 * ks + 8 * lq; float cw[4][8], cb[8];
#pragma unroll
        for (int v = 0; v < 4; ++v) { const f32x4 w0 = *(const GAS f32x4*)(a.in[I_LCW] + (size_t)(l * 4 + v) * 512 + i0), w1 = *(const GAS f32x4*)(a.in[I_LCW] + (size_t)(l * 4 + v) * 512 + i0 + 4);
            cw[v][0] = w0[0]; cw[v][1] = w0[1]; cw[v][2] = w0[2]; cw[v][3] = w0[3]; cw[v][4] = w1[0]; cw[v][5] = w1[1]; cw[v][6] = w1[2]; cw[v][7] = w1[3]; }
        { const f32x4 b0 = *(const GAS f32x4*)(a.in[I_LCB] + l * 512 + i0), b1 = *(const GAS f32x4*)(a.in[I_LCB] + l * 512 + i0 + 4);
          cb[0] = b0[0]; cb[1] = b0[1]; cb[2] = b0[2]; cb[3] = b0[3]; cb[4] = b1[0]; cb[5] = b1[1]; cb[6] = b1[2]; cb[7] = b1[3]; }
#pragma unroll
        for (int mt = 0; mt < 4; ++mt) { const int t = 16 * mt + l15; float u[8];
#pragma unroll
            for (int q = 0; q < 8; ++q) u[q] = cb[q];
#pragma unroll
            for (int v = 0; v < 4; ++v) { const int tt = t - 3 + v; const int row = (t0 + tt) < 0 ? 0 : (t0 + tt);
                v4u raw = *(const GAS v4u*)(PR + (size_t)row * PJ + A_X + i0);
                if (!(tt >= 0 || hp)) raw = (v4u){0u, 0u, 0u, 0u};
                u[0] += cw[v][0] * bflo(raw.x); u[1] += cw[v][1] * bfhi(raw.x); u[2] += cw[v][2] * bflo(raw.y); u[3] += cw[v][3] * bfhi(raw.y);
                u[4] += cw[v][4] * bflo(raw.z); u[5] += cw[v][5] * bfhi(raw.z); u[6] += cw[v][6] * bflo(raw.w); u[7] += cw[v][7] * bfhi(raw.w); }
            v4u pk; pk.x = pk2(u[0], u[1]); pk.y = pk2(u[2], u[3]); pk.z = pk2(u[4], u[5]); pk.w = pk2(u[6], u[7]); yf[mt][ks] = __builtin_bit_cast(bf16x8, pk); }
    }
    if (conv_only) {
#pragma unroll
        for (int mt = 0; mt < 4; ++mt) { asm volatile("" :: "v"(yf[mt][0]), "v"(yf[mt][1])); }
        return; }
    const bf16* WRt = (const bf16*)(a.ws + WS_LRW) + (size_t)((l * 2 + 0) * 8 + h) * 4096; const bf16* WIt = (const bf16*)(a.ws + WS_LRW) + (size_t)((l * 2 + 1) * 8 + h) * 4096;
#define LRU_LOADS(J, XR, XI, BR, BI, LL) do { const int ch0_ = h * 64 + 16 * (J) + 4 * lq; \
        _Pragma("unroll") for (int ks = 0; ks < 2; ++ks) { XR[ks] = *(const GAS bf16x8*)(WRt + (size_t)(16 * (J) + l15) * 64 + 32 * ks + 8 * lq); XI[ks] = *(const GAS bf16x8*)(WIt + (size_t)(16 * (J) + l15) * 64 + 32 * ks + 8 * lq); } \
        BR = *(const GAS f32x4*)(a.in[I_LBR] + l * 512 + ch0_); BI = *(const GAS f32x4*)(a.in[I_LBI] + l * 512 + ch0_); LL = *(const GAS f32x4*)(a.in[I_LL] + l * 512 + ch0_); \
        } while (0)
    bf16x8 cxr[2], cxi[2], nxr[2], nxi[2]; f32x4 br4, bi4, ll4, nbr, nbi, nll;
    LRU_LOADS(0, cxr, cxi, br4, bi4, ll4);
#pragma unroll 1
    for (int jt = 0; jt < 4; ++jt) {
        const int jn = jt < 3 ? jt + 1 : 3;
        LRU_LOADS(jn, nxr, nxi, nbr, nbi, nll);
        const int ch0 = h * 64 + 16 * jt + 4 * lq;
        f32x4 hin4 = (f32x4){0.f, 0.f, 0.f, 0.f}; v2u czv[4];
#pragma unroll
        for (int mt = 0; mt < 4; ++mt) czv[mt] = (v2u){0u, 0u};
        if (fin) { hin4 = *(const GAS f32x4*)((const float*)(a.ws + WS_LRUH) + (size_t)c * 512 + ch0);
#pragma unroll
            for (int mt = 0; mt < 4; ++mt) czv[mt] = *(const GAS v2u*)(PR + (size_t)(t0 + 16 * mt + l15) * PJ + A_Z + ch0); }
        PIN_MEM();
        f32x4 ar[4], ai[4], au[4];
#pragma unroll
        for (int mt = 0; mt < 4; ++mt) { ar[mt] = (f32x4){0.f, 0.f, 0.f, 0.f}; ai[mt] = ar[mt]; au[mt] = ar[mt]; }
#pragma unroll
        for (int ks = 0; ks < 2; ++ks) {
            bf16x8 xu = (bf16x8){0, 0, 0, 0, 0, 0, 0, 0};
#pragma unroll
            for (int e = 0; e < 8; ++e) xu[e] = (32 * ks + 8 * lq + e == 16 * jt + l15) ? (short)0x3F80 : (short)0;
#pragma unroll
            for (int mt = 0; mt < 4; ++mt) { ar[mt] = mfma32(cxr[ks], yf[mt][ks], ar[mt]); ai[mt] = mfma32(cxi[ks], yf[mt][ks], ai[mt]); au[mt] = mfma32(xu, yf[mt][ks], au[mt]); }
        }
        float hv[4][4]; unsigned cpk[4][4];
#pragma unroll
        for (int r = 0; r < 4; ++r) {
            const float sp = softplus(-ll4[r]); float A[4], B[4];
#pragma unroll
            for (int mt = 0; mt < 4; ++mt) { const float rg = sigm(ar[mt][r] + br4[r]), ig = sigm(ai[mt][r] + bi4[r]); const float la = -8.0f * rg * sp;
                A[mt] = fexp(la); B[mt] = fsqrt(neg_expm1(2.0f * la)) * ig * au[mt][r]; }
#pragma unroll
            for (int mt = 0; mt < 4; ++mt) { LRU_SCAN_STEP(0x111); LRU_SCAN_STEP(0x112); LRU_SCAN_STEP(0x114); LRU_SCAN_STEP(0x118); }
            float Ac = 1.0f, Bc = 0.0f;
#pragma unroll
            for (int mt = 0; mt < 4; ++mt) { B[mt] = A[mt] * Bc + B[mt]; A[mt] = A[mt] * Ac; Ac = __shfl(A[mt], (lane & 48) | 15); Bc = __shfl(B[mt], (lane & 48) | 15); }
            if (fin) {
#pragma unroll
                for (int mt = 0; mt < 4; ++mt) hv[mt][r] = B[mt] + A[mt] * hin4[r];
            } else {
#pragma unroll
                for (int mt = 0; mt < 4; ++mt) cpk[mt][r] = pk2(A[mt], B[mt]);
                if (l15 == 15) { float* E = (float*)(a.ws + WS_LRUE) + ((size_t)c * 512 + ch0 + r) * 2; E[0] = A[3]; E[1] = B[3]; }
            }
        }
        if (!fin) {
#pragma unroll
            for (int mt = 0; mt < 4; ++mt) { v4u o; o.x = cpk[mt][0]; o.y = cpk[mt][1]; o.z = cpk[mt][2]; o.w = cpk[mt][3];
                *(GAS v4u*)((unsigned*)a.out + (size_t)8388608 + (size_t)(t0 + 16 * mt + l15) * 512 + ch0) = o; }
        }
        if (fin) {
#pragma unroll
            for (int mt = 0; mt < 4; ++mt) { GAS v2u* zp = (GAS v2u*)(PR + (size_t)(t0 + 16 * mt + l15) * PJ + A_Z + ch0); const v2u zv = czv[mt];
                v2u o; o.x = pk2(hv[mt][0] * silu(bflo(zv.x)), hv[mt][1] * silu(bfhi(zv.x))); o.y = pk2(hv[mt][2] * silu(bflo(zv.y)), hv[mt][3] * silu(bfhi(zv.y))); if (dry) asm volatile("" :: "v"(o.x), "v"(o.y)); else *zp = o; }
        }
#pragma unroll
        for (int ks = 0; ks < 2; ++ks) { cxr[ks] = nxr[ks]; cxi[ks] = nxi[ks]; }
        br4 = nbr; bi4 = nbi; ll4 = nll;
    }
#undef LRU_LOADS
}

__device__ __forceinline__ void lru_out(const Args& a, int l, int c, bool dry = false) {
    const int tid = opaque_tid(), cg = tid & 63, tq = tid >> 6; const int t0 = c * 64;
    bf16* PR = (bf16*)(a.ws + WS_PROJ); const unsigned* LC = (const unsigned*)a.out + (size_t)8388608;
    const f32x4 h0 = *(const GAS f32x4*)((const float*)(a.ws + WS_LRUH) + (size_t)c * 512 + 8 * cg), h1 = *(const GAS f32x4*)((const float*)(a.ws + WS_LRUH) + (size_t)c * 512 + 8 * cg + 4);
    v4u p0[8], p1[8], zz[8];
#pragma unroll
    for (int i = 0; i < 8; ++i) { const size_t t = (size_t)(t0 + 8 * tq + i);
        p0[i] = *(const GAS v4u*)(LC + t * 512 + 8 * cg); p1[i] = *(const GAS v4u*)(LC + t * 512 + 8 * cg + 4); zz[i] = *(const GAS v4u*)(PR + t * PJ + A_Z + 8 * cg); }
    PIN_MEM();
#pragma unroll
    for (int i = 0; i < 8; ++i) { const size_t t = (size_t)(t0 + 8 * tq + i);
        const float y0 = (bfhi(p0[i].x) + bflo(p0[i].x) * h0[0]) * silu(bflo(zz[i].x)), y1 = (bfhi(p0[i].y) + bflo(p0[i].y) * h0[1]) * silu(bfhi(zz[i].x));
        const float y2 = (bfhi(p0[i].z) + bflo(p0[i].z) * h0[2]) * silu(bflo(zz[i].y)), y3 = (bfhi(p0[i].w) + bflo(p0[i].w) * h0[3]) * silu(bfhi(zz[i].y));
        const float y4 = (bfhi(p1[i].x) + bflo(p1[i].x) * h1[0]) * silu(bflo(zz[i].z)), y5 = (bfhi(p1[i].y) + bflo(p1[i].y) * h1[1]) * silu(bfhi(zz[i].z));
        const float y6 = (bfhi(p1[i].z) + bflo(p1[i].z) * h1[2]) * silu(bflo(zz[i].w)), y7 = (bfhi(p1[i].w) + bflo(p1[i].w) * h1[3]) * silu(bfhi(zz[i].w));
        v4u o; o.x = pk2(y0, y1); o.y = pk2(y2, y3); o.z = pk2(y4, y5); o.w = pk2(y6, y7);
        if (dry) asm volatile("" :: "v"(o.x), "v"(o.y), "v"(o.z), "v"(o.w)); else *(GAS v4u*)(PR + t * PJ + A_Z + 8 * cg) = o; }
}

constexpr int UBP = 520;
__device__ __forceinline__ void s5_local(const Args& a, int l, int c) {
    const int tid = opaque_tid(), lane = tid & 63, w = __builtin_amdgcn_readfirstlane(tid >> 6), l15 = lane & 15, lq = lane >> 4;
    const int t0 = c * 64;
    const bf16* PR = (const bf16*)(a.ws + WS_PROJ);
    const unsigned char* tb = a.ws + WS_S5T + (size_t)l * S5T_LAYER;
    const bf16* BC = (const bf16*)(tb + S5T_BC); const f32x2* PW = (const f32x2*)(tb + S5T_PW);
    f32x2* ST = (f32x2*)(a.ws + WS_S5ST) + (size_t)c * 2048;
#pragma unroll 2
    for (int k = 0; k < 4; ++k) {
        const int g = 4 * w + k; bf16x4 yf[4], xr[4], xi[4]; f32x2 wb[4][4], st[4][4];
#pragma unroll
        for (int nt = 0; nt < 4; ++nt) yf[nt] = *(const GAS bf16x4*)(PR + (size_t)(t0 + 16 * nt + l15) * PJ + B_U + g * 16 + 4 * lq);
#pragma unroll
        for (int mt = 0; mt < 4; ++mt) { xr[mt] = *(const GAS bf16x4*)(BC + ((size_t)g * 128 + 16 * mt + l15) * 16 + 4 * lq); xi[mt] = *(const GAS bf16x4*)(BC + ((size_t)g * 128 + 64 + 16 * mt + l15) * 16 + 4 * lq);
#pragma unroll
            for (int r = 0; r < 4; ++r) { const int n = 16 * mt + 4 * lq + r; wb[mt][r] = PW[(g * 64 + n) * 17 + (15 - l15)]; st[mt][r] = PW[(g * 64 + n) * 17 + 16]; } }
        PIN_MEM();
#pragma unroll
        for (int mt = 0; mt < 4; ++mt) {
            f32x4 ar[4], ai[4];
#pragma unroll
            for (int nt = 0; nt < 4; ++nt) { ar[nt] = mfma16(xr[mt], yf[nt], (f32x4){0.f, 0.f, 0.f, 0.f}); ai[nt] = mfma16(xi[mt], yf[nt], (f32x4){0.f, 0.f, 0.f, 0.f}); }
#pragma unroll
            for (int r = 0; r < 4; ++r) {
                const int n = 16 * mt + 4 * lq + r; const f32x2 s16 = st[mt][r];
                float er = 0.f, ei = 0.f, wr = wb[mt][r].x, wi = wb[mt][r].y;
#pragma unroll
                for (int nt = 3; nt >= 0; --nt) { const float br = ar[nt][r], bi = ai[nt][r]; er += wr * br - wi * bi; ei += wr * bi + wi * br;
                    const float nwr = wr * s16.x - wi * s16.y, nwi = wr * s16.y + wi * s16.x; wr = nwr; wi = nwi; }
                er += dppf<0x111>(0.f, er); ei += dppf<0x111>(0.f, ei); er += dppf<0x112>(0.f, er); ei += dppf<0x112>(0.f, ei);
                er += dppf<0x114>(0.f, er); ei += dppf<0x114>(0.f, ei); er += dppf<0x118>(0.f, er); ei += dppf<0x118>(0.f, ei);
                if (l15 == 15) { const f32x2 v = {er, ei}; ST[g * 64 + n] = v; }
            }
        }
    }
}
__device__ __forceinline__ void s5_out(const Args& a, int l, int c, LAS unsigned char* lds, bool dry = false) {
    const int tid = opaque_tid(), lane = tid & 63, w = __builtin_amdgcn_readfirstlane(tid >> 6), l15 = lane & 15, lq = lane >> 4;
    const int t0 = c * 64;
    LAS bf16* ub = (LAS bf16*)lds;
    bf16* PR = (bf16*)(a.ws + WS_PROJ);
    { v4u ut[8];
#pragma unroll
      for (int i = 0; i < 8; ++i) { const int idx = tid + NTHR * i, row = idx >> 6, c8 = idx & 63; ut[i] = *(const GAS v4u*)(PR + (size_t)(t0 + row) * PJ + B_U + c8 * 8); }
      PIN_MEM();
      for (int idx = tid; idx < 16 * 65; idx += NTHR) { const int row = idx / 65, c8 = idx % 65; *(LAS v4u*)(ub + row * UBP + c8 * 8) = (v4u){0u, 0u, 0u, 0u}; }
#pragma unroll
      for (int i = 0; i < 8; ++i) { const int idx = tid + NTHR * i, row = idx >> 6, c8 = idx & 63; *(LAS v4u*)(ub + (16 + row) * UBP + c8 * 8) = ut[i]; } }
    __syncthreads();
    const unsigned char* tb = a.ws + WS_S5T + (size_t)l * S5T_LAYER;
    const bf16* KT = (const bf16*)(tb + S5T_KT); const bf16* CC = (const bf16*)(tb + S5T_CC); const f32x2* PW = (const f32x2*)(tb + S5T_PW);
    const f32x2* ST = (const f32x2*)(a.ws + WS_S5ST) + (size_t)c * 2048;
#define S5_KLOAD(dst, kb) do { _Pragma("unroll") for (int k8 = 0; k8 < 8; ++k8) dst[k8] = *(const GAS bf16x8*)(kp + (size_t)(2 * ((kb) * 8 + k8)) * 256); } while (0)
#define S5_KMMA(src, kb) do { _Pragma("unroll") for (int k8 = 0; k8 < 8; ++k8) { _Pragma("unroll") for (int it = (kb); it < 4; ++it) { \
        const bf16x8 yf = *(const LAS bf16x8*)(up + (16 * it - 2 * ((kb) * 8 + k8)) * UBP); acc[it] = mfma32(src[k8], yf, acc[it]); } } } while (0)
#pragma unroll 1
    for (int k = 0; k < 4; ++k) {
        const int g = 4 * w + k; f32x4 acc[4];
#pragma unroll
        for (int it = 0; it < 4; ++it) acc[it] = (f32x4){0.f, 0.f, 0.f, 0.f};
        const bf16* kp = KT + ((size_t)(g * 64 + (lq >> 1)) * 16 + l15) * 16 + 8 * (lq & 1);
        const LAS bf16* up = ub + (16 + l15 - (lq >> 1)) * UBP + g * 16 + 8 * (lq & 1);
        bf16x8 ka[8], kc[8];
        S5_KLOAD(ka, 0); S5_KLOAD(kc, 1); PIN_MEM();
        S5_KMMA(ka, 0);
        S5_KLOAD(ka, 2); PIN_MEM();
        S5_KMMA(kc, 1);
        bf16x8 xfc[4]; f32x2 pb[4][4], ps[4][4], sv[4][4];
        S5_KLOAD(kc, 3);
#pragma unroll
        for (int ks2 = 0; ks2 < 4; ++ks2) { xfc[ks2] = *(const GAS bf16x8*)(CC + ((size_t)g * 16 + l15) * 128 + 32 * ks2 + 8 * lq);
#pragma unroll
            for (int m = 0; m < 4; ++m) { const int n = 16 * ks2 + 4 * lq + m; pb[ks2][m] = PW[(g * 64 + n) * 17 + l15 + 1]; ps[ks2][m] = PW[(g * 64 + n) * 17 + 16]; sv[ks2][m] = ST[g * 64 + n]; } }
        const f32x4 dsk = *(const GAS f32x4*)(a.in[I_SD] + l * 512 + g * 16 + 4 * lq);
        PIN_MEM();
        S5_KMMA(ka, 2);
        S5_KMMA(kc, 3);
#pragma unroll
        for (int ks2 = 0; ks2 < 4; ++ks2) {
            float pr[4], pi[4];
#pragma unroll
            for (int m = 0; m < 4; ++m) { pr[m] = pb[ks2][m].x; pi[m] = pb[ks2][m].y; }
#pragma unroll
            for (int it = 0; it < 4; ++it) {
                v4u zz; unsigned zw[4];
#pragma unroll
                for (int m = 0; m < 4; ++m) { const float sr = sv[ks2][m].x, si = sv[ks2][m].y, qr = ps[ks2][m].x, qi = ps[ks2][m].y;
                    const float zr = pr[m] * sr - pi[m] * si, zi = pr[m] * si + pi[m] * sr; zw[m] = pk2(zr, zi);
                    const float nr = pr[m] * qr - pi[m] * qi, ni = pr[m] * qi + pi[m] * qr; pr[m] = nr; pi[m] = ni; }
                zz.x = zw[0]; zz.y = zw[1]; zz.z = zw[2]; zz.w = zw[3];
                acc[it] = mfma32(xfc[ks2], __builtin_bit_cast(bf16x8, zz), acc[it]);
            }
        }
#pragma unroll
        for (int it = 0; it < 4; ++it) { LAS v2u* p = (LAS v2u*)(ub + (16 + 16 * it + l15) * UBP + g * 16 + 4 * lq); const v2u uv = *p;
            const float y0 = gelu_tanh(acc[it][0] + dsk[0] * bflo(uv.x)), y1 = gelu_tanh(acc[it][1] + dsk[1] * bfhi(uv.x)), y2 = gelu_tanh(acc[it][2] + dsk[2] * bflo(uv.y)), y3 = gelu_tanh(acc[it][3] + dsk[3] * bfhi(uv.y));
            v2u o; o.x = pk2(y0, y1); o.y = pk2(y2, y3); *p = o; }
    }
#undef S5_KLOAD
#undef S5_KMMA
    {
        f32x4 acc[4][4]; v2u zv[4][4]; f32x4 gb[4];
        const bf16* wp = (const bf16*)(a.ws + WS_GLUT) + (size_t)l * 512 * 512 + (size_t)(64 * w + l15) * 512 + 8 * lq;
        bf16x8 xa[4], xb[4];
#pragma unroll
        for (int jt = 0; jt < 4; ++jt) { xa[jt] = *(const GAS bf16x8*)(wp + (size_t)(16 * jt) * 512); gb[jt] = *(const GAS f32x4*)(a.in[I_SGB] + l * 512 + 64 * w + 16 * jt + 4 * lq);
#pragma unroll
            for (int tt = 0; tt < 4; ++tt) { zv[jt][tt] = *(const GAS v2u*)(PR + (size_t)(t0 + 16 * tt + l15) * PJ + B_Z + 64 * w + 16 * jt + 4 * lq); acc[jt][tt] = (f32x4){0.f, 0.f, 0.f, 0.f}; } }
        PIN_MEM();
        __syncthreads();
        const LAS bf16* yp = ub + (16 + l15) * UBP + 8 * lq;
#define S5_GMMA(xf, ks) do { bf16x8 yf[4]; _Pragma("unroll") for (int tt = 0; tt < 4; ++tt) yf[tt] = *(const LAS bf16x8*)(yp + (16 * tt) * UBP + 32 * (ks)); \
        _Pragma("unroll") for (int jt = 0; jt < 4; ++jt) _Pragma("unroll") for (int tt = 0; tt < 4; ++tt) acc[jt][tt] = mfma32(xf[jt], yf[tt], acc[jt][tt]); } while (0)
#pragma unroll 1
        for (int k2 = 0; k2 < 8; ++k2) {
#pragma unroll
            for (int jt = 0; jt < 4; ++jt) xb[jt] = *(const GAS bf16x8*)(wp + (size_t)(16 * jt) * 512 + 32 * (2 * k2 + 1));
            PIN_MEM();
            S5_GMMA(xa, 2 * k2);
            const int kn = k2 < 7 ? 2 * k2 + 2 : 15;
#pragma unroll
            for (int jt = 0; jt < 4; ++jt) xa[jt] = *(const GAS bf16x8*)(wp + (size_t)(16 * jt) * 512 + 32 * kn);
            PIN_MEM();
            S5_GMMA(xb, 2 * k2 + 1);
        }
#undef S5_GMMA
#pragma unroll
        for (int jt = 0; jt < 4; ++jt) { const int j0 = 64 * w + 16 * jt + 4 * lq;
#pragma unroll
            for (int tt = 0; tt < 4; ++tt) { const int t = 16 * tt + l15; const v2u yv = *(const LAS v2u*)(ub + (16 + t) * UBP + j0);
                GAS v2u* zp = (GAS v2u*)(PR + (size_t)(t0 + t) * PJ + B_Z + j0); const v2u zz = zv[jt][tt];
                const float o0 = bflo(yv.x) * sigm(acc[jt][tt][0] + gb[jt][0]) * silu(bflo(zz.x)), o1 = bfhi(yv.x) * sigm(acc[jt][tt][1] + gb[jt][1]) * silu(bfhi(zz.x));
                const float o2 = bflo(yv.y) * sigm(acc[jt][tt][2] + gb[jt][2]) * silu(bflo(zz.y)), o3 = bfhi(yv.y) * sigm(acc[jt][tt][3] + gb[jt][3]) * silu(bfhi(zz.y));
                v2u o; o.x = pk2(o0, o1); o.y = pk2(o2, o3); if (dry) asm volatile("" :: "v"(o.x), "v"(o.y)); else *zp = o; } }
    }
    __syncthreads();
}

__device__ __forceinline__ void s5_chunk(const Args& a, int l, int c, bool fin, LAS unsigned char* lds, bool dry = false) { if (fin) s5_out(a, l, c, lds, dry); else s5_local(a, l, c); }

constexpr int QP = 264, VPF = 520, SPP = 72;
constexpr int GLA_QD = 0, GLA_KI = 33792, GLA_VV = 67584, GLA_SS = 134144, GLA_GT = 134144, GLA_GLW = 136192;
__device__ __forceinline__ void gla_chunk(const Args& a, int l, int c, bool fin, LAS unsigned char* lds, bool dry = false) {
    const int tid = opaque_tid(), lane = tid & 63, w = __builtin_amdgcn_readfirstlane(tid >> 6), l15 = lane & 15, lq = lane >> 4; const int t0 = c * 64;
    LAS bf16* QD = (LAS bf16*)(lds + GLA_QD); LAS bf16* KI = (LAS bf16*)(lds + GLA_KI); LAS bf16* VV = (LAS bf16*)(lds + GLA_VV); LAS bf16* SS = (LAS bf16*)(lds + GLA_SS);
    LAS float* GT = (LAS float*)(lds + GLA_GT); LAS float* GLW = (LAS float*)(lds + GLA_GLW);
    bf16* PR = (bf16*)(a.ws + WS_PROJ); const float* EX = (const float*)(a.ws + WS_EX);
    bf16* KV = (bf16*)(a.ws + WS_GLA) + (size_t)c * 32768;
    const int d = tid & 255, half = tid >> 8; float g[32]; unsigned short kraw[32], qraw[32];
    { float wg[16]; v4u vt[8];
      const f32x2 glr = *(const GAS f32x2*)(EX + (size_t)(t0 + (tid >> 3)) * 32 + 2 * (tid & 7));
#pragma unroll
      for (int r = 0; r < 16; ++r) wg[r] = a.in[I_GWG][(size_t)(l * 16 + r) * 256 + d];
      const float bg = a.in[I_GBG][l * 256 + d];
#pragma unroll
      for (int i = 0; i < 8; ++i) { const int idx = tid + NTHR * i, row = idx >> 6, c8 = idx & 63; vt[i] = *(const GAS v4u*)(PR + (size_t)(t0 + row) * PJ + C_V + c8 * 8); }
#pragma unroll
      for (int tt = 0; tt < 32; ++tt) { kraw[tt] = PR[(size_t)(t0 + 32 * half + tt) * PJ + C_K + d]; qraw[tt] = PR[(size_t)(t0 + 32 * half + tt) * PJ + C_Q + d]; }
      PIN_MEM();
      *(LAS f32x2*)(GLW + (tid >> 3) * 16 + 2 * (tid & 7)) = glr;
#pragma unroll
      for (int i = 0; i < 8; ++i) { const int idx = tid + NTHR * i, row = idx >> 6, c8 = idx & 63; *(LAS v4u*)(VV + row * VPF + c8 * 8) = vt[i]; }
      __syncthreads();
      float run = 0.f;
#pragma unroll
      for (int tt = 0; tt < 32; ++tt) { const LAS f32x4* gl = (const LAS f32x4*)(GLW + (32 * half + tt) * 16); const f32x4 g0 = gl[0], g1 = gl[1], g2 = gl[2], g3 = gl[3];
          float lg = bg + ((g0[0] * wg[0] + g0[1] * wg[1]) + (g0[2] * wg[2] + g0[3] * wg[3])) + ((g1[0] * wg[4] + g1[1] * wg[5]) + (g1[2] * wg[6] + g1[3] * wg[7]))
                        + ((g2[0] * wg[8] + g2[1] * wg[9]) + (g2[2] * wg[10] + g2[3] * wg[11])) + ((g3[0] * wg[12] + g3[1] * wg[13]) + (g3[2] * wg[14] + g3[3] * wg[15]));
          run += -softplus(-lg) * (1.0f / 16.0f); g[tt] = run; }
      GT[half * 256 + d] = run; }
    __syncthreads();
    { const float tot0 = GT[d], tot1 = GT[256 + d], off = half ? tot0 : 0.f, glast = tot0 + tot1;
      const float kofs = fin ? 0.f : glast;
#pragma unroll
      for (int tt = 0; tt < 32; ++tt) { const int t = 32 * half + tt; const float gc = g[tt] + off; const float kx = bf2f(kraw[tt]), qx = bf2f(qraw[tt]);
          QD[t * QP + d] = (bf16)f2bf(qx * 0.125f * fexp(gc)); KI[t * QP + d] = (bf16)f2bf(kx * fexp(kofs - gc)); }
      if (!fin && half == 0) ((float*)(a.ws + WS_GDEC))[(size_t)c * 256 + d] = fexp(glast); }
    __syncthreads();
    if (!fin) {
        const int h = w >> 1, eh = w & 1; f32x4 acc[4][4];
#pragma unroll
        for (int dt = 0; dt < 4; ++dt)
#pragma unroll
            for (int et = 0; et < 4; ++et) acc[dt][et] = (f32x4){0.f, 0.f, 0.f, 0.f};
#pragma unroll
        for (int ks = 0; ks < 2; ++ks) { bf16x8 xf[4], yf[4];
#pragma unroll
            for (int dt = 0; dt < 4; ++dt) xf[dt] = tr_frag(KI + (32 * ks + 8 * lq + (l15 >> 2)) * QP + h * 64 + 16 * dt + 4 * (l15 & 3), QP);
#pragma unroll
            for (int et = 0; et < 4; ++et) yf[et] = tr_frag(VV + (32 * ks + 8 * lq + (l15 >> 2)) * VPF + h * 128 + 64 * eh + 16 * et + 4 * (l15 & 3), VPF);
#pragma unroll
            for (int dt = 0; dt < 4; ++dt)
#pragma unroll
                for (int et = 0; et < 4; ++et) acc[dt][et] = mfma32(xf[dt], yf[et], acc[dt][et]); }
#pragma unroll
        for (int dt = 0; dt < 4; ++dt)
#pragma unroll
            for (int et = 0; et < 4; ++et) { v2u o; o.x = pk2(acc[dt][et][0], acc[dt][et][1]); o.y = pk2(acc[dt][et][2], acc[dt][et][3]);
                *(GAS v2u*)(KV + ((size_t)h * 128 + 64 * eh + 16 * et + l15) * 64 + 16 * dt + 4 * lq) = o; }
    } else {
#pragma unroll 1
        for (int rd = 0; rd < 2; ++rd) {
            const int hl = w >> 2, it = w & 3, h = 2 * rd + hl, i = 16 * it + l15; LAS bf16* SSw = SS + w * 16 * SPP;
            bf16x8 pf[2][8]; v2u zv[8]; f32x4 nw[8];
#pragma unroll
            for (int ks = 0; ks < 2; ++ks)
#pragma unroll
                for (int et = 0; et < 8; ++et) pf[ks][et] = *(const GAS bf16x8*)(KV + ((size_t)h * 128 + 16 * et + l15) * 64 + 32 * ks + 8 * lq);
#pragma unroll
            for (int et = 0; et < 8; ++et) { zv[et] = *(const GAS v2u*)(PR + (size_t)(t0 + i) * PJ + C_Z + h * 128 + 16 * et + 4 * lq); nw[et] = *(const GAS f32x4*)(a.in[I_GNW] + l * 128 + 16 * et + 4 * lq); }
            PIN_MEM();
#pragma unroll
            for (int jt = 0; jt < 4; ++jt) { v2u o = (v2u){0u, 0u};
                if (jt <= it) { f32x4 s = (f32x4){0.f, 0.f, 0.f, 0.f};
#pragma unroll
                    for (int ks = 0; ks < 2; ++ks) { const bf16x8 xf = *(const LAS bf16x8*)(KI + (16 * jt + l15) * QP + h * 64 + 32 * ks + 8 * lq), yf = *(const LAS bf16x8*)(QD + (16 * it + l15) * QP + h * 64 + 32 * ks + 8 * lq);
                        s = mfma32(xf, yf, s); }
                    const int j0 = 16 * jt + 4 * lq;
                    o.x = pk2(j0 <= i ? s[0] : 0.f, j0 + 1 <= i ? s[1] : 0.f); o.y = pk2(j0 + 2 <= i ? s[2] : 0.f, j0 + 3 <= i ? s[3] : 0.f); }
                *(LAS v2u*)(SSw + l15 * SPP + 16 * jt + 4 * lq) = o; }
            f32x4 oa[8];
#pragma unroll
            for (int et = 0; et < 8; ++et) oa[et] = (f32x4){0.f, 0.f, 0.f, 0.f};
#pragma unroll
            for (int ks = 0; ks < 2; ++ks) { if (32 * ks <= 16 * it + 15) { const bf16x8 yf = *(const LAS bf16x8*)(SSw + l15 * SPP + 32 * ks + 8 * lq);
#pragma unroll
                for (int et = 0; et < 8; ++et) { const bf16x8 xf = tr_frag(VV + (32 * ks + 8 * lq + (l15 >> 2)) * VPF + h * 128 + 16 * et + 4 * (l15 & 3), VPF); oa[et] = mfma32(xf, yf, oa[et]); } } }
#pragma unroll
            for (int ks = 0; ks < 2; ++ks) { const bf16x8 yf = *(const LAS bf16x8*)(QD + (16 * it + l15) * QP + h * 64 + 32 * ks + 8 * lq);
#pragma unroll
                for (int et = 0; et < 8; ++et) oa[et] = mfma32(pf[ks][et], yf, oa[et]); }
            float ss = 0.f;
#pragma unroll
            for (int et = 0; et < 8; ++et) ss += (oa[et][0] * oa[et][0] + oa[et][1] * oa[et][1]) + (oa[et][2] * oa[et][2] + oa[et][3] * oa[et][3]);
            ss += __shfl_xor(ss, 16); ss += __shfl_xor(ss, 32);
            const float rstd = frsq(ss * (1.0f / 128.0f) + EPS);
#pragma unroll
            for (int et = 0; et < 8; ++et) { GAS v2u* zp = (GAS v2u*)(PR + (size_t)(t0 + i) * PJ + C_Z + h * 128 + 16 * et + 4 * lq);
                v2u o; o.x = pk2(oa[et][0] * rstd * nw[et][0] * silu(bflo(zv[et].x)), oa[et][1] * rstd * nw[et][1] * silu(bfhi(zv[et].x)));
                o.y = pk2(oa[et][2] * rstd * nw[et][2] * silu(bflo(zv[et].y)), oa[et][3] * rstd * nw[et][3] * silu(bfhi(zv[et].y)));
                if (dry) asm volatile("" :: "v"(o.x), "v"(o.y)); else *zp = o; }
        }
    }
    __syncthreads();
}

constexpr int XSP = 520, BMP = 264, MP = 72;
constexpr int SSD_XS = 0, SSD_CM = 66560, SSD_BM = 100352, SSD_M = 100352, SSD_DT = 137216, SSD_AC = 139264, SSD_SQ = 141312;
__device__ __forceinline__ void ssd_chunk(const Args& a, int l, int c, bool fin, LAS unsigned char* lds, bool dry = false) {
    const int tid = opaque_tid(), lane = tid & 63, w = __builtin_amdgcn_readfirstlane(tid >> 6), l15 = lane & 15, lq = lane >> 4; const int t0 = c * 64;
    const bool hp = (c % CPB) != 0;
    LAS bf16* XS = (LAS bf16*)(lds + SSD_XS); LAS bf16* CM = (LAS bf16*)(lds + SSD_CM); LAS bf16* BM = (LAS bf16*)(lds + SSD_BM); LAS bf16* MM = (LAS bf16*)(lds + SSD_M);
    LAS float* dtl = (LAS float*)(lds + SSD_DT); LAS float* acl = (LAS float*)(lds + SSD_AC); LAS float* ssq = (LAS float*)(lds + SSD_SQ);
    bf16* PR = (bf16*)(a.ws + WS_PROJ); const float* EX = (const float*)(a.ws + WS_EX);
    bf16* STT = (bf16*)(a.ws + WS_SSD) + (size_t)c * 65536;
    { const int h = w; const float bias = a.in[I_DDTB][l * 8 + h], av = -expf(a.in[I_DALOG][l * 8 + h]);
      const float dt = softplus(EX[(size_t)(t0 + lane) * 32 + 16 + h] + bias); float cum = dt * av;
#pragma unroll
      for (int off = 1; off < 64; off <<= 1) { const float pv = __shfl_up(cum, off); if (lane >= off) cum += pv; }
      dtl[lane * 8 + h] = dt; acl[lane * 8 + h] = cum; }
    __syncthreads();
    { const int cg = tid & 127, seg = tid >> 7; int mycol, wch, pitch; LAS bf16* dst;
      if (cg < 64) { mycol = D_XS + 8 * cg; wch = 8 * cg; dst = XS + 8 * cg; pitch = XSP; }
      else if (cg < 96) { mycol = D_BM + 8 * (cg - 64); wch = 512 + 8 * (cg - 64); dst = BM + 8 * (cg - 64); pitch = BMP; }
      else { mycol = D_CM + 8 * (cg - 96); wch = 768 + 8 * (cg - 96); dst = CM + 8 * (cg - 96); pitch = BMP; }
      if (fin || cg < 96) {
          float wgt[4][8], cb[8];
          const float* cw = a.in[I_DCW] + (size_t)l * 4 * 1024 + wch;
#pragma unroll
          for (int v = 0; v < 4; ++v) { const f32x4 w0 = *(const GAS f32x4*)(cw + v * 1024), w1 = *(const GAS f32x4*)(cw + v * 1024 + 4);
              wgt[v][0] = w0[0]; wgt[v][1] = w0[1]; wgt[v][2] = w0[2]; wgt[v][3] = w0[3]; wgt[v][4] = w1[0]; wgt[v][5] = w1[1]; wgt[v][6] = w1[2]; wgt[v][7] = w1[3]; }
          { const f32x4 b0 = *(const GAS f32x4*)(a.in[I_DCB] + l * 1024 + wch), b1 = *(const GAS f32x4*)(a.in[I_DCB] + l * 1024 + wch + 4);
            cb[0] = b0[0]; cb[1] = b0[1]; cb[2] = b0[2]; cb[3] = b0[3]; cb[4] = b1[0]; cb[5] = b1[1]; cb[6] = b1[2]; cb[7] = b1[3]; }
          const int hh = cg >> 3; const float aL = acl[63 * 8 + (hh & 7)];
          v4u raws[19];
#pragma unroll
          for (int r = 0; r < 19; ++r) { const int t = 16 * seg - 3 + r; const int row = (t0 + t) < 0 ? 0 : (t0 + t); raws[r] = *(const GAS v4u*)(PR + (size_t)row * PJ + mycol); }
          PIN_MEM();
          float x3[8], x2[8], x1[8];
#pragma unroll
          for (int q = 0; q < 8; ++q) { x3[q] = 0.f; x2[q] = 0.f; x1[q] = 0.f; }
#pragma unroll
          for (int r = 0; r < 19; ++r) {
              const int t = 16 * seg - 3 + r; v4u raw = raws[r];
              if (!(t >= 0 || hp)) raw = (v4u){0u, 0u, 0u, 0u};
              float x0[8]; x0[0] = bflo(raw.x); x0[1] = bfhi(raw.x); x0[2] = bflo(raw.y); x0[3] = bfhi(raw.y); x0[4] = bflo(raw.z); x0[5] = bfhi(raw.z); x0[6] = bflo(raw.w); x0[7] = bfhi(raw.w);
              if (r >= 3) {
                  float sc = 1.0f; if (!fin && cg < 64) sc = fexp(aL - acl[t * 8 + hh]) * dtl[t * 8 + hh];
                  float o[8];
#pragma unroll
                  for (int q = 0; q < 8; ++q) o[q] = silu(cb[q] + wgt[0][q] * x3[q] + wgt[1][q] * x2[q] + wgt[2][q] * x1[q] + wgt[3][q] * x0[q]) * sc;
                  v4u pk; pk.x = pk2(o[0], o[1]); pk.y = pk2(o[2], o[3]); pk.z = pk2(o[4], o[5]); pk.w = pk2(o[6], o[7]);
                  *(LAS v4u*)(dst + t * pitch) = pk;
              }
#pragma unroll
              for (int q = 0; q < 8; ++q) { x3[q] = x2[q]; x2[q] = x1[q]; x1[q] = x0[q]; }
          }
      } }
    __syncthreads();
    if (!fin) {
        const int h = w, g = h >> 2;
#pragma unroll 1
        for (int sh = 0; sh < 2; ++sh) {
            f32x4 acc[4][4];
#pragma unroll
            for (int st = 0; st < 4; ++st)
#pragma unroll
                for (int pt = 0; pt < 4; ++pt) acc[st][pt] = (f32x4){0.f, 0.f, 0.f, 0.f};
#pragma unroll
            for (int ks = 0; ks < 2; ++ks) {
                bf16x8 xf[4], yf[4];
#pragma unroll
                for (int st = 0; st < 4; ++st) xf[st] = tr_frag(BM + (32 * ks + 8 * lq + (l15 >> 2)) * BMP + g * 128 + 64 * sh + 16 * st + 4 * (l15 & 3), BMP);
#pragma unroll
                for (int pt = 0; pt < 4; ++pt) yf[pt] = tr_frag(XS + (32 * ks + 8 * lq + (l15 >> 2)) * XSP + h * 64 + 16 * pt + 4 * (l15 & 3), XSP);
#pragma unroll
                for (int st = 0; st < 4; ++st)
#pragma unroll
                    for (int pt = 0; pt < 4; ++pt) acc[st][pt] = mfma32(xf[st], yf[pt], acc[st][pt]);
            }
#pragma unroll
            for (int st = 0; st < 4; ++st)
#pragma unroll
                for (int pt = 0; pt < 4; ++pt) { v2u o; o.x = pk2(acc[st][pt][0], acc[st][pt][1]); o.y = pk2(acc[st][pt][2], acc[st][pt][3]);
                    *(GAS v2u*)(STT + ((size_t)h * 64 + 16 * pt + l15) * 128 + 64 * sh + 16 * st + 4 * lq) = o; }
        }
        if (lane == 0) ((float*)(a.ws + WS_SDEC))[(size_t)c * 8 + h] = fexp(acl[63 * 8 + h]);
    } else {
        const int gC = w >> 2, itC = w & 3; f32x4 cbt[4];
#pragma unroll
        for (int jt = 0; jt < 4; ++jt) cbt[jt] = (f32x4){0.f, 0.f, 0.f, 0.f};
#pragma unroll
        for (int ks = 0; ks < 4; ++ks) {
            const bf16x8 yf = *(const LAS bf16x8*)(CM + (16 * itC + l15) * BMP + gC * 128 + 32 * ks + 8 * lq);
#pragma unroll
            for (int jt = 0; jt < 4; ++jt) { const bf16x8 xf = *(const LAS bf16x8*)(BM + (16 * jt + l15) * BMP + gC * 128 + 32 * ks + 8 * lq); cbt[jt] = mfma32(xf, yf, cbt[jt]); }
        }
        __syncthreads();
        f32x4 yv[2][4][2];
#pragma unroll 1
        for (int rd = 0; rd < 2; ++rd) {
            bf16x8 pfr[4][4]; v2u zvr[2][4];
            { const int ms_ = w >> 1, half_ = w & 1, g_ = ms_ >> 1, h_ = g_ * 4 + 2 * rd + (ms_ & 1);
#pragma unroll
              for (int ks = 0; ks < 4; ++ks)
#pragma unroll
                  for (int pt = 0; pt < 4; ++pt) pfr[ks][pt] = *(const GAS bf16x8*)(STT + ((size_t)h_ * 64 + 16 * pt + l15) * 128 + 32 * ks + 8 * lq);
#pragma unroll
              for (int i2 = 0; i2 < 2; ++i2)
#pragma unroll
                  for (int pt = 0; pt < 4; ++pt) zvr[i2][pt] = *(const GAS v2u*)(PR + (size_t)(t0 + 16 * (2 * half_ + i2) + l15) * PJ + D_Z + h_ * 64 + 16 * pt + 4 * lq);
              PIN_MEM(); }
            { const int i = 16 * itC + l15;
#pragma unroll
              for (int hh = 0; hh < 2; ++hh) { const int h = gC * 4 + 2 * rd + hh; const float ai = acl[i * 8 + h];
#pragma unroll
                  for (int jt = 0; jt < 4; ++jt) { float mv[4];
#pragma unroll
                      for (int r = 0; r < 4; ++r) { const int j = 16 * jt + 4 * lq + r; mv[r] = (j <= i) ? cbt[jt][r] * fexp(ai - acl[j * 8 + h]) * dtl[j * 8 + h] : 0.f; }
                      v2u o; o.x = pk2(mv[0], mv[1]); o.y = pk2(mv[2], mv[3]); *(LAS v2u*)(MM + ((gC * 2 + hh) * 64 + i) * MP + 16 * jt + 4 * lq) = o; } } }
            __syncthreads();
            { const int ms = w >> 1, half = w & 1, g = ms >> 1, h = g * 4 + 2 * rd + (ms & 1);
              f32x4 a1[4][2], a2[4][2];
#pragma unroll
              for (int pt = 0; pt < 4; ++pt)
#pragma unroll
                  for (int i2 = 0; i2 < 2; ++i2) { a1[pt][i2] = (f32x4){0.f, 0.f, 0.f, 0.f}; a2[pt][i2] = (f32x4){0.f, 0.f, 0.f, 0.f}; }
#pragma unroll
              for (int ks = 0; ks < 2; ++ks) { if (ks <= half) {
                  bf16x8 xf[4];
#pragma unroll
                  for (int pt = 0; pt < 4; ++pt) xf[pt] = tr_frag(XS + (32 * ks + 8 * lq + (l15 >> 2)) * XSP + h * 64 + 16 * pt + 4 * (l15 & 3), XSP);
#pragma unroll
                  for (int i2 = 0; i2 < 2; ++i2) { const bf16x8 yf = *(const LAS bf16x8*)(MM + (ms * 64 + 16 * (2 * half + i2) + l15) * MP + 32 * ks + 8 * lq);
#pragma unroll
                      for (int pt = 0; pt < 4; ++pt) a1[pt][i2] = mfma32(xf[pt], yf, a1[pt][i2]); } } }
#pragma unroll
              for (int ks = 0; ks < 4; ++ks) {
#pragma unroll
                  for (int i2 = 0; i2 < 2; ++i2) { const bf16x8 yf = *(const LAS bf16x8*)(CM + (16 * (2 * half + i2) + l15) * BMP + g * 128 + 32 * ks + 8 * lq);
#pragma unroll
                      for (int pt = 0; pt < 4; ++pt) a2[pt][i2] = mfma32(pfr[ks][pt], yf, a2[pt][i2]); } }
              const float Dh = a.in[I_DD][l * 8 + h];
#pragma unroll
              for (int i2 = 0; i2 < 2; ++i2) { const int i = 16 * (2 * half + i2) + l15; const float ea = fexp(acl[i * 8 + h]); float s2 = 0.f;
#pragma unroll
                  for (int pt = 0; pt < 4; ++pt) { const int ch = h * 64 + 16 * pt + 4 * lq;
                      const v2u xv = *(const LAS v2u*)(XS + i * XSP + ch); const v2u zv = zvr[i2][pt];
                      f32x4 y; y[0] = (a1[pt][i2][0] + ea * a2[pt][i2][0] + Dh * bflo(xv.x)) * silu(bflo(zv.x)); y[1] = (a1[pt][i2][1] + ea * a2[pt][i2][1] + Dh * bfhi(xv.x)) * silu(bfhi(zv.x));
                      y[2] = (a1[pt][i2][2] + ea * a2[pt][i2][2] + Dh * bflo(xv.y)) * silu(bflo(zv.y)); y[3] = (a1[pt][i2][3] + ea * a2[pt][i2][3] + Dh * bfhi(xv.y)) * silu(bfhi(zv.y));
                      if (rd == 0) yv[0][pt][i2] = y; else yv[1][pt][i2] = y;
                      s2 += (y[0] * y[0] + y[1] * y[1]) + (y[2] * y[2] + y[3] * y[3]); }
                  s2 += __shfl_xor(s2, 16); s2 += __shfl_xor(s2, 32);
                  if (lq == 0) ssq[i * 8 + h] = s2; } }
            __syncthreads();
        }
        { const int ms = w >> 1, half = w & 1, g = ms >> 1;
#pragma unroll
          for (int rd = 0; rd < 2; ++rd) { const int h = g * 4 + 2 * rd + (ms & 1);
#pragma unroll
              for (int i2 = 0; i2 < 2; ++i2) { const int i = 16 * (2 * half + i2) + l15; const LAS float* sq = ssq + i * 8;
                  const float rstd = frsq((((sq[0] + sq[1]) + (sq[2] + sq[3])) + ((sq[4] + sq[5]) + (sq[6] + sq[7]))) * (1.0f / 512.0f) + EPS);
#pragma unroll
                  for (int pt = 0; pt < 4; ++pt) { const int ch = h * 64 + 16 * pt + 4 * lq; const f32x4 nw = *(const GAS f32x4*)(a.in[I_DNW] + l * 512 + ch); const f32x4 y = yv[rd][pt][i2];
                      v2u o; o.x = pk2(y[0] * rstd * nw[0], y[1] * rstd * nw[1]); o.y = pk2(y[2] * rstd * nw[2], y[3] * rstd * nw[3]);
                      if (dry) asm volatile("" :: "v"(o.x), "v"(o.y)); else *(GAS v2u*)(PR + (size_t)(t0 + i) * PJ + D_Z + ch) = o; } } } }
    }
    __syncthreads();
}

__device__ __forceinline__ void scan_phase(const Args& a, int l, int vcu, int G, LAS unsigned char* lds) {
    const int tid = opaque_tid();
    LAS float* dl = (LAS float*)lds;
    for (int j = vcu; j < 202; j += G) {
        if (j < 192) {
            const bool isS = j < 128; const int jj = isS ? j : j - 128;
            const int b = isS ? (jj >> 6) : (jj >> 5), r0 = (isS ? (jj & 63) : (jj & 31)) * 1024, h = r0 >> 13, r = r0 + 2 * tid;
            if (isS) { if (tid < CPB) dl[tid] = ((const float*)(a.ws + WS_SDEC))[(size_t)(b * CPB + tid) * 8 + h]; }
            else { for (int i = tid; i < CPB * 64; i += NTHR) dl[i] = ((const float*)(a.ws + WS_GDEC))[(size_t)(b * CPB + (i >> 6)) * 256 + h * 64 + (i & 63)]; }
            const int cstride = isS ? 131072 : 65536;
            const __amdgpu_buffer_rsrc_t rs = __builtin_amdgcn_make_buffer_rsrc((void*)(a.ws + (isS ? WS_SSD : WS_GLA) + (size_t)b * CPB * cstride), (short)0, CPB * cstride, 0x00020000);
            __syncthreads();
            float s0 = 0.f, s1 = 0.f; const int d = r & 63;
#pragma unroll 1
            for (int n0 = 0; n0 < CPB; n0 += 64) { unsigned kv[64];
#pragma unroll
                for (int q = 0; q < 64; ++q) kv[q] = __builtin_amdgcn_raw_buffer_load_b32(rs, r * 2, (n0 + q) * cstride, 0);
                asm volatile("s_waitcnt vmcnt(0)" ::: "memory");
#pragma unroll
                for (int q = 0; q < 64; ++q) { float d0, d1; if (isS) { d0 = dl[n0 + q]; d1 = d0; } else { const f32x2 dd = *(const LAS f32x2*)(dl + (n0 + q) * 64 + d); d0 = dd.x; d1 = dd.y; }
                    __builtin_amdgcn_raw_buffer_store_b32(pk2(s0, s1), rs, r * 2, (n0 + q) * cstride, 0); s0 = d0 * s0 + bflo(kv[q]); s1 = d1 * s1 + bfhi(kv[q]);
                    if ((q & 15) == 15) PIN_MEM(); } }
            __syncthreads();
        } else if (j < 200) {
            const int e2 = (j - 192) * NTHR + tid, b = e2 >> 11, gn = e2 & 2047;
            const float* A64 = (const float*)(a.ws + WS_S5T + (size_t)l * S5T_LAYER + S5T_A64); const float ar = A64[gn * 2], ai = A64[gn * 2 + 1];
            f32x2* p = (f32x2*)(a.ws + WS_S5ST) + (size_t)b * CPB * 2048 + gn; float sr = 0.f, si = 0.f;
#pragma unroll 1
            for (int n0 = 0; n0 < CPB; n0 += 32) { f32x2 ev[32];
#pragma unroll
                for (int q = 0; q < 32; ++q) ev[q] = p[(size_t)(n0 + q) * 2048];
                asm volatile("s_waitcnt vmcnt(0)" ::: "memory");
#pragma unroll
                for (int q = 0; q < 32; ++q) { const f32x2 o = {sr, si}; p[(size_t)(n0 + q) * 2048] = o; const float nr = ar * sr - ai * si + ev[q].x, ni = ar * si + ai * sr + ev[q].y; sr = nr; si = ni; } }
        } else {
            const int e2 = (j - 200) * NTHR + tid, b = e2 >> 9, ch = e2 & 511;
            const f32x2* E = (const f32x2*)(a.ws + WS_LRUE) + (size_t)b * CPB * 512 + ch; float* H = (float*)(a.ws + WS_LRUH) + (size_t)b * CPB * 512 + ch; float hs = 0.f;
#pragma unroll 1
            for (int n0 = 0; n0 < CPB; n0 += 32) { f32x2 ev[32];
#pragma unroll
                for (int q = 0; q < 32; ++q) ev[q] = E[(size_t)(n0 + q) * 512];
#pragma unroll
                for (int q = 0; q < 32; ++q) { H[(size_t)(n0 + q) * 512] = hs; hs = ev[q].x * hs + ev[q].y; } }
        }
    }
}

__device__ __forceinline__ void final_norm(const Args& a, int vcu, int G) {
    const int tid = opaque_tid(), lane = tid & 63, wave = tid >> 6; const int gw = vcu * NWAVES + wave, NGW = G * NWAVES;
    const float* rowss = (const float*)(a.ws + WS_PART) + (size_t)DEPTH * T * 16;
    for (int m = gw; m < T; m += NGW) {
        float rsum = 0.f;
#pragma unroll
        for (int q = 0; q < 16; ++q) rsum += rowss[(size_t)m * 16 + q];
        const float rstd = 1.0f / sqrtf(rsum * (1.0f / 1024.0f) + EPS);
        const GAS v2u* xr = (const GAS v2u*)((const bf16*)(a.ws + WS_XBF) + (size_t)m * DM) + lane; GAS f32x4* orow = (GAS f32x4*)(a.out + (size_t)m * DM) + lane; const GAS f32x4* wr = (const GAS f32x4*)(a.in[I_NFW]) + lane;
        v2u xv[4];
#pragma unroll
        for (int j = 0; j < 4; ++j) xv[j] = xr[64 * j];
#pragma unroll
        for (int j = 0; j < 4; ++j) { const f32x4 w = wr[64 * j]; f32x4 v = (f32x4){bflo(xv[j].x), bfhi(xv[j].x), bflo(xv[j].y), bfhi(xv[j].y)}; v = v * rstd * w; orow[64 * j] = v; }
    }
}

#define XB_TMO      128
#define XB_XCNT(j)  (256  + 64 * (j))
#define XB_XSUB(j)  (1280 + 64 * (j))
#define XB_XGEN(j)  (2304 + 64 * (j))
#define XB_TOP      3328
#define XB_TOPGEN   3392
#define XCD_BAR_WORDS 3456
#define XB_SPIN_CAP (1u << 22)
__device__ __forceinline__ unsigned xb_ld(unsigned* p)              { return __hip_atomic_load(p, __ATOMIC_RELAXED, __HIP_MEMORY_SCOPE_AGENT); }
__device__ __forceinline__ unsigned xb_add(unsigned* p, unsigned v) { return __hip_atomic_fetch_add(p, v, __ATOMIC_RELAXED, __HIP_MEMORY_SCOPE_AGENT); }
__device__ __forceinline__ unsigned xb_xcc_id() { return (unsigned)__builtin_amdgcn_s_getreg((3 << 11) | 20) & 0xFu; }
#define XB_SPIN(cond, bar) do { unsigned _sp = 0; while (cond) { __builtin_amdgcn_s_sleep(1); \
    if ((++_sp & 255u) == 0u) { if (xb_ld(&(bar)[XB_TMO])) break; if (_sp > XB_SPIN_CAP) { atomicAdd(&(bar)[XB_TMO], 1u); break; } } } } while (0)
struct XcdBarrier { unsigned* bar; unsigned x; volatile LAS unsigned* st; };
__device__ __forceinline__ XcdBarrier xcd_barrier_post(unsigned* bar, volatile LAS unsigned* st) {
    XcdBarrier b; b.bar = bar; b.x = xb_xcc_id(); b.st = st;
    if (threadIdx.x == 0) (void)xb_add(&bar[XB_XCNT(b.x)], 1u);
    return b;
}
__device__ __forceinline__ void xcd_barrier_complete(unsigned* bar, unsigned x, unsigned& nloc, unsigned& nx) {
    const unsigned G = gridDim.x * gridDim.y * gridDim.z;
    unsigned sum, cnt, mine, sp = 0u;
    for (;;) {
        sum = 0u; cnt = 0u; mine = 0u;
#pragma unroll
        for (unsigned j = 0; j < 16; ++j) { const unsigned c = xb_ld(&bar[XB_XCNT(j)]); sum += c; cnt += (c > 0u) ? 1u : 0u; mine = (j == x) ? c : mine; }
        if (sum == G) break;
        __builtin_amdgcn_s_sleep(1);
        if ((++sp & 255u) == 0u) { if (xb_ld(&bar[XB_TMO])) break; if (sp > XB_SPIN_CAP) { atomicAdd(&bar[XB_TMO], 1u); break; } }
    }
    nloc = mine > 0u ? mine : 1u; nx = cnt > 0u ? cnt : 1u;
}
__device__ __forceinline__ void xcd_barrier(const XcdBarrier& b) {
    asm volatile("s_waitcnt vmcnt(0)" ::: "memory");
    __syncthreads();
    if (threadIdx.x == 0) {
        unsigned* bar = b.bar;
        __builtin_amdgcn_s_waitcnt(0);
        unsigned nloc = b.st[0], nx = b.st[1];
        if (nloc == 0u) { xcd_barrier_complete(bar, b.x, nloc, nx); b.st[0] = nloc; b.st[1] = nx; }
        const unsigned old = xb_add(&bar[XB_XSUB(b.x)], 1u);
        const unsigned gen = old / nloc;
        if (old + 1u == (gen + 1u) * nloc) {
            __builtin_amdgcn_fence(__ATOMIC_RELEASE, "agent");
            asm volatile("s_waitcnt vmcnt(0)" ::: "memory");
            const unsigned og = xb_add(&bar[XB_TOP], 1u);
            const unsigned tg = og / nx;
            if (og + 1u == (tg + 1u) * nx) xb_add(&bar[XB_TOPGEN], 1u);
            else XB_SPIN(xb_ld(&bar[XB_TOPGEN]) == tg, bar);
            __builtin_amdgcn_fence(__ATOMIC_ACQUIRE, "agent");
            xb_add(&bar[XB_XGEN(b.x)], 1u);
            asm volatile("s_waitcnt vmcnt(0)" ::: "memory");
        } else {
            XB_SPIN(xb_ld(&bar[XB_XGEN(b.x)]) == gen, bar);
            __builtin_amdgcn_fence(__ATOMIC_ACQUIRE, "agent");
            asm volatile("s_waitcnt vmcnt(0)" ::: "memory");
        }
    }
    __syncthreads();
}

constexpr int N_PHASES = 2 + 5 * DEPTH;
__global__ void __launch_bounds__(NTHR, 2) mega_fwd(Args args) {
    extern __shared__ __attribute__((aligned(16))) unsigned char lds_raw[];
    LAS unsigned char* lds = (LAS unsigned char*)lds_raw;
    const int G = gridDim.x, bx = blockIdx.x; const int vcu = (G % 8 == 0) ? (bx % 8) * (G / 8) + bx / 8 : bx;
    const int lo = args.ph_lo, hi = args.ph_hi;
    float* rowss = (float*)(args.ws + WS_PART);
    volatile LAS unsigned* bst = (volatile LAS unsigned*)(lds + LDS_BYTES - 64);
    if (threadIdx.x < 2) bst[threadIdx.x] = 0u;
    __syncthreads();
    XcdBarrier xbar = xcd_barrier_post((unsigned*)(args.ws + WS_CTL), bst);
    constexpr int N_EXTRA = PROBE_DUP == 0 ? 0 : (PROBE_DUP == 3 ? 4 : 1);
    for (int sq = lo; sq < hi + N_EXTRA; ++sq) {
        int ph = sq;
        if (PROBE_DUP == 1) ph = sq <= 1 ? sq : sq - 1;
        if (PROBE_DUP == 2) ph = sq <= 2 ? sq : sq - 1;
        if (PROBE_DUP == 3) ph = sq <= 4 ? sq : sq - 4;
        if (PROBE_DUP == 4) ph = sq <= 5 ? sq : sq - 1;
        if (PROBE_DUP == 5) ph = sq <= 0 ? sq : sq - 1;
        if (PROBE_DUP == 6) ph = sq <= N_PHASES - 1 ? sq : sq - 1;
        if (ph == 0) { if (DBG_MASK & 1) p0_prologue(args, lds, vcu, G); }
        else if (ph == N_PHASES - 1) { if (DBG_MASK & 256) final_norm(args, vcu, G); }
        else {
            const int l = (ph - 1) / 5, sub = (ph - 1) % 5;
            if (sub == 0) { if (DBG_MASK & 2) {
                pg8::Gemm g{(const bf16*)args.out, (const bf16*)(args.ws + WS_WIN) + (size_t)l * NPAD * DM, T, PJ, DM, DM, 512};
                pg8::StaticOrder S; S.init(T, PJ, G, bx);
                pg8::EpiProj E{(bf16*)(args.ws + WS_PROJ), (float*)(args.ws + WS_EX), rowss + (size_t)l * T * 16, PJ};
                pg8::gemm_phase<pg8::EpiProj, pg8::StaticOrder, true, true>(lds, g, S, E);
                for (int c = vcu; c < NCHUNK; c += G) ex_chunk(args, l, c); }
            } else if (sub == 1 || sub == 3) {
                const bool fin = (sub == 3);
                for (int c = vcu; c < NCHUNK; c += G) {
                    if (PROBE_MIX == 1 && !fin) lru_chunk(args, l, c, false, lds); if (PROBE_MIX == 9 && !fin) lru_chunk(args, l, c, false, lds, false, true); if (PROBE_MIX == 5 && fin) lru_chunk(args, l, c, true, lds, true);
                    if (fin) lru_out(args, l, c); else lru_chunk(args, l, c, false, lds);
                    if (PROBE_MIX == 2 && !fin) s5_chunk(args, l, c, false, lds); if (PROBE_MIX == 6 && fin) s5_chunk(args, l, c, true, lds, true);
                    s5_chunk(args, l, c, fin, lds);
                    if (PROBE_MIX == 3 && !fin) gla_chunk(args, l, c, false, lds); if (PROBE_MIX == 7 && fin) gla_chunk(args, l, c, true, lds, true);
                    gla_chunk(args, l, c, fin, lds);
                    if (PROBE_MIX == 4 && !fin) ssd_chunk(args, l, c, false, lds); if (PROBE_MIX == 8 && fin) ssd_chunk(args, l, c, true, lds, true);
                    ssd_chunk(args, l, c, fin, lds); }
            } else if (sub == 2) { if (DBG_MASK & 64) scan_phase(args, l, vcu, G, lds); }
            else if (DBG_MASK & 128) {
                pg8::Gemm g{(const bf16*)(args.ws + WS_PROJ), (const bf16*)(args.ws + WS_WOUT) + (size_t)l * DM * 2048, T, DM, 2048, PJ, 1280};
                pg8::StaticOrder S; S.init(T, DM, G, bx);
                pg8::EpiOut E{l == 0 ? args.in[I_X] : nullptr, (const bf16*)args.out, l == DEPTH - 1 ? (bf16*)(args.ws + WS_XBF) : (bf16*)args.out, rowss + (size_t)(l + 1) * T * 16};
                pg8::gemm_phase<pg8::EpiOut, pg8::StaticOrder, true, true>(lds, g, S, E);
            }
        }
        if (sq + 1 < hi + N_EXTRA) { xcd_barrier(xbar); }
    }
}

extern "C" void kernel_launch(void* const* d_in, const int* in_sizes, int n_in, void* d_out, int out_size, void* d_ws, size_t ws_size, hipStream_t stream) {
    static int grid = 0;
    if (grid == 0) {
        if (n_in != 31 || out_size != T * DM || ws_size < WS_END) { fprintf(stderr, "kernel_launch: unexpected shapes (n_in %d out %d ws %zu need %zu)\n", n_in, out_size, ws_size, (size_t)WS_END); grid = -1; return; }
        int dev = 0, cus = 0, per_cu = 0;
        if (hipGetDevice(&dev) != hipSuccess || hipDeviceGetAttribute(&cus, hipDeviceAttributeMultiprocessorCount, dev) != hipSuccess) { grid = -1; return; }
        if (hipFuncSetAttribute((const void*)mega_fwd, hipFuncAttributeMaxDynamicSharedMemorySize, LDS_BYTES) != hipSuccess) { fprintf(stderr, "kernel_launch: hipFuncSetAttribute failed\n"); grid = -1; return; }
        if (hipOccupancyMaxActiveBlocksPerMultiprocessor(&per_cu, (const void*)mega_fwd, NTHR, LDS_BYTES) != hipSuccess || per_cu < 1) { fprintf(stderr, "kernel_launch: occupancy query says %d blocks/CU\n", per_cu); (void)hipGetLastError(); per_cu = 1; }
        grid = cus;
        fprintf(stderr, "kernel_launch: grid %d (per_cu %d)\n", grid, per_cu);
    }
    if (grid < 0) return;
    (void)hipMemsetAsync((char*)d_ws + WS_CTL, 0, CTL_ZERO_BYTES, stream);
    Args a{};
    for (int i = 0; i < 31; ++i) a.in[i] = (const float*)d_in[i];
    a.out = (float*)d_out; a.ws = (unsigned char*)d_ws;
#if MK_PER_PHASE
    for (int ph = 0; ph < N_PHASES; ++ph) { a.ph_lo = ph; a.ph_hi = ph + 1; hipLaunchKernelGGL(mega_fwd, dim3(grid), dim3(NTHR), LDS_BYTES, stream, a); }
#else
    a.ph_lo = 0; a.ph_hi = N_PHASES;
    void* kargs[] = {&a};
    hipError_t e = hipLaunchCooperativeKernel((const void*)mega_fwd, dim3(grid), dim3(NTHR), kargs, LDS_BYTES, stream);
    if (e != hipSuccess) fprintf(stderr, "kernel_launch: cooperative launch failed: %s\n", hipGetErrorString(e));
#endif
}
```

```cpp
#include <hip/hip_runtime.h>
#include <hip/hip_cooperative_groups.h>
#include <cstdio>
#include <cstdint>
namespace cg = cooperative_groups;

#ifndef DBG_MASK
#define DBG_MASK 0xFFF
#endif
#ifndef PROBE_DUP
#define PROBE_DUP 0
#endif
#ifndef PROBE_MIX
#define PROBE_MIX 0
#endif
#ifndef MK_PER_PHASE
#define MK_PER_PHASE 0
#endif

namespace pg8 {
#define PG8_LAS __attribute__((address_space(3)))
typedef unsigned short bf16_t;
typedef short bf16x8 __attribute__((ext_vector_type(8)));
typedef float f32x4 __attribute__((ext_vector_type(4)));
typedef unsigned u32x4 __attribute__((ext_vector_type(4)));
typedef unsigned u32x2 __attribute__((ext_vector_type(2)));
constexpr int BM = 256, BK = 64, HALF = 128, HTB = HALF * BK * 2, STAGE_BYTES = 8 * HTB, NXCD = 8, WGM = 8;

__host__ __device__ __forceinline__ int lds_byte(int r, int c) { const int st = (r >> 4) * 2 + (c >> 5), rr = r & 15, cc = c & 31, ob = rr * 64 + cc * 2; return st * 1024 + (ob ^ (((ob >> 9) & 1) << 5)); }
__host__ __device__ __forceinline__ void stage_rc(int b, int& R, int& C) { const int st = b / 1024, sb = b % 1024, swz = sb ^ (((sb >> 9) & 1) << 5); R = (st >> 1) * 16 + swz / 64; C = (st & 1) * 32 + (swz % 64) / 2; }
__host__ __device__ __forceinline__ int perm32(int rho) { const int n = rho >> 4, i = rho & 15; return 8 * (i >> 2) + 4 * n + (i & 3); }

struct Unit { int pm, pn; };
struct Gemm { const bf16_t* A; const bf16_t* Bt; int M, N, K, lda, segcols; };

struct StaticOrder {
    int nM, nN, nwg, G, c;
    __host__ __device__ void init(int M, int N, int G_, int c_) { nM = M / BM; nN = N / BM; nwg = nM * nN; G = G_; c = c_; }
    __host__ __device__ bool next(int i, Unit& u) const {
        const long L = (long)i * G + c; if (L >= nwg) return false;
        int wgid = (int)L; { const int q = nwg / NXCD, r = nwg % NXCD, xcd = wgid % NXCD, off = wgid / NXCD; wgid = (xcd < r ? xcd * (q + 1) : r * (q + 1) + (xcd - r) * q) + off; }
        const int nig = WGM * nN, gid = wgid / nig, fm = gid * WGM, gsz = (nM - fm) < WGM ? (nM - fm) : WGM;
        u.pm = fm + ((wgid % nig) % gsz); u.pn = (wgid % nig) / gsz; return true;
    }
};

__device__ __forceinline__ unsigned cvt_pk_bf16(float lo, float hi) { unsigned r; asm volatile("v_cvt_pk_bf16_f32 %0, %1, %2" : "=v"(r) : "v"(lo), "v"(hi)); return r; }

struct EpiProj {
    static constexpr bool PERM = true;
    bf16_t* P; float* EX; const float* rowss; int pj;
    __device__ __forceinline__ void operator()(const f32x4 (&acc)[2][2][4][2], const Unit& u, int wr, int wc, int fr, int fq) const {
        const int row0 = u.pm * BM + wr * 64 + fr;
#pragma unroll
        for (int ai = 0; ai < 2; ++ai)
#pragma unroll
            for (int m = 0; m < 4; ++m) {
                const int row = row0 + ai * HALF + m * 16;
                const f32x4* pp = (const f32x4*)(rowss + (size_t)row * 16); const f32x4 p0 = pp[0], p1 = pp[1], p2 = pp[2], p3 = pp[3];
                const float rsum = (((p0[0] + p0[1]) + (p0[2] + p0[3])) + ((p1[0] + p1[1]) + (p1[2] + p1[3]))) + (((p2[0] + p2[1]) + (p2[2] + p2[3])) + ((p3[0] + p3[1]) + (p3[2] + p3[3])));
                const float rstd = 1.0f / sqrtf(rsum * (1.0f / 1024.0f) + 1e-6f);
                if (u.pn < 20) {
                    bf16_t* rowp = P + (size_t)row * pj + u.pn * BM + wc * 32 + 8 * fq;
#pragma unroll
                    for (int bj = 0; bj < 2; ++bj) { const f32x4 v0 = acc[ai][bj][m][0] * rstd, v1 = acc[ai][bj][m][1] * rstd;
                        u32x4 w; w.x = cvt_pk_bf16(v0[0], v0[1]); w.y = cvt_pk_bf16(v0[2], v0[3]); w.z = cvt_pk_bf16(v1[0], v1[1]); w.w = cvt_pk_bf16(v1[2], v1[3]);
                        *(u32x4*)(rowp + bj * HALF) = w; }
                } else if (wc == 0) {
                    float* ep = EX + (size_t)row * 32 + 8 * fq;
                    *(f32x4*)(ep) = acc[ai][0][m][0] * rstd; *(f32x4*)(ep + 4) = acc[ai][0][m][1] * rstd;
                }
            }
    }
};
struct EpiOut {
    static constexpr bool PERM = false;
    const float* Xf; const bf16_t* XBin; bf16_t* XBout; float* rowss_next;
    __device__ __forceinline__ void operator()(const f32x4 (&acc)[2][2][4][2], const Unit& u, int wr, int wc, int fr, int fq) const {
        const int row0 = u.pm * BM + wr * 64 + fr, col0 = u.pn * BM + wc * 32 + 4 * fq;
#pragma unroll
        for (int ai = 0; ai < 2; ++ai)
#pragma unroll
            for (int mh = 0; mh < 2; ++mh) {
                f32x4 xo[2][2][2];
                if (Xf) {
#pragma unroll
                    for (int m = 0; m < 2; ++m)
#pragma unroll
                        for (int bj = 0; bj < 2; ++bj)
#pragma unroll
                            for (int n = 0; n < 2; ++n) xo[m][bj][n] = *(const f32x4*)(Xf + (size_t)(row0 + ai * HALF + (2 * mh + m) * 16) * 1024 + col0 + bj * HALF + n * 16);
                } else {
#pragma unroll
                    for (int m = 0; m < 2; ++m)
#pragma unroll
                        for (int bj = 0; bj < 2; ++bj)
#pragma unroll
                            for (int n = 0; n < 2; ++n) { const u32x2 w = *(const u32x2*)(XBin + (size_t)(row0 + ai * HALF + (2 * mh + m) * 16) * 1024 + col0 + bj * HALF + n * 16);
                                xo[m][bj][n] = (f32x4){__builtin_bit_cast(float, w.x << 16), __builtin_bit_cast(float, w.x & 0xffff0000u), __builtin_bit_cast(float, w.y << 16), __builtin_bit_cast(float, w.y & 0xffff0000u)}; }
                }
#pragma unroll
                for (int m = 0; m < 2; ++m) {
                    const int mm = 2 * mh + m, row = row0 + ai * HALF + mm * 16; float ss = 0.f;
#pragma unroll
                    for (int bj = 0; bj < 2; ++bj)
#pragma unroll
                        for (int n = 0; n < 2; ++n) { const size_t off = (size_t)row * 1024 + col0 + bj * HALF + n * 16;
                            const f32x4 xn = xo[m][bj][n] + acc[ai][bj][mm][n];
                            u32x2 w; w.x = cvt_pk_bf16(xn[0], xn[1]); w.y = cvt_pk_bf16(xn[2], xn[3]); *(u32x2*)(XBout + off) = w;
                            ss += (xn[0] * xn[0] + xn[1] * xn[1]) + (xn[2] * xn[2] + xn[3] * xn[3]); }
                    ss += __shfl_xor(ss, 16); ss += __shfl_xor(ss, 32);
                    if (fq == 0) rowss_next[(size_t)row * 16 + u.pn * 4 + wc] = ss;
                }
            }
    }
};

__device__ __forceinline__ int opaque_tid() { int t = threadIdx.x; asm volatile("" : "+v"(t)); return t; }
template <class Epi, class Sched, bool ALIGN_EPI = false, bool SP2 = false>
__device__ __forceinline__ void gemm_phase(PG8_LAS unsigned char* lds, const Gemm g, const Sched& S, const Epi& E) {
    const int tid = opaque_tid(), wid = __builtin_amdgcn_readfirstlane(tid >> 6), lane = tid & 63, wr = wid >> 2, wc = wid & 3, fr = lane & 15, fq = lane >> 4;
    const int K = g.K, nt = K / BK, lda = g.lda;
    unsigned voffA[2], voffB[2];
#pragma unroll
    for (int i = 0; i < 2; ++i) { int R, C; stage_rc(tid * 16 + i * 8192, R, C); const int Rb = Epi::PERM ? ((R & ~31) + perm32(R & 31)) : R;
        voffA[i] = (unsigned)(R * lda + C) * 2u; voffB[i] = (unsigned)(Rb * K + C) * 2u; }
    const size_t kstep = (size_t)(BK * 2);
    const size_t segB = (size_t)g.segcols * 2;
    const size_t hstepA = (size_t)HALF * lda * 2, hstepB = (size_t)HALF * K * 2;
    const size_t tstepA = 2 * hstepA, tstepB = 2 * hstepB;
    const unsigned ldsw = (unsigned)wid * 1024u;
    const int aoff = lds_byte(wr * 64 + fr, fq * 8), boff = lds_byte(wc * 32 + fr, fq * 8);
#define PG8_KA(t) ((size_t)((t) >> 3) * segB + (size_t)((t) & 7) * kstep)
#define PG8_SA(b, h) (((b) * 2 + (h)) * HTB)
#define PG8_SB(b, h) ((4 + (b) * 2 + (h)) * HTB)
#define PG8_STAGE(bufoff, gbase, voff) do { _Pragma("unroll") for (int _i = 0; _i < 2; ++_i) \
        __builtin_amdgcn_global_load_lds((const unsigned*)((const char*)(gbase) + (voff)[_i]), (PG8_LAS unsigned*)(lds + (bufoff) + ldsw + _i * 8192), 16, 0, 0); } while (0)
#define PG8_LDA(dst, b, h) do { _Pragma("unroll") for (int m = 0; m < 4; ++m) _Pragma("unroll") for (int k = 0; k < 2; ++k) dst[m][k] = *(const PG8_LAS bf16x8*)(lds + PG8_SA(b, h) + aoff + m * 2048 + k * 1024); } while (0)
#define PG8_LDB(dst, b, h) do { _Pragma("unroll") for (int n = 0; n < 2; ++n) _Pragma("unroll") for (int k = 0; k < 2; ++k) dst[n][k] = *(const PG8_LAS bf16x8*)(lds + PG8_SB(b, h) + boff + n * 2048 + k * 1024); } while (0)
#define PG8_MMA(ai, bj, At, Bt) do { __builtin_amdgcn_s_setprio(1); _Pragma("unroll") for (int m = 0; m < 4; ++m) _Pragma("unroll") for (int n = 0; n < 2; ++n) _Pragma("unroll") for (int k = 0; k < 2; ++k) \
        acc[ai][bj][m][n] = __builtin_amdgcn_mfma_f32_16x16x32_bf16(Bt[n][k], At[m][k], acc[ai][bj][m][n], 0, 0, 0); __builtin_amdgcn_s_setprio(0); } while (0)
#define PG8_WAIT_V(n) asm volatile("s_waitcnt vmcnt(" #n ")" ::: "memory")
#define PG8_WAIT_L(n) asm volatile("s_waitcnt lgkmcnt(" #n ")" ::: "memory")
#define PG8_BAR __builtin_amdgcn_s_barrier()
#define PG8_SCHED __builtin_amdgcn_sched_barrier(0)
    Unit cur, nxt; int ui = 0;
    if (!S.next(0, cur)) return;
    f32x4 acc[2][2][4][2];
#pragma unroll
    for (int a = 0; a < 2; ++a)
#pragma unroll
        for (int b = 0; b < 2; ++b)
#pragma unroll
            for (int m = 0; m < 4; ++m)
#pragma unroll
                for (int n = 0; n < 2; ++n) acc[a][b][m][n] = (f32x4){0.f, 0.f, 0.f, 0.f};
    bf16x8 At[4][2], B0[2][2], B1[2][2];
    const char* cA = (const char*)g.A + (size_t)cur.pm * tstepA; const char* cB = (const char*)g.Bt + (size_t)cur.pn * tstepB;
    if constexpr (SP2) {
        PG8_STAGE(PG8_SB(0, 0), cB, voffB); PG8_STAGE(PG8_SB(0, 1), cB + hstepB, voffB); PG8_STAGE(PG8_SA(0, 0), cA, voffA); PG8_STAGE(PG8_SA(0, 1), cA + hstepA, voffA);
        if (wr == 1) PG8_BAR;
        PG8_WAIT_V(2); PG8_BAR;
        PG8_STAGE(PG8_SB(1, 0), cB + kstep, voffB); PG8_STAGE(PG8_SA(1, 0), cA + kstep, voffA); PG8_STAGE(PG8_SB(1, 1), cB + hstepB + kstep, voffB);
        PG8_WAIT_V(6); PG8_BAR;
    } else {
        PG8_STAGE(PG8_SB(0, 0), cB, voffB); PG8_STAGE(PG8_SA(0, 0), cA, voffA); PG8_STAGE(PG8_SB(0, 1), cB + hstepB, voffB); PG8_STAGE(PG8_SA(0, 1), cA + hstepA, voffA);
        if (wr == 1) PG8_BAR;
        PG8_WAIT_V(4); PG8_BAR;
        PG8_STAGE(PG8_SB(1, 0), cB + kstep, voffB); PG8_STAGE(PG8_SA(1, 0), cA + kstep, voffA); PG8_STAGE(PG8_SB(1, 1), cB + hstepB + kstep, voffB);
        PG8_WAIT_V(6); PG8_BAR;
    }
    for (;;) {
        const bool has_next = S.next(ui + 1, nxt);
        const char* nA = has_next ? (const char*)g.A + (size_t)nxt.pm * tstepA : cA; const char* nB = has_next ? (const char*)g.Bt + (size_t)nxt.pn * tstepB : cB;
        for (int t = 0; t < nt; t += 2) {
            const bool last = (t == nt - 2);
            const char* a1 = cA + PG8_KA(t + 1);
            const char* a2 = last ? nA : cA + PG8_KA(t + 2); const char* b2 = last ? nB : cB + (size_t)(t + 2) * kstep;
            const char* a3 = a2 + kstep; const char* b3 = b2 + kstep;
            if constexpr (SP2) {
            PG8_LDB(B0, 0, 0); PG8_LDB(B1, 0, 1); PG8_SCHED; PG8_LDA(At, 0, 0); PG8_STAGE(PG8_SA(1, 1), a1 + hstepA, voffA);
            PG8_WAIT_V(8); PG8_WAIT_L(0); PG8_BAR; PG8_MMA(0, 0, At, B0); PG8_MMA(0, 1, At, B1); PG8_BAR; PG8_SCHED;
            PG8_LDA(At, 0, 1); PG8_STAGE(PG8_SB(0, 0), b2, voffB); PG8_STAGE(PG8_SB(0, 1), b2 + hstepB, voffB); PG8_STAGE(PG8_SA(0, 0), a2, voffA);
            PG8_WAIT_V(8); PG8_WAIT_L(0); PG8_BAR; PG8_MMA(1, 0, At, B0); PG8_MMA(1, 1, At, B1); PG8_BAR; PG8_SCHED;
            PG8_LDB(B0, 1, 0); PG8_LDB(B1, 1, 1); PG8_SCHED; PG8_LDA(At, 1, 0); PG8_STAGE(PG8_SA(0, 1), a2 + hstepA, voffA);
            PG8_WAIT_V(8); PG8_WAIT_L(0); PG8_BAR; PG8_MMA(0, 0, At, B0); PG8_MMA(0, 1, At, B1); PG8_BAR; PG8_SCHED;
            PG8_LDA(At, 1, 1); PG8_STAGE(PG8_SB(1, 0), b3, voffB); PG8_STAGE(PG8_SB(1, 1), b3 + hstepB, voffB); PG8_STAGE(PG8_SA(1, 0), a3, voffA);
            PG8_WAIT_V(8); PG8_WAIT_L(0); PG8_BAR; PG8_MMA(1, 0, At, B0); PG8_MMA(1, 1, At, B1); PG8_BAR; PG8_SCHED;
            } else {
            PG8_LDB(B0, 0, 0); PG8_SCHED; PG8_LDA(At, 0, 0); PG8_STAGE(PG8_SA(1, 1), a1 + hstepA, voffA);
            PG8_WAIT_L(8); PG8_BAR; PG8_WAIT_L(0); PG8_MMA(0, 0, At, B0); PG8_BAR; PG8_SCHED;
            PG8_LDB(B1, 0, 1); PG8_STAGE(PG8_SB(0, 0), b2, voffB);
            PG8_BAR; PG8_WAIT_L(0); PG8_MMA(0, 1, At, B1); PG8_BAR;
            PG8_LDA(At, 0, 1); PG8_STAGE(PG8_SA(0, 0), a2, voffA);
            PG8_BAR; PG8_WAIT_L(0); PG8_MMA(1, 0, At, B0); PG8_BAR; PG8_SCHED;
            PG8_STAGE(PG8_SB(0, 1), b2 + hstepB, voffB);
            PG8_WAIT_V(6); PG8_BAR; PG8_MMA(1, 1, At, B1); PG8_BAR;
            PG8_LDB(B0, 1, 0); PG8_SCHED; PG8_LDA(At, 1, 0); PG8_STAGE(PG8_SA(0, 1), a2 + hstepA, voffA);
            PG8_WAIT_L(8); PG8_BAR; PG8_WAIT_L(0); PG8_MMA(0, 0, At, B0); PG8_BAR; PG8_SCHED;
            PG8_LDB(B1, 1, 1); PG8_STAGE(PG8_SB(1, 0), b3, voffB);
            PG8_BAR; PG8_WAIT_L(0); PG8_MMA(0, 1, At, B1); PG8_BAR;
            PG8_LDA(At, 1, 1); PG8_STAGE(PG8_SA(1, 0), a3, voffA);
            PG8_BAR; PG8_WAIT_L(0); PG8_MMA(1, 0, At, B0); PG8_BAR; PG8_SCHED;
            PG8_STAGE(PG8_SB(1, 1), b3 + hstepB, voffB);
            PG8_WAIT_V(6); PG8_BAR; PG8_MMA(1, 1, At, B1); PG8_BAR;
            }
        }
        if constexpr (ALIGN_EPI) { if (wr == 0) PG8_BAR; }
        E(acc, cur, wr, wc, fr, fq);
        if (!has_next) break;
#pragma unroll
        for (int a = 0; a < 2; ++a)
#pragma unroll
            for (int b = 0; b < 2; ++b)
#pragma unroll
                for (int m = 0; m < 4; ++m)
#pragma unroll
                    for (int n = 0; n < 2; ++n) acc[a][b][m][n] = (f32x4){0.f, 0.f, 0.f, 0.f};
        cur = nxt; cA = nA; cB = nB; ++ui;
        if constexpr (ALIGN_EPI) { if (wr == 1) PG8_BAR; }
    }
    PG8_WAIT_V(0);
    if constexpr (!ALIGN_EPI) { if (wr == 0) PG8_BAR; }
    PG8_BAR;
#undef PG8_KA
#undef PG8_SA
#undef PG8_SB
#undef PG8_STAGE
#undef PG8_LDA
#undef PG8_LDB
#undef PG8_MMA
#undef PG8_WAIT_V
#undef PG8_WAIT_L
#undef PG8_BAR
#undef PG8_SCHED
}
}

constexpr int NWAVES = 8, NTHR = 512;
constexpr int DM = 1024, BATCH = 2, SEQ = 8192, DEPTH = 4, T = BATCH * SEQ;
constexpr int DIN = 5144, PJ = 5120, NPAD = 5152, NCHUNK = T / 64, CPB = SEQ / 64;
constexpr float EPS = 1e-6f;
constexpr int A_Z = 0, A_X = 512, C_Q = 1024, B_Z = 1280, B_U = 1792, C_K = 2304, C_Z = 2560, C_V = 3072, D_CM = 3584, D_Z = 3840, D_XS = 4352, D_BM = 4864;
constexpr int O_AX = 0, O_AZ = 512, O_BU = 1024, O_BZ = 1536, O_CQ = 2048, O_CK = 2304, O_CV = 2560, O_CZ = 3072, O_CG = 3584, O_DZ = 3600, O_DXBC = 4112, O_DDT = 5136;
__host__ __device__ __forceinline__ int orig_col(int j) {
    if (j < 512) return O_AZ + j;
    if (j < 1024) return O_AX + (j - 512);
    if (j < 1280) return O_CQ + (j - 1024);
    if (j < 1792) return O_BZ + (j - 1280);
    if (j < 2304) return O_BU + (j - 1792);
    if (j < 2560) return O_CK + (j - 2304);
    if (j < 3072) return O_CZ + (j - 2560);
    if (j < 3584) return O_CV + (j - 3072);
    if (j < 3840) return O_DXBC + 768 + (j - 3584);
    if (j < 4352) return O_DZ + (j - 3840);
    if (j < 4864) return O_DXBC + (j - 4352);
    if (j < 5120) return O_DXBC + 512 + (j - 4864);
    if (j < 5136) return O_CG + (j - 5120);
    if (j < 5144) return O_DDT + (j - 5136);
    return -1;
}
constexpr size_t MiB = 1u << 20;
constexpr size_t WS_CTL = 0, CTL_ZERO_BYTES = 1 * MiB;
constexpr size_t CTL_ROWSS = 512 * 1024;
constexpr size_t WS_WIN = 1 * MiB;
constexpr size_t WS_WOUT = 43 * MiB;
constexpr size_t WS_S5T = 59 * MiB;
constexpr size_t WS_PROJ = 75 * MiB;
constexpr size_t WS_EX = 235 * MiB;
constexpr size_t WS_GLA = 237 * MiB;
constexpr size_t WS_SSD = 253 * MiB;
constexpr size_t WS_XBF = WS_SSD;
constexpr size_t WS_S5ST = 285 * MiB;
constexpr size_t WS_LRUE = 289 * MiB;
constexpr size_t WS_LRUH = 290 * MiB;
constexpr size_t WS_GDEC = 291 * MiB;
constexpr size_t WS_SDEC = 292 * MiB;
constexpr size_t WS_PART = 293 * MiB;
constexpr size_t WS_GLUT = 298 * MiB;
constexpr size_t WS_LRW = 300 * MiB;
constexpr size_t WS_END = 301 * MiB;
constexpr size_t S5T_AB = 0;
constexpr size_t S5T_A64 = 16384;
constexpr size_t S5T_BC = 65536;
constexpr size_t S5T_CC = 196608;
constexpr size_t S5T_PW = 327680;
constexpr size_t S5T_KT = 1048576;
constexpr size_t S5T_LAYER = 4 * MiB;

constexpr int LDS_BYTES = 155648;

#define GAS __attribute__((address_space(1)))
#define LAS __attribute__((address_space(3)))
typedef unsigned short bf16;
typedef unsigned v4u __attribute__((ext_vector_type(4)));
typedef float f32x4 __attribute__((ext_vector_type(4)));

__device__ __forceinline__ unsigned f2bf_sw(float f) { unsigned u = __builtin_bit_cast(unsigned, f); return (u + 0x7fffu + ((u >> 16) & 1u)) >> 16; }
__device__ __forceinline__ unsigned pk2_sw(float lo, float hi) { return f2bf_sw(lo) | (f2bf_sw(hi) << 16); }
typedef float cvt_f32x2 __attribute__((ext_vector_type(2)));
typedef __bf16 cvt_bf16x2 __attribute__((ext_vector_type(2)));
__device__ __forceinline__ unsigned pk2(float lo, float hi) { const cvt_f32x2 v = {lo, hi}; return __builtin_bit_cast(unsigned, __builtin_convertvector(v, cvt_bf16x2)); }
__device__ __forceinline__ unsigned f2bf(float f) { return pk2(f, f); }
__device__ __forceinline__ float bf2f(unsigned h) { return __builtin_bit_cast(float, (h & 0xffffu) << 16); }
__device__ __forceinline__ float bflo(unsigned w) { return __builtin_bit_cast(float, w << 16); }
__device__ __forceinline__ float bfhi(unsigned w) { return __builtin_bit_cast(float, w & 0xffff0000u); }
__device__ __forceinline__ float fexp(float x) { return __builtin_amdgcn_exp2f(x * 1.4426950408889634f); }
__device__ __forceinline__ float frcp(float x) { return __builtin_amdgcn_rcpf(x); }
__device__ __forceinline__ float sigm(float x) { return frcp(1.0f + fexp(-x)); }
__device__ __forceinline__ float silu(float x) { return x * frcp(1.0f + fexp(-x)); }
__device__ __forceinline__ float softplus(float x) { return fmaxf(x, 0.f) + __builtin_amdgcn_logf(1.0f + fexp(-fabsf(x))) * 0.6931471805599453f; }
__device__ __forceinline__ float gelu_tanh(float x) { const float u = 0.7978845608028654f * (x + 0.044715f * x * x * x); return x * frcp(1.0f + fexp(-2.0f * u)); }
__device__ __forceinline__ float neg_expm1(float x) { const float s = -x * (1.0f + x * (0.5f + x * (0.16666667f + x * 0.041666668f))); const float d = 1.0f - fexp(x); return fabsf(x) < 0.03f ? s : d; }
__device__ __forceinline__ float fsqrt(float x) { return __builtin_amdgcn_sqrtf(x); }
__device__ __forceinline__ float frsq(float x) { return __builtin_amdgcn_rsqf(x); }
__device__ __forceinline__ float wave_sum(float v) {
#pragma unroll
    for (int o = 1; o < 64; o <<= 1) v += __shfl_xor(v, o);
    return v;
}

__device__ __forceinline__ int opaque_tid() { int t = threadIdx.x; asm volatile("" : "+v"(t)); return t; }
typedef short bf16x8 __attribute__((ext_vector_type(8)));
typedef short bf16x4 __attribute__((ext_vector_type(4)));
typedef float f32x2 __attribute__((ext_vector_type(2)));
typedef unsigned v2u __attribute__((ext_vector_type(2)));
__device__ __forceinline__ f32x4 mfma32(bf16x8 x, bf16x8 y, f32x4 c) { return __builtin_amdgcn_mfma_f32_16x16x32_bf16(x, y, c, 0, 0, 0); }
__device__ __forceinline__ f32x4 mfma16(bf16x4 x, bf16x4 y, f32x4 c) { return __builtin_amdgcn_mfma_f32_16x16x16bf16_1k(x, y, c, 0, 0, 0); }
typedef short v4i16_t __attribute__((ext_vector_type(4)));
__device__ __forceinline__ bf16x8 tr_frag(const LAS bf16* p, int pitch) {
    const v4i16_t x = __builtin_amdgcn_ds_read_tr16_b64_v4i16((LAS v4i16_t*)p), y = __builtin_amdgcn_ds_read_tr16_b64_v4i16((LAS v4i16_t*)(p + 4 * pitch));
    return (bf16x8){x[0], x[1], x[2], x[3], y[0], y[1], y[2], y[3]};
}
#define PIN_MEM() asm volatile("" ::: "memory")
struct Args { const float* in[31]; float* out; unsigned char* ws; int ph_lo, ph_hi; };
enum { I_X = 0, I_NORMW, I_WIN, I_LCW, I_LCB, I_LWR, I_LBR, I_LWI, I_LBI, I_LL, I_SLR, I_SLI, I_SLDT, I_SBR, I_SBI, I_SCR, I_SCI, I_SD, I_SGW, I_SGB,
       I_GWG, I_GBG, I_GNW, I_DCW, I_DCB, I_DDTB, I_DALOG, I_DD, I_DNW, I_WOUT, I_NFW };

template <bool MAPPED>
__device__ __forceinline__ void p0_transpose_item(const float* W, int K, int ldw, int nblk, const float* kscale, bf16* WT, LAS float* scr, int item, int lane) {
    const int kb = item / nblk, nb = item % nblk, k0 = 64 * kb, n0 = 32 * nb;
    const int myc = n0 + (lane & 31); const int oc = MAPPED ? orig_col(myc) : myc;
    const int c = lane & 7; float ksc[8];
    { float vv[32]; const int occ = oc >= 0 ? oc : 0;
#pragma unroll
      for (int i = 0; i < 32; ++i) { const int kk = 2 * i + (lane >> 5); vv[i] = W[(size_t)(k0 + kk) * ldw + occ]; }
#pragma unroll
      for (int q = 0; q < 8; ++q) ksc[q] = kscale ? kscale[k0 + 8 * c + q] : 1.0f;
      PIN_MEM();
#pragma unroll
      for (int i = 0; i < 32; ++i) { const int kk = 2 * i + (lane >> 5); scr[kk * 33 + (lane & 31)] = oc >= 0 ? vv[i] : 0.f; } }
    asm volatile("s_waitcnt lgkmcnt(0)" ::: "memory");
#pragma unroll
    for (int j = 0; j < 4; ++j) { const int n = (lane >> 3) + 8 * j; const LAS float* s = scr + (8 * c) * 33 + n;
        v4u o; o.x = pk2(s[0 * 33] * ksc[0], s[1 * 33] * ksc[1]); o.y = pk2(s[2 * 33] * ksc[2], s[3 * 33] * ksc[3]); o.z = pk2(s[4 * 33] * ksc[4], s[5 * 33] * ksc[5]); o.w = pk2(s[6 * 33] * ksc[6], s[7 * 33] * ksc[7]);
        *(GAS v4u*)(WT + (size_t)(n0 + n) * K + k0 + 8 * c) = o; }
    asm volatile("s_waitcnt lgkmcnt(0)" ::: "memory");
}

__device__ __forceinline__ void p0_s5_tables(const Args& a, LAS unsigned char* lds, int item) {
    const int tid = opaque_tid(); const int l = item >> 6, g = (item >> 1) & 31, dh = item & 1;
    LAS f32x2* P = (LAS f32x2*)lds;
    LAS f32x2* BL = P + 32 * 64;
    LAS f32x2* CL = BL + 64 * 16;
    unsigned char* tb = a.ws + WS_S5T + (size_t)l * S5T_LAYER;
    const float dt = expf(a.in[I_SLDT][l * 32 + g]);
    const float* LR = a.in[I_SLR] + l * 2048 + g * 64; const float* LI = a.in[I_SLI] + l * 2048 + g * 64;
    for (int idx = tid; idx < 2048; idx += NTHR) { const int dd = idx >> 6, n = idx & 63, d = dh * 32 + dd;
        const float m = expf(LR[n] * dt * (float)d), ang = LI[n] * dt * (float)d; const f32x2 v = {m * cosf(ang), m * sinf(ang)}; P[dd * 64 + n] = v;
        if (dh == 0 && d <= 16) ((f32x2*)(tb + S5T_PW))[(g * 64 + n) * 17 + d] = v;
        if (dh == 0 && d == 1) ((f32x2*)(tb + S5T_AB))[g * 64 + n] = v; }
    for (int idx = tid; idx < 1024; idx += NTHR) { const int n = idx >> 4, q = idx & 15; const float lr = LR[n], li = LI[n];
        const float mag = expf(lr * dt), abr = mag * cosf(li * dt), abi = mag * sinf(li * dt), den = lr * lr + li * li, nr = abr - 1.0f;
        const float cr = (nr * lr + abi * li) / den, ci = (abi * lr - nr * li) / den;
        const float br = a.in[I_SBR][((size_t)(l * 32 + g) * 64 + n) * 16 + q], bi = a.in[I_SBI][((size_t)(l * 32 + g) * 64 + n) * 16 + q];
        const f32x2 v = {cr * br - ci * bi, cr * bi + ci * br}; BL[n * 16 + q] = v;
        if (dh == 0) { bf16* BC = (bf16*)(tb + S5T_BC); BC[(g * 128 + n) * 16 + q] = (bf16)f2bf(v.x); BC[(g * 128 + 64 + n) * 16 + q] = (bf16)f2bf(v.y); } }
    for (int idx = tid; idx < 1024; idx += NTHR) { const int p = idx >> 6, n = idx & 63;
        const f32x2 v = {a.in[I_SCR][((size_t)(l * 32 + g) * 16 + p) * 64 + n], a.in[I_SCI][((size_t)(l * 32 + g) * 16 + p) * 64 + n]}; CL[p * 64 + n] = v;
        if (dh == 0) { bf16* CC = (bf16*)(tb + S5T_CC); CC[(g * 16 + p) * 128 + 2 * n] = (bf16)f2bf(v.x); CC[(g * 16 + p) * 128 + 2 * n + 1] = (bf16)f2bf(-v.y); } }
    if (dh == 0 && tid < 64) { const float m64 = expf(64.0f * LR[tid] * dt), ang = 64.0f * LI[tid] * dt; const f32x2 v = {m64 * cosf(ang), m64 * sinf(ang)}; ((f32x2*)(tb + S5T_A64))[g * 64 + tid] = v; }
    __syncthreads();
    { const int pq = tid & 255, p = pq >> 4, q = pq & 15, dq = tid >> 8; float s[16];
#pragma unroll
      for (int i = 0; i < 16; ++i) s[i] = 0.f;
#pragma unroll 1
      for (int nh = 0; nh < 4; ++nh) { float cbr[16], cbi[16];
#pragma unroll
          for (int n = 0; n < 16; ++n) { const f32x2 cv = CL[p * 64 + nh * 16 + n], bv = BL[(nh * 16 + n) * 16 + q]; cbr[n] = cv.x * bv.x - cv.y * bv.y; cbi[n] = cv.x * bv.y + cv.y * bv.x; }
#pragma unroll
          for (int i = 0; i < 16; ++i) { const LAS f32x2* pp = P + (dq * 16 + i) * 64 + nh * 16; float t = 0.f;
#pragma unroll
              for (int n = 0; n < 16; ++n) { const f32x2 pw = pp[n]; t += cbr[n] * pw.x - cbi[n] * pw.y; }
              s[i] += t; } }
      bf16* KT = (bf16*)(tb + S5T_KT);
#pragma unroll
      for (int i = 0; i < 16; ++i) KT[((size_t)(g * 64 + dh * 32 + dq * 16 + i) * 16 + p) * 16 + q] = (bf16)f2bf(s[i]); }
    __syncthreads();
}

__device__ __forceinline__ void p0_prologue(const Args& a, LAS unsigned char* lds, int vcu, int G) {
    const int tid = opaque_tid(), lane = tid & 63, wave = __builtin_amdgcn_readfirstlane(tid >> 6);
    for (int item = vcu; item < DEPTH * 64; item += G) p0_s5_tables(a, lds, item);
    for (int idx = vcu * NTHR + tid; idx < DEPTH * 2 * 8 * 64 * 64; idx += G * NTHR) { const int i = idx & 63, j = (idx >> 6) & 63, h = (idx >> 12) & 7, gate = (idx >> 15) & 1, l = idx >> 16;
        ((bf16*)(a.ws + WS_LRW))[idx] = (bf16)f2bf(a.in[gate ? I_LWI : I_LWR][((size_t)(l * 8 + h) * 64 + i) * 64 + j]); }
    LAS float* scr = (LAS float*)(lds + wave * 16384);
    const int gw = vcu * NWAVES + wave, NGW = G * NWAVES;
    for (int it = gw; it < DEPTH * 128; it += NGW) { const int l = it >> 7;
        p0_transpose_item<false>(a.in[I_SGW] + (size_t)l * 512 * 512, 512, 512, 16, nullptr, (bf16*)(a.ws + WS_GLUT) + (size_t)l * 512 * 512, scr, it & 127, lane); }
    constexpr int I_IN = (DM / 64) * (NPAD / 32), I_OUT = (2048 / 64) * (DM / 32);
    for (int it = gw; it < DEPTH * (I_IN + I_OUT); it += NGW) {
        const int l = it / (I_IN + I_OUT); int r = it % (I_IN + I_OUT);
        if (r < I_IN) p0_transpose_item<true>(a.in[I_WIN] + (size_t)l * DM * DIN, DM, DIN, NPAD / 32, a.in[I_NORMW] + l * DM, (bf16*)(a.ws + WS_WIN) + (size_t)l * NPAD * DM, scr, r, lane);
        else p0_transpose_item<false>(a.in[I_WOUT] + (size_t)l * 2048 * DM, 2048, DM, DM / 32, nullptr, (bf16*)(a.ws + WS_WOUT) + (size_t)l * DM * 2048, scr, r - I_IN, lane);
    }
    float* rowss0 = (float*)(a.ws + WS_PART);
    for (int m0 = gw; m0 < T; m0 += 4 * NGW) {
        f32x4 v[4][4];
#pragma unroll
        for (int r = 0; r < 4; ++r)
#pragma unroll
            for (int j = 0; j < 4; ++j) v[r][j] = ((const GAS f32x4*)(a.in[I_X] + (size_t)(m0 + r * NGW) * DM) + lane)[64 * j];
        PIN_MEM();
#pragma unroll
        for (int r = 0; r < 4; ++r) { const int m = m0 + r * NGW; float s = 0.f;
            GAS unsigned long long* o8 = (GAS unsigned long long*)((bf16*)a.out + (size_t)m * DM) + lane;
#pragma unroll
            for (int j = 0; j < 4; ++j) { const f32x4 x = v[r][j]; s += (x.x * x.x + x.y * x.y) + (x.z * x.z + x.w * x.w);
                o8[64 * j] = (unsigned long long)pk2(x.x, x.y) | ((unsigned long long)pk2(x.z, x.w) << 32); }
            s = wave_sum(s); if (lane < 16) rowss0[(size_t)m * 16 + lane] = lane == 0 ? s : 0.f; }
    }
}

__device__ __forceinline__ void ex_chunk(const Args& a, int l, int c) {
    const int tid = opaque_tid(), lane = tid & 63, w = __builtin_amdgcn_readfirstlane(tid >> 6), l15 = lane & 15, lq = lane >> 4;
    const int nt = w & 1, tt = w >> 1, t = c * 64 + 16 * tt + l15;
    const bf16* wp = (const bf16*)(a.ws + WS_WIN) + ((size_t)l * NPAD + PJ + 16 * nt + l15) * DM + 8 * lq;
    const bf16* xp = (const bf16*)a.out + (size_t)t * DM + 8 * lq;
    const float* rs = (const float*)(a.ws + WS_PART) + (size_t)l * T * 16 + (size_t)t * 16;
    const f32x4 p0 = *(const GAS f32x4*)(rs), p1 = *(const GAS f32x4*)(rs + 4), p2 = *(const GAS f32x4*)(rs + 8), p3 = *(const GAS f32x4*)(rs + 12);
    f32x4 acc = (f32x4){0.f, 0.f, 0.f, 0.f};
#pragma unroll 1
    for (int kb = 0; kb < 4; ++kb) { bf16x8 xf[8], yf[8];
#pragma unroll
        for (int k8 = 0; k8 < 8; ++k8) { xf[k8] = *(const GAS bf16x8*)(wp + 32 * (kb * 8 + k8)); yf[k8] = *(const GAS bf16x8*)(xp + 32 * (kb * 8 + k8)); }
        PIN_MEM();
#pragma unroll
        for (int k8 = 0; k8 < 8; ++k8) acc = mfma32(xf[k8], yf[k8], acc); }
    const float rsum = (((p0[0] + p0[1]) + (p0[2] + p0[3])) + ((p1[0] + p1[1]) + (p1[2] + p1[3]))) + (((p2[0] + p2[1]) + (p2[2] + p2[3])) + ((p3[0] + p3[1]) + (p3[2] + p3[3])));
    const float rstd = frsq(rsum * (1.0f / 1024.0f) + EPS);
    *(GAS f32x4*)((float*)(a.ws + WS_EX) + (size_t)t * 32 + 16 * nt + 4 * lq) = acc * rstd;
}

template <int CTRL> __device__ __forceinline__ float dppf(float old, float v) { return __builtin_bit_cast(float, __builtin_amdgcn_update_dpp(__builtin_bit_cast(int, old), __builtin_bit_cast(int, v), CTRL, 0xF, 0xF, false)); }
#define LRU_SCAN_STEP(CTRL) do { const float Ap = dppf<CTRL>(1.0f, A[mt]), Bp = dppf<CTRL>(0.0f, B[mt]); B[mt] = A[mt] * Bp + B[mt]; A[mt] = A[mt] * Ap; } while (0)
__device__ __forceinline__ void lru_chunk(const Args& a, int l, int c, bool fin, LAS unsigned char* lds, bool dry = false, bool conv_only = false) {
    const int tid = opaque_tid(), lane = tid & 63, h = __builtin_amdgcn_readfirstlane(tid >> 6), l15 = lane & 15, lq = lane >> 4;
    const int t0 = c * 64; const bool hp = (c % CPB) != 0;
    bf16* PR = (bf16*)(a.ws + WS_PROJ);
    bf16x8 yf[4][2];
#pragma unroll
    for (int ks = 0; ks < 2; ++ks) {
        const int i0 = h * 64 + 32 * ks + 8 * lq; float cw[4][8], cb[8];
#pragma unroll
        for (int v = 0; v < 4; ++v) { const f32x4 w0 = *(const GAS f32x4*)(a.in[I_LCW] + (size_t)(l * 4 + v) * 512 + i0), w1 = *(const GAS f32x4*)(a.in[I_LCW] + (size_t)(l * 4 + v) * 512 + i0 + 4);
            cw[v][0] = w0[0]; cw[v][1] = w0[1]; cw[v][2] = w0[2]; cw[v][3] = w0[3]; cw[v][4] = w1[0]; cw[v][5] = w1[1]; cw[v][6] = w1[2]; cw[v][7] = w1[3]; }
        { const f32x4 b0 = *(const GAS f32x4*)(a.in[I_LCB] + l * 512 + i0), b1 = *(const GAS f32x4*)(a.in[I_LCB] + l * 512 + i0 + 4);
          cb[0] = b0[0]; cb[1] = b0[1]; cb[2] = b0[2]; cb[3] = b0[3]; cb[4] = b1[0]; cb[5] = b1[1]; cb[6] = b1[2]; cb[7] = b1[3]; }
#pragma unroll
        for (int mt = 0; mt < 4; ++mt) { const int t = 16 * mt + l15; float u[8];
#pragma unroll
            for (int q = 0; q < 8; ++q) u[q] = cb[q];
#pragma unroll
            for (int v = 0; v < 4; ++v) { const int tt = t - 3 + v; const int row = (t0 + tt) < 0 ? 0 : (t0 + tt);
                v4u raw = *(const GAS v4u*)(PR + (size_t)row * PJ + A_X + i0);
                if (!(tt >= 0 || hp)) raw = (v4u){0u, 0u, 0u, 0u};
                u[0] += cw[v][0] * bflo(raw.x); u[1] += cw[v][1] * bfhi(raw.x); u[2] += cw[v][2] * bflo(raw.y); u[3] += cw[v][3] * bfhi(raw.y);
                u[4] += cw[v][4] * bflo(raw.z); u[5] += cw[v][5] * bfhi(raw.z); u[6] += cw[v][6] * bflo(raw.w); u[7] += cw[v][7] * bfhi(raw.w); }
            v4u pk; pk.x = pk2(u[0], u[1]); pk.y = pk2(u[2], u[3]); pk.z = pk2(u[4], u[5]); pk.w = pk2(u[6], u[7]); yf[mt][ks] = __builtin_bit_cast(bf16x8, pk); }
    }
    if (conv_only) {
#pragma unroll
        for (int mt = 0; mt < 4; ++mt) { asm volatile("" :: "v"(yf[mt][0]), "v"(yf[mt][1])); }
        return; }
    const bf16* WRt = (const bf16*)(a.ws + WS_LRW) + (size_t)((l * 2 + 0) * 8 + h) * 4096; const bf16* WIt = (const bf16*)(a.ws + WS_LRW) + (size_t)((l * 2 + 1) * 8 + h) * 4096;
#define LRU_LOADS(J, XR, XI, BR, BI, LL) do { const int ch0_ = h * 64 + 16 * (J) + 4 * lq; \
        _Pragma("unroll") for (int ks = 0; ks < 2; ++ks) { XR[ks] = *(const GAS bf16x8*)(WRt + (size_t)(16 * (J) + l15) * 64 + 32 * ks + 8 * lq); XI[ks] = *(const GAS bf16x8*)(WIt + (size_t)(16 * (J) + l15) * 64 + 32 * ks + 8 * lq); } \
        BR = *(const GAS f32x4*)(a.in[I_LBR] + l * 512 + ch0_); BI = *(const GAS f32x4*)(a.in[I_LBI] + l * 512 + ch0_); LL = *(const GAS f32x4*)(a.in[I_LL] + l * 512 + ch0_); \
        } while (0)
    bf16x8 cxr[2], cxi[2], nxr[2], nxi[2]; f32x4 br4, bi4, ll4, nbr, nbi, nll;
    LRU_LOADS(0, cxr, cxi, br4, bi4, ll4);
#pragma unroll 1
    for (int jt = 0; jt < 4; ++jt) {
        const int jn = jt < 3 ? jt + 1 : 3;
        LRU_LOADS(jn, nxr, nxi, nbr, nbi, nll);
        const int ch0 = h * 64 + 16 * jt + 4 * lq;
        f32x4 hin4 = (f32x4){0.f, 0.f, 0.f, 0.f}; v2u czv[4];
#pragma unroll
        for (int mt = 0; mt < 4; ++mt) czv[mt] = (v2u){0u, 0u};
        if (fin) { hin4 = *(const GAS f32x4*)((const float*)(a.ws + WS_LRUH) + (size_t)c * 512 + ch0);
#pragma unroll
            for (int mt = 0; mt < 4; ++mt) czv[mt] = *(const GAS v2u*)(PR + (size_t)(t0 + 16 * mt + l15) * PJ + A_Z + ch0); }
        PIN_MEM();
        f32x4 ar[4], ai[4], au[4];
#pragma unroll
        for (int mt = 0; mt < 4; ++mt) { ar[mt] = (f32x4){0.f, 0.f, 0.f, 0.f}; ai[mt] = ar[mt]; au[mt] = ar[mt]; }
#pragma unroll
        for (int ks = 0; ks < 2; ++ks) {
            bf16x8 xu = (bf16x8){0, 0, 0, 0, 0, 0, 0, 0};
#pragma unroll
            for (int e = 0; e < 8; ++e) xu[e] = (32 * ks + 8 * lq + e == 16 * jt + l15) ? (short)0x3F80 : (short)0;
#pragma unroll
            for (int mt = 0; mt < 4; ++mt) { ar[mt] = mfma32(cxr[ks], yf[mt][ks], ar[mt]); ai[mt] = mfma32(cxi[ks], yf[mt][ks], ai[mt]); au[mt] = mfma32(xu, yf[mt][ks], au[mt]); }
        }
        float hv[4][4]; unsigned cpk[4][4];
#pragma unroll
        for (int r = 0; r < 4; ++r) {
            const float sp = softplus(-ll4[r]); float A[4], B[4];
#pragma unroll
            for (int mt = 0; mt < 4; ++mt) { const float rg = sigm(ar[mt][r] + br4[r]), ig = sigm(ai[mt][r] + bi4[r]); const float la = -8.0f * rg * sp;
                A[mt] = fexp(la); B[mt] = fsqrt(neg_expm1(2.0f * la)) * ig * au[mt][r]; }
#pragma unroll
            for (int mt = 0; mt < 4; ++mt) { LRU_SCAN_STEP(0x111); LRU_SCAN_STEP(0x112); LRU_SCAN_STEP(0x114); LRU_SCAN_STEP(0x118); }
            float Ac = 1.0f, Bc = 0.0f;
#pragma unroll
            for (int mt = 0; mt < 4; ++mt) { B[mt] = A[mt] * Bc + B[mt]; A[mt] = A[mt] * Ac; Ac = __shfl(A[mt], (lane & 48) | 15); Bc = __shfl(B[mt], (lane & 48) | 15); }
            if (fin) {
#pragma unroll
                for (int mt = 0; mt < 4; ++mt) hv[mt][r] = B[mt] + A[mt] * hin4[r];
            } else {
#pragma unroll
                for (int mt = 0; mt < 4; ++mt) cpk[mt][r] = pk2(A[mt], B[mt]);
                if (l15 == 15) { float* E = (float*)(a.ws + WS_LRUE) + ((size_t)c * 512 + ch0 + r) * 2; E[0] = A[3]; E[1] = B[3]; }
            }
        }
        if (!fin) {
#pragma unroll
            for (int mt = 0; mt < 4; ++mt) { v4u o; o.x = cpk[mt][0]; o.y = cpk[mt][1]; o.z = cpk[mt][2]; o.w = cpk[mt][3];
                *(GAS v4u*)((unsigned*)a.out + (size_t)8388608 + (size_t)(t0 + 16 * mt + l15) * 512 + ch0) = o; }
        }
        if (fin) {
#pragma unroll
            for (int mt = 0; mt < 4; ++mt) { GAS v2u* zp = (GAS v2u*)(PR + (size_t)(t0 + 16 * mt + l15) * PJ + A_Z + ch0); const v2u zv = czv[mt];
                v2u o; o.x = pk2(hv[mt][0] * silu(bflo(zv.x)), hv[mt][1] * silu(bfhi(zv.x))); o.y = pk2(hv[mt][2] * silu(bflo(zv.y)), hv[mt][3] * silu(bfhi(zv.y))); if (dry) asm volatile("" :: "v"(o.x), "v"(o.y)); else *zp = o; }
        }
#pragma unroll
        for (int ks = 0; ks < 2; ++ks) { cxr[ks] = nxr[ks]; cxi[ks] = nxi[ks]; }
        br4 = nbr; bi4 = nbi; ll4 = nll;
    }
#undef LRU_LOADS
}

__device__ __forceinline__ void lru_out(const Args& a, int l, int c, bool dry = false) {
    const int tid = opaque_tid(), cg = tid & 63, tq = tid >> 6; const int t0 = c * 64;
    bf16* PR = (bf16*)(a.ws + WS_PROJ); const unsigned* LC = (const unsigned*)a.out + (size_t)8388608;
    const f32x4 h0 = *(const GAS f32x4*)((const float*)(a.ws + WS_LRUH) + (size_t)c * 512 + 8 * cg), h1 = *(const GAS f32x4*)((const float*)(a.ws + WS_LRUH) + (size_t)c * 512 + 8 * cg + 4);
    v4u p0[8], p1[8], zz[8];
#pragma unroll
    for (int i = 0; i < 8; ++i) { const size_t t = (size_t)(t0 + 8 * tq + i);
        p0[i] = *(const GAS v4u*)(LC + t * 512 + 8 * cg); p1[i] = *(const GAS v4u*)(LC + t * 512 + 8 * cg + 4); zz[i] = *(const GAS v4u*)(PR + t * PJ + A_Z + 8 * cg); }
    PIN_MEM();
#pragma unroll
    for (int i = 0; i < 8; ++i) { const size_t t = (size_t)(t0 + 8 * tq + i);
        const float y0 = (bfhi(p0[i].x) + bflo(p0[i].x) * h0[0]) * silu(bflo(zz[i].x)), y1 = (bfhi(p0[i].y) + bflo(p0[i].y) * h0[1]) * silu(bfhi(zz[i].x));
        const float y2 = (bfhi(p0[i].z) + bflo(p0[i].z) * h0[2]) * silu(bflo(zz[i].y)), y3 = (bfhi(p0[i].w) + bflo(p0[i].w) * h0[3]) * silu(bfhi(zz[i].y));
        const float y4 = (bfhi(p1[i].x) + bflo(p1[i].x) * h1[0]) * silu(bflo(zz[i].z)), y5 = (bfhi(p1[i].y) + bflo(p1[i].y) * h1[1]) * silu(bfhi(zz[i].z));
        const float y6 = (bfhi(p1[i].z) + bflo(p1[i].z) * h1[2]) * silu(bflo(zz[i].w)), y7 = (bfhi(p1[i].w) + bflo(p1[i].w) * h1[3]) * silu(bfhi(zz[i].w));
        v4u o; o.x = pk2(y0, y1); o.y = pk2(y2, y3); o.z = pk2(y4, y5); o.w = pk2(y6, y7);
        if (dry) asm volatile("" :: "v"(o.x), "v"(o.y), "v"(o.z), "v"(o.w)); else *(GAS v4u*)(PR + t * PJ + A_Z + 8 * cg) = o; }
}

constexpr int UBP = 520;
__device__ __forceinline__ void s5_local(const Args& a, int l, int c) {
    const int tid = opaque_tid(), lane = tid & 63, w = __builtin_amdgcn_readfirstlane(tid >> 6), l15 = lane & 15, lq = lane >> 4;
    const int t0 = c * 64;
    const bf16* PR = (const bf16*)(a.ws + WS_PROJ);
    const unsigned char* tb = a.ws + WS_S5T + (size_t)l * S5T_LAYER;
    const bf16* BC = (const bf16*)(tb + S5T_BC); const f32x2* PW = (const f32x2*)(tb + S5T_PW);
    f32x2* ST = (f32x2*)(a.ws + WS_S5ST) + (size_t)c * 2048;
#pragma unroll 2
    for (int k = 0; k < 4; ++k) {
        const int g = 4 * w + k; bf16x4 yf[4], xr[4], xi[4]; f32x2 wb[4][4], st[4][4];
#pragma unroll
        for (int nt = 0; nt < 4; ++nt) yf[nt] = *(const GAS bf16x4*)(PR + (size_t)(t0 + 16 * nt + l15) * PJ + B_U + g * 16 + 4 * lq);
#pragma unroll
        for (int mt = 0; mt < 4; ++mt) { xr[mt] = *(const GAS bf16x4*)(BC + ((size_t)g * 128 + 16 * mt + l15) * 16 + 4 * lq); xi[mt] = *(const GAS bf16x4*)(BC + ((size_t)g * 128 + 64 + 16 * mt + l15) * 16 + 4 * lq);
#pragma unroll
            for (int r = 0; r < 4; ++r) { const int n = 16 * mt + 4 * lq + r; wb[mt][r] = PW[(g * 64 + n) * 17 + (15 - l15)]; st[mt][r] = PW[(g * 64 + n) * 17 + 16]; } }
        PIN_MEM();
#pragma unroll
        for (int mt = 0; mt < 4; ++mt) {
            f32x4 ar[4], ai[4];
#pragma unroll
            for (int nt = 0; nt < 4; ++nt) { ar[nt] = mfma16(xr[mt], yf[nt], (f32x4){0.f, 0.f, 0.f, 0.f}); ai[nt] = mfma16(xi[mt], yf[nt], (f32x4){0.f, 0.f, 0.f, 0.f}); }
#pragma unroll
            for (int r = 0; r < 4; ++r) {
                const int n = 16 * mt + 4 * lq + r; const f32x2 s16 = st[mt][r];
                float er = 0.f, ei = 0.f, wr = wb[mt][r].x, wi = wb[mt][r].y;
#pragma unroll
                for (int nt = 3; nt >= 0; --nt) { const float br = ar[nt][r], bi = ai[nt][r]; er += wr * br - wi * bi; ei += wr * bi + wi * br;
                    const float nwr = wr * s16.x - wi * s16.y, nwi = wr * s16.y + wi * s16.x; wr = nwr; wi = nwi; }
                er += dppf<0x111>(0.f, er); ei += dppf<0x111>(0.f, ei); er += dppf<0x112>(0.f, er); ei += dppf<0x112>(0.f, ei);
                er += dppf<0x114>(0.f, er); ei += dppf<0x114>(0.f, ei); er += dppf<0x118>(0.f, er); ei += dppf<0x118>(0.f, ei);
                if (l15 == 15) { const f32x2 v = {er, ei}; ST[g * 64 + n] = v; }
            }
        }
    }
}
__device__ __forceinline__ void s5_out(const Args& a, int l, int c, LAS unsigned char* lds, bool dry = false) {
    const int tid = opaque_tid(), lane = tid & 63, w = __builtin_amdgcn_readfirstlane(tid >> 6), l15 = lane & 15, lq = lane >> 4;
    const int t0 = c * 64;
    LAS bf16* ub = (LAS bf16*)lds;
    bf16* PR = (bf16*)(a.ws + WS_PROJ);
    { v4u ut[8];
#pragma unroll
      for (int i = 0; i < 8; ++i) { const int idx = tid + NTHR * i, row = idx >> 6, c8 = idx & 63; ut[i] = *(const GAS v4u*)(PR + (size_t)(t0 + row) * PJ + B_U + c8 * 8); }
      PIN_MEM();
      for (int idx = tid; idx < 16 * 65; idx += NTHR) { const int row = idx / 65, c8 = idx % 65; *(LAS v4u*)(ub + row * UBP + c8 * 8) = (v4u){0u, 0u, 0u, 0u}; }
#pragma unroll
      for (int i = 0; i < 8; ++i) { const int idx = tid + NTHR * i, row = idx >> 6, c8 = idx & 63; *(LAS v4u*)(ub + (16 + row) * UBP + c8 * 8) = ut[i]; } }
    __syncthreads();
    const unsigned char* tb = a.ws + WS_S5T + (size_t)l * S5T_LAYER;
    const bf16* KT = (const bf16*)(tb + S5T_KT); const bf16* CC = (const bf16*)(tb + S5T_CC); const f32x2* PW = (const f32x2*)(tb + S5T_PW);
    const f32x2* ST = (const f32x2*)(a.ws + WS_S5ST) + (size_t)c * 2048;
#define S5_KLOAD(dst, kb) do { _Pragma("unroll") for (int k8 = 0; k8 < 8; ++k8) dst[k8] = *(const GAS bf16x8*)(kp + (size_t)(2 * ((kb) * 8 + k8)) * 256); } while (0)
#define S5_KMMA(src, kb) do { _Pragma("unroll") for (int k8 = 0; k8 < 8; ++k8) { _Pragma("unroll") for (int it = (kb); it < 4; ++it) { \
        const bf16x8 yf = *(const LAS bf16x8*)(up + (16 * it - 2 * ((kb) * 8 + k8)) * UBP); acc[it] = mfma32(src[k8], yf, acc[it]); } } } while (0)
#pragma unroll 1
    for (int k = 0; k < 4; ++k) {
        const int g = 4 * w + k; f32x4 acc[4];
#pragma unroll
        for (int it = 0; it < 4; ++it) acc[it] = (f32x4){0.f, 0.f, 0.f, 0.f};
        const bf16* kp = KT + ((size_t)(g * 64 + (lq >> 1)) * 16 + l15) * 16 + 8 * (lq & 1);
        const LAS bf16* up = ub + (16 + l15 - (lq >> 1)) * UBP + g * 16 + 8 * (lq & 1);
        bf16x8 ka[8], kc[8];
        S5_KLOAD(ka, 0); S5_KLOAD(kc, 1); PIN_MEM();
        S5_KMMA(ka, 0);
        S5_KLOAD(ka, 2); PIN_MEM();
        S5_KMMA(kc, 1);
        bf16x8 xfc[4]; f32x2 pb[4][4], ps[4][4], sv[4][4];
        S5_KLOAD(kc, 3);
#pragma unroll
        for (int ks2 = 0; ks2 < 4; ++ks2) { xfc[ks2] = *(const GAS bf16x8*)(CC + ((size_t)g * 16 + l15) * 128 + 32 * ks2 + 8 * lq);
#pragma unroll
            for (int m = 0; m < 4; ++m) { const int n = 16 * ks2 + 4 * lq + m; pb[ks2][m] = PW[(g * 64 + n) * 17 + l15 + 1]; ps[ks2][m] = PW[(g * 64 + n) * 17 + 16]; sv[ks2][m] = ST[g * 64 + n]; } }
        const f32x4 dsk = *(const GAS f32x4*)(a.in[I_SD] + l * 512 + g * 16 + 4 * lq);
        PIN_MEM();
        S5_KMMA(ka, 2);
        S5_KMMA(kc, 3);
#pragma unroll
        for (int ks2 = 0; ks2 < 4; ++ks2) {
            float pr[4], pi[4];
#pragma unroll
            for (int m = 0; m < 4; ++m) { pr[m] = pb[ks2][m].x; pi[m] = pb[ks2][m].y; }
#pragma unroll
            for (int it = 0; it < 4; ++it) {
                v4u zz; unsigned zw[4];
#pragma unroll
                for (int m = 0; m < 4; ++m) { const float sr = sv[ks2][m].x, si = sv[ks2][m].y, qr = ps[ks2][m].x, qi = ps[ks2][m].y;
                    const float zr = pr[m] * sr - pi[m] * si, zi = pr[m] * si + pi[m] * sr; zw[m] = pk2_sw(zr, zi);
                    const float nr = pr[m] * qr - pi[m] * qi, ni = pr[m] * qi + pi[m] * qr; pr[m] = nr; pi[m] = ni; }
                zz.x = zw[0]; zz.y = zw[1]; zz.z = zw[2]; zz.w = zw[3];
                acc[it] = mfma32(xfc[ks2], __builtin_bit_cast(bf16x8, zz), acc[it]);
            }
        }
#pragma unroll
        for (int it = 0; it < 4; ++it) { LAS v2u* p = (LAS v2u*)(ub + (16 + 16 * it + l15) * UBP + g * 16 + 4 * lq); const v2u uv = *p;
            const float y0 = gelu_tanh(acc[it][0] + dsk[0] * bflo(uv.x)), y1 = gelu_tanh(acc[it][1] + dsk[1] * bfhi(uv.x)), y2 = gelu_tanh(acc[it][2] + dsk[2] * bflo(uv.y)), y3 = gelu_tanh(acc[it][3] + dsk[3] * bfhi(uv.y));
            v2u o; o.x = pk2(y0, y1); o.y = pk2(y2, y3); *p = o; }
    }
#undef S5_KLOAD
#undef S5_KMMA
    {
        f32x4 acc[4][4]; v2u zv[4][4]; f32x4 gb[4];
        const bf16* wp = (const bf16*)(a.ws + WS_GLUT) + (size_t)l * 512 * 512 + (size_t)(64 * w + l15) * 512 + 8 * lq;
        bf16x8 xa[4], xb[4];
#pragma unroll
        for (int jt = 0; jt < 4; ++jt) { xa[jt] = *(const GAS bf16x8*)(wp + (size_t)(16 * jt) * 512); gb[jt] = *(const GAS f32x4*)(a.in[I_SGB] + l * 512 + 64 * w + 16 * jt + 4 * lq);
#pragma unroll
            for (int tt = 0; tt < 4; ++tt) { zv[jt][tt] = *(const GAS v2u*)(PR + (size_t)(t0 + 16 * tt + l15) * PJ + B_Z + 64 * w + 16 * jt + 4 * lq); acc[jt][tt] = (f32x4){0.f, 0.f, 0.f, 0.f}; } }
        PIN_MEM();
        __syncthreads();
        const LAS bf16* yp = ub + (16 + l15) * UBP + 8 * lq;
#define S5_GMMA(xf, ks) do { bf16x8 yf[4]; _Pragma("unroll") for (int tt = 0; tt < 4; ++tt) yf[tt] = *(const LAS bf16x8*)(yp + (16 * tt) * UBP + 32 * (ks)); \
        _Pragma("unroll") for (int jt = 0; jt < 4; ++jt) _Pragma("unroll") for (int tt = 0; tt < 4; ++tt) acc[jt][tt] = mfma32(xf[jt], yf[tt], acc[jt][tt]); } while (0)
#pragma unroll 1
        for (int k2 = 0; k2 < 8; ++k2) {
#pragma unroll
            for (int jt = 0; jt < 4; ++jt) xb[jt] = *(const GAS bf16x8*)(wp + (size_t)(16 * jt) * 512 + 32 * (2 * k2 + 1));
            PIN_MEM();
            S5_GMMA(xa, 2 * k2);
            const int kn = k2 < 7 ? 2 * k2 + 2 : 15;
#pragma unroll
            for (int jt = 0; jt < 4; ++jt) xa[jt] = *(const GAS bf16x8*)(wp + (size_t)(16 * jt) * 512 + 32 * kn);
            PIN_MEM();
            S5_GMMA(xb, 2 * k2 + 1);
        }
#undef S5_GMMA
#pragma unroll
        for (int jt = 0; jt < 4; ++jt) { const int j0 = 64 * w + 16 * jt + 4 * lq;
#pragma unroll
            for (int tt = 0; tt < 4; ++tt) { const int t = 16 * tt + l15; const v2u yv = *(const LAS v2u*)(ub + (16 + t) * UBP + j0);
                GAS v2u* zp = (GAS v2u*)(PR + (size_t)(t0 + t) * PJ + B_Z + j0); const v2u zz = zv[jt][tt];
                const float o0 = bflo(yv.x) * sigm(acc[jt][tt][0] + gb[jt][0]) * silu(bflo(zz.x)), o1 = bfhi(yv.x) * sigm(acc[jt][tt][1] + gb[jt][1]) * silu(bfhi(zz.x));
                const float o2 = bflo(yv.y) * sigm(acc[jt][tt][2] + gb[jt][2]) * silu(bflo(zz.y)), o3 = bfhi(yv.y) * sigm(acc[jt][tt][3] + gb[jt][3]) * silu(bfhi(zz.y));
                v2u o; o.x = pk2(o0, o1); o.y = pk2(o2, o3); if (dry) asm volatile("" :: "v"(o.x), "v"(o.y)); else *zp = o; } }
    }
    __syncthreads();
}

__device__ __forceinline__ void s5_chunk(const Args& a, int l, int c, bool fin, LAS unsigned char* lds, bool dry = false) { if (fin) s5_out(a, l, c, lds, dry); else s5_local(a, l, c); }

constexpr int QP = 264, VPF = 520, SPP = 72;
constexpr int GLA_QD = 0, GLA_KI = 33792, GLA_VV = 67584, GLA_SS = 134144, GLA_GT = 134144, GLA_GLW = 136192;
__device__ __forceinline__ void gla_chunk(const Args& a, int l, int c, bool fin, LAS unsigned char* lds, bool dry = false) {
    const int tid = opaque_tid(), lane = tid & 63, w = __builtin_amdgcn_readfirstlane(tid >> 6), l15 = lane & 15, lq = lane >> 4; const int t0 = c * 64;
    LAS bf16* QD = (LAS bf16*)(lds + GLA_QD); LAS bf16* KI = (LAS bf16*)(lds + GLA_KI); LAS bf16* VV = (LAS bf16*)(lds + GLA_VV); LAS bf16* SS = (LAS bf16*)(lds + GLA_SS);
    LAS float* GT = (LAS float*)(lds + GLA_GT); LAS float* GLW = (LAS float*)(lds + GLA_GLW);
    bf16* PR = (bf16*)(a.ws + WS_PROJ); const float* EX = (const float*)(a.ws + WS_EX);
    bf16* KV = (bf16*)(a.ws + WS_GLA) + (size_t)c * 32768;
    const int d = tid & 255, half = tid >> 8; float g[32]; unsigned short kraw[32], qraw[32];
    { float wg[16]; v4u vt[8];
      const f32x2 glr = *(const GAS f32x2*)(EX + (size_t)(t0 + (tid >> 3)) * 32 + 2 * (tid & 7));
#pragma unroll
      for (int r = 0; r < 16; ++r) wg[r] = a.in[I_GWG][(size_t)(l * 16 + r) * 256 + d];
      const float bg = a.in[I_GBG][l * 256 + d];
#pragma unroll
      for (int i = 0; i < 8; ++i) { const int idx = tid + NTHR * i, row = idx >> 6, c8 = idx & 63; vt[i] = *(const GAS v4u*)(PR + (size_t)(t0 + row) * PJ + C_V + c8 * 8); }
#pragma unroll
      for (int tt = 0; tt < 32; ++tt) { kraw[tt] = PR[(size_t)(t0 + 32 * half + tt) * PJ + C_K + d]; qraw[tt] = PR[(size_t)(t0 + 32 * half + tt) * PJ + C_Q + d]; }
      PIN_MEM();
      *(LAS f32x2*)(GLW + (tid >> 3) * 16 + 2 * (tid & 7)) = glr;
#pragma unroll
      for (int i = 0; i < 8; ++i) { const int idx = tid + NTHR * i, row = idx >> 6, c8 = idx & 63; *(LAS v4u*)(VV + row * VPF + c8 * 8) = vt[i]; }
      __syncthreads();
      float run = 0.f;
#pragma unroll
      for (int tt = 0; tt < 32; ++tt) { const LAS f32x4* gl = (const LAS f32x4*)(GLW + (32 * half + tt) * 16); const f32x4 g0 = gl[0], g1 = gl[1], g2 = gl[2], g3 = gl[3];
          float lg = bg + ((g0[0] * wg[0] + g0[1] * wg[1]) + (g0[2] * wg[2] + g0[3] * wg[3])) + ((g1[0] * wg[4] + g1[1] * wg[5]) + (g1[2] * wg[6] + g1[3] * wg[7]))
                        + ((g2[0] * wg[8] + g2[1] * wg[9]) + (g2[2] * wg[10] + g2[3] * wg[11])) + ((g3[0] * wg[12] + g3[1] * wg[13]) + (g3[2] * wg[14] + g3[3] * wg[15]));
          run += -softplus(-lg) * (1.0f / 16.0f); g[tt] = run; }
      GT[half * 256 + d] = run; }
    __syncthreads();
    { const float tot0 = GT[d], tot1 = GT[256 + d], off = half ? tot0 : 0.f, glast = tot0 + tot1;
      const float kofs = fin ? 0.f : glast;
#pragma unroll
      for (int tt = 0; tt < 32; ++tt) { const int t = 32 * half + tt; const float gc = g[tt] + off; const float kx = bf2f(kraw[tt]), qx = bf2f(qraw[tt]);
          QD[t * QP + d] = (bf16)f2bf(qx * 0.125f * fexp(gc)); KI[t * QP + d] = (bf16)f2bf(kx * fexp(kofs - gc)); }
      if (!fin && half == 0) ((float*)(a.ws + WS_GDEC))[(size_t)c * 256 + d] = fexp(glast); }
    __syncthreads();
    if (!fin) {
        const int h = w >> 1, eh = w & 1; f32x4 acc[4][4];
#pragma unroll
        for (int dt = 0; dt < 4; ++dt)
#pragma unroll
            for (int et = 0; et < 4; ++et) acc[dt][et] = (f32x4){0.f, 0.f, 0.f, 0.f};
#pragma unroll
        for (int ks = 0; ks < 2; ++ks) { bf16x8 xf[4], yf[4];
#pragma unroll
            for (int dt = 0; dt < 4; ++dt) xf[dt] = tr_frag(KI + (32 * ks + 8 * lq + (l15 >> 2)) * QP + h * 64 + 16 * dt + 4 * (l15 & 3), QP);
#pragma unroll
            for (int et = 0; et < 4; ++et) yf[et] = tr_frag(VV + (32 * ks + 8 * lq + (l15 >> 2)) * VPF + h * 128 + 64 * eh + 16 * et + 4 * (l15 & 3), VPF);
#pragma unroll
            for (int dt = 0; dt < 4; ++dt)
#pragma unroll
                for (int et = 0; et < 4; ++et) acc[dt][et] = mfma32(xf[dt], yf[et], acc[dt][et]); }
#pragma unroll
        for (int dt = 0; dt < 4; ++dt)
#pragma unroll
            for (int et = 0; et < 4; ++et) { v2u o; o.x = pk2(acc[dt][et][0], acc[dt][et][1]); o.y = pk2(acc[dt][et][2], acc[dt][et][3]);
                *(GAS v2u*)(KV + ((size_t)h * 128 + 64 * eh + 16 * et + l15) * 64 + 16 * dt + 4 * lq) = o; }
    } else {
#pragma unroll 1
        for (int rd = 0; rd < 2; ++rd) {
            const int hl = w >> 2, it = w & 3, h = 2 * rd + hl, i = 16 * it + l15; LAS bf16* SSw = SS + w * 16 * SPP;
            bf16x8 pf[2][8]; v2u zv[8]; f32x4 nw[8];
#pragma unroll
            for (int ks = 0; ks < 2; ++ks)
#pragma unroll
                for (int et = 0; et < 8; ++et) pf[ks][et] = *(const GAS bf16x8*)(KV + ((size_t)h * 128 + 16 * et + l15) * 64 + 32 * ks + 8 * lq);
#pragma unroll
            for (int et = 0; et < 8; ++et) { zv[et] = *(const GAS v2u*)(PR + (size_t)(t0 + i) * PJ + C_Z + h * 128 + 16 * et + 4 * lq); nw[et] = *(const GAS f32x4*)(a.in[I_GNW] + l * 128 + 16 * et + 4 * lq); }
            PIN_MEM();
#pragma unroll
            for (int jt = 0; jt < 4; ++jt) { v2u o = (v2u){0u, 0u};
                if (jt <= it) { f32x4 s = (f32x4){0.f, 0.f, 0.f, 0.f};
#pragma unroll
                    for (int ks = 0; ks < 2; ++ks) { const bf16x8 xf = *(const LAS bf16x8*)(KI + (16 * jt + l15) * QP + h * 64 + 32 * ks + 8 * lq), yf = *(const LAS bf16x8*)(QD + (16 * it + l15) * QP + h * 64 + 32 * ks + 8 * lq);
                        s = mfma32(xf, yf, s); }
                    const int j0 = 16 * jt + 4 * lq;
                    o.x = pk2(j0 <= i ? s[0] : 0.f, j0 + 1 <= i ? s[1] : 0.f); o.y = pk2(j0 + 2 <= i ? s[2] : 0.f, j0 + 3 <= i ? s[3] : 0.f); }
                *(LAS v2u*)(SSw + l15 * SPP + 16 * jt + 4 * lq) = o; }
            f32x4 oa[8];
#pragma unroll
            for (int et = 0; et < 8; ++et) oa[et] = (f32x4){0.f, 0.f, 0.f, 0.f};
#pragma unroll
            for (int ks = 0; ks < 2; ++ks) { if (32 * ks <= 16 * it + 15) { const bf16x8 yf = *(const LAS bf16x8*)(SSw + l15 * SPP + 32 * ks + 8 * lq);
#pragma unroll
                for (int et = 0; et < 8; ++et) { const bf16x8 xf = tr_frag(VV + (32 * ks + 8 * lq + (l15 >> 2)) * VPF + h * 128 + 16 * et + 4 * (l15 & 3), VPF); oa[et] = mfma32(xf, yf, oa[et]); } } }
#pragma unroll
            for (int ks = 0; ks < 2; ++ks) { const bf16x8 yf = *(const LAS bf16x8*)(QD + (16 * it + l15) * QP + h * 64 + 32 * ks + 8 * lq);
#pragma unroll
                for (int et = 0; et < 8; ++et) oa[et] = mfma32(pf[ks][et], yf, oa[et]); }
            float ss = 0.f;
#pragma unroll
            for (int et = 0; et < 8; ++et) ss += (oa[et][0] * oa[et][0] + oa[et][1] * oa[et][1]) + (oa[et][2] * oa[et][2] + oa[et][3] * oa[et][3]);
            ss += __shfl_xor(ss, 16); ss += __shfl_xor(ss, 32);
            const float rstd = frsq(ss * (1.0f / 128.0f) + EPS);
#pragma unroll
            for (int et = 0; et < 8; ++et) { GAS v2u* zp = (GAS v2u*)(PR + (size_t)(t0 + i) * PJ + C_Z + h * 128 + 16 * et + 4 * lq);
                v2u o; o.x = pk2(oa[et][0] * rstd * nw[et][0] * silu(bflo(zv[et].x)), oa[et][1] * rstd * nw[et][1] * silu(bfhi(zv[et].x)));
                o.y = pk2(oa[et][2] * rstd * nw[et][2] * silu(bflo(zv[et].y)), oa[et][3] * rstd * nw[et][3] * silu(bfhi(zv[et].y)));
                if (dry) asm volatile("" :: "v"(o.x), "v"(o.y)); else *zp = o; }
        }
    }
    __syncthreads();
}

constexpr int XSP = 520, BMP = 264, MP = 72;
constexpr int SSD_XS = 0, SSD_CM = 66560, SSD_BM = 100352, SSD_M = 100352, SSD_DT = 137216, SSD_AC = 139264, SSD_SQ = 141312;
__device__ __forceinline__ void ssd_chunk(const Args& a, int l, int c, bool fin, LAS unsigned char* lds, bool dry = false) {
    const int tid = opaque_tid(), lane = tid & 63, w = __builtin_amdgcn_readfirstlane(tid >> 6), l15 = lane & 15, lq = lane >> 4; const int t0 = c * 64;
    const bool hp = (c % CPB) != 0;
    LAS bf16* XS = (LAS bf16*)(lds + SSD_XS); LAS bf16* CM = (LAS bf16*)(lds + SSD_CM); LAS bf16* BM = (LAS bf16*)(lds + SSD_BM); LAS bf16* MM = (LAS bf16*)(lds + SSD_M);
    LAS float* dtl = (LAS float*)(lds + SSD_DT); LAS float* acl = (LAS float*)(lds + SSD_AC); LAS float* ssq = (LAS float*)(lds + SSD_SQ);
    bf16* PR = (bf16*)(a.ws + WS_PROJ); const float* EX = (const float*)(a.ws + WS_EX);
    bf16* STT = (bf16*)(a.ws + WS_SSD) + (size_t)c * 65536;
    { const int h = w; const float bias = a.in[I_DDTB][l * 8 + h], av = -expf(a.in[I_DALOG][l * 8 + h]);
      const float dt = softplus(EX[(size_t)(t0 + lane) * 32 + 16 + h] + bias); float cum = dt * av;
#pragma unroll
      for (int off = 1; off < 64; off <<= 1) { const float pv = __shfl_up(cum, off); if (lane >= off) cum += pv; }
      dtl[lane * 8 + h] = dt; acl[lane * 8 + h] = cum; }
    __syncthreads();
    { const int cg = tid & 127, seg = tid >> 7; int mycol, wch, pitch; LAS bf16* dst;
      if (cg < 64) { mycol = D_XS + 8 * cg; wch = 8 * cg; dst = XS + 8 * cg; pitch = XSP; }
      else if (cg < 96) { mycol = D_BM + 8 * (cg - 64); wch = 512 + 8 * (cg - 64); dst = BM + 8 * (cg - 64); pitch = BMP; }
      else { mycol = D_CM + 8 * (cg - 96); wch = 768 + 8 * (cg - 96); dst = CM + 8 * (cg - 96); pitch = BMP; }
      if (fin || cg < 96) {
          float wgt[4][8], cb[8];
          const float* cw = a.in[I_DCW] + (size_t)l * 4 * 1024 + wch;
#pragma unroll
          for (int v = 0; v < 4; ++v) { const f32x4 w0 = *(const GAS f32x4*)(cw + v * 1024), w1 = *(const GAS f32x4*)(cw + v * 1024 + 4);
              wgt[v][0] = w0[0]; wgt[v][1] = w0[1]; wgt[v][2] = w0[2]; wgt[v][3] = w0[3]; wgt[v][4] = w1[0]; wgt[v][5] = w1[1]; wgt[v][6] = w1[2]; wgt[v][7] = w1[3]; }
          { const f32x4 b0 = *(const GAS f32x4*)(a.in[I_DCB] + l * 1024 + wch), b1 = *(const GAS f32x4*)(a.in[I_DCB] + l * 1024 + wch + 4);
            cb[0] = b0[0]; cb[1] = b0[1]; cb[2] = b0[2]; cb[3] = b0[3]; cb[4] = b1[0]; cb[5] = b1[1]; cb[6] = b1[2]; cb[7] = b1[3]; }
          const int hh = cg >> 3; const float aL = acl[63 * 8 + (hh & 7)];
          v4u raws[19];
#pragma unroll
          for (int r = 0; r < 19; ++r) { const int t = 16 * seg - 3 + r; const int row = (t0 + t) < 0 ? 0 : (t0 + t); raws[r] = *(const GAS v4u*)(PR + (size_t)row * PJ + mycol); }
          PIN_MEM();
          float x3[8], x2[8], x1[8];
#pragma unroll
          for (int q = 0; q < 8; ++q) { x3[q] = 0.f; x2[q] = 0.f; x1[q] = 0.f; }
#pragma unroll
          for (int r = 0; r < 19; ++r) {
              const int t = 16 * seg - 3 + r; v4u raw = raws[r];
              if (!(t >= 0 || hp)) raw = (v4u){0u, 0u, 0u, 0u};
              float x0[8]; x0[0] = bflo(raw.x); x0[1] = bfhi(raw.x); x0[2] = bflo(raw.y); x0[3] = bfhi(raw.y); x0[4] = bflo(raw.z); x0[5] = bfhi(raw.z); x0[6] = bflo(raw.w); x0[7] = bfhi(raw.w);
              if (r >= 3) {
                  float sc = 1.0f; if (!fin && cg < 64) sc = fexp(aL - acl[t * 8 + hh]) * dtl[t * 8 + hh];
                  float o[8];
#pragma unroll
                  for (int q = 0; q < 8; ++q) o[q] = silu(cb[q] + wgt[0][q] * x3[q] + wgt[1][q] * x2[q] + wgt[2][q] * x1[q] + wgt[3][q] * x0[q]) * sc;
                  v4u pk; pk.x = pk2(o[0], o[1]); pk.y = pk2(o[2], o[3]); pk.z = pk2(o[4], o[5]); pk.w = pk2(o[6], o[7]);
                  *(LAS v4u*)(dst + t * pitch) = pk;
              }
#pragma unroll
              for (int q = 0; q < 8; ++q) { x3[q] = x2[q]; x2[q] = x1[q]; x1[q] = x0[q]; }
          }
      } }
    __syncthreads();
    if (!fin) {
        const int h = w, g = h >> 2;
#pragma unroll 1
        for (int sh = 0; sh < 2; ++sh) {
            f32x4 acc[4][4];
#pragma unroll
            for (int st = 0; st < 4; ++st)
#pragma unroll
                for (int pt = 0; pt < 4; ++pt) acc[st][pt] = (f32x4){0.f, 0.f, 0.f, 0.f};
#pragma unroll
            for (int ks = 0; ks < 2; ++ks) {
                bf16x8 xf[4], yf[4];
#pragma unroll
                for (int st = 0; st < 4; ++st) xf[st] = tr_frag(BM + (32 * ks + 8 * lq + (l15 >> 2)) * BMP + g * 128 + 64 * sh + 16 * st + 4 * (l15 & 3), BMP);
#pragma unroll
                for (int pt = 0; pt < 4; ++pt) yf[pt] = tr_frag(XS + (32 * ks + 8 * lq + (l15 >> 2)) * XSP + h * 64 + 16 * pt + 4 * (l15 & 3), XSP);
#pragma unroll
                for (int st = 0; st < 4; ++st)
#pragma unroll
                    for (int pt = 0; pt < 4; ++pt) acc[st][pt] = mfma32(xf[st], yf[pt], acc[st][pt]);
            }
#pragma unroll
            for (int st = 0; st < 4; ++st)
#pragma unroll
                for (int pt = 0; pt < 4; ++pt) { v2u o; o.x = pk2(acc[st][pt][0], acc[st][pt][1]); o.y = pk2(acc[st][pt][2], acc[st][pt][3]);
                    *(GAS v2u*)(STT + ((size_t)h * 64 + 16 * pt + l15) * 128 + 64 * sh + 16 * st + 4 * lq) = o; }
        }
        if (lane == 0) ((float*)(a.ws + WS_SDEC))[(size_t)c * 8 + h] = fexp(acl[63 * 8 + h]);
    } else {
        const int gC = w >> 2, itC = w & 3; f32x4 cbt[4];
#pragma unroll
        for (int jt = 0; jt < 4; ++jt) cbt[jt] = (f32x4){0.f, 0.f, 0.f, 0.f};
#pragma unroll
        for (int ks = 0; ks < 4; ++ks) {
            const bf16x8 yf = *(const LAS bf16x8*)(CM + (16 * itC + l15) * BMP + gC * 128 + 32 * ks + 8 * lq);
#pragma unroll
            for (int jt = 0; jt < 4; ++jt) { const bf16x8 xf = *(const LAS bf16x8*)(BM + (16 * jt + l15) * BMP + gC * 128 + 32 * ks + 8 * lq); cbt[jt] = mfma32(xf, yf, cbt[jt]); }
        }
        __syncthreads();
        f32x4 yv[2][4][2];
#pragma unroll 1
        for (int rd = 0; rd < 2; ++rd) {
            bf16x8 pfr[4][4]; v2u zvr[2][4];
            { const int ms_ = w >> 1, half_ = w & 1, g_ = ms_ >> 1, h_ = g_ * 4 + 2 * rd + (ms_ & 1);
#pragma unroll
              for (int ks = 0; ks < 4; ++ks)
#pragma unroll
                  for (int pt = 0; pt < 4; ++pt) pfr[ks][pt] = *(const GAS bf16x8*)(STT + ((size_t)h_ * 64 + 16 * pt + l15) * 128 + 32 * ks + 8 * lq);
#pragma unroll
              for (int i2 = 0; i2 < 2; ++i2)
#pragma unroll
                  for (int pt = 0; pt < 4; ++pt) zvr[i2][pt] = *(const GAS v2u*)(PR + (size_t)(t0 + 16 * (2 * half_ + i2) + l15) * PJ + D_Z + h_ * 64 + 16 * pt + 4 * lq);
              PIN_MEM(); }
            { const int i = 16 * itC + l15;
#pragma unroll
              for (int hh = 0; hh < 2; ++hh) { const int h = gC * 4 + 2 * rd + hh; const float ai = acl[i * 8 + h];
#pragma unroll
                  for (int jt = 0; jt < 4; ++jt) { float mv[4];
#pragma unroll
                      for (int r = 0; r < 4; ++r) { const int j = 16 * jt + 4 * lq + r; mv[r] = (j <= i) ? cbt[jt][r] * fexp(ai - acl[j * 8 + h]) * dtl[j * 8 + h] : 0.f; }
                      v2u o; o.x = pk2(mv[0], mv[1]); o.y = pk2(mv[2], mv[3]); *(LAS v2u*)(MM + ((gC * 2 + hh) * 64 + i) * MP + 16 * jt + 4 * lq) = o; } } }
            __syncthreads();
            { const int ms = w >> 1, half = w & 1, g = ms >> 1, h = g * 4 + 2 * rd + (ms & 1);
              f32x4 a1[4][2], a2[4][2];
#pragma unroll
              for (int pt = 0; pt < 4; ++pt)
#pragma unroll
                  for (int i2 = 0; i2 < 2; ++i2) { a1[pt][i2] = (f32x4){0.f, 0.f, 0.f, 0.f}; a2[pt][i2] = (f32x4){0.f, 0.f, 0.f, 0.f}; }
#pragma unroll
              for (int ks = 0; ks < 2; ++ks) { if (ks <= half) {
                  bf16x8 xf[4];
#pragma unroll
                  for (int pt = 0; pt < 4; ++pt) xf[pt] = tr_frag(XS + (32 * ks + 8 * lq + (l15 >> 2)) * XSP + h * 64 + 16 * pt + 4 * (l15 & 3), XSP);
#pragma unroll
                  for (int i2 = 0; i2 < 2; ++i2) { const bf16x8 yf = *(const LAS bf16x8*)(MM + (ms * 64 + 16 * (2 * half + i2) + l15) * MP + 32 * ks + 8 * lq);
#pragma unroll
                      for (int pt = 0; pt < 4; ++pt) a1[pt][i2] = mfma32(xf[pt], yf, a1[pt][i2]); } } }
#pragma unroll
              for (int ks = 0; ks < 4; ++ks) {
#pragma unroll
                  for (int i2 = 0; i2 < 2; ++i2) { const bf16x8 yf = *(const LAS bf16x8*)(CM + (16 * (2 * half + i2) + l15) * BMP + g * 128 + 32 * ks + 8 * lq);
#pragma unroll
                      for (int pt = 0; pt < 4; ++pt) a2[pt][i2] = mfma32(pfr[ks][pt], yf, a2[pt][i2]); } }
              const float Dh = a.in[I_DD][l * 8 + h];
#pragma unroll
              for (int i2 = 0; i2 < 2; ++i2) { const int i = 16 * (2 * half + i2) + l15; const float ea = fexp(acl[i * 8 + h]); float s2 = 0.f;
#pragma unroll
                  for (int pt = 0; pt < 4; ++pt) { const int ch = h * 64 + 16 * pt + 4 * lq;
                      const v2u xv = *(const LAS v2u*)(XS + i * XSP + ch); const v2u zv = zvr[i2][pt];
                      f32x4 y; y[0] = (a1[pt][i2][0] + ea * a2[pt][i2][0] + Dh * bflo(xv.x)) * silu(bflo(zv.x)); y[1] = (a1[pt][i2][1] + ea * a2[pt][i2][1] + Dh * bfhi(xv.x)) * silu(bfhi(zv.x));
                      y[2] = (a1[pt][i2][2] + ea * a2[pt][i2][2] + Dh * bflo(xv.y)) * silu(bflo(zv.y)); y[3] = (a1[pt][i2][3] + ea * a2[pt][i2][3] + Dh * bfhi(xv.y)) * silu(bfhi(zv.y));
                      if (rd == 0) yv[0][pt][i2] = y; else yv[1][pt][i2] = y;
                      s2 += (y[0] * y[0] + y[1] * y[1]) + (y[2] * y[2] + y[3] * y[3]); }
                  s2 += __shfl_xor(s2, 16); s2 += __shfl_xor(s2, 32);
                  if (lq == 0) ssq[i * 8 + h] = s2; } }
            __syncthreads();
        }
        { const int ms = w >> 1, half = w & 1, g = ms >> 1;
#pragma unroll
          for (int rd = 0; rd < 2; ++rd) { const int h = g * 4 + 2 * rd + (ms & 1);
#pragma unroll
              for (int i2 = 0; i2 < 2; ++i2) { const int i = 16 * (2 * half + i2) + l15; const LAS float* sq = ssq + i * 8;
                  const float rstd = frsq((((sq[0] + sq[1]) + (sq[2] + sq[3])) + ((sq[4] + sq[5]) + (sq[6] + sq[7]))) * (1.0f / 512.0f) + EPS);
#pragma unroll
                  for (int pt = 0; pt < 4; ++pt) { const int ch = h * 64 + 16 * pt + 4 * lq; const f32x4 nw = *(const GAS f32x4*)(a.in[I_DNW] + l * 512 + ch); const f32x4 y = yv[rd][pt][i2];
                      v2u o; o.x = pk2(y[0] * rstd * nw[0], y[1] * rstd * nw[1]); o.y = pk2(y[2] * rstd * nw[2], y[3] * rstd * nw[3]);
                      if (dry) asm volatile("" :: "v"(o.x), "v"(o.y)); else *(GAS v2u*)(PR + (size_t)(t0 + i) * PJ + D_Z + ch) = o; } } } }
    }
    __syncthreads();
}

__device__ __forceinline__ void scan_phase(const Args& a, int l, int vcu, int G, LAS unsigned char* lds) {
    const int tid = opaque_tid();
    LAS float* dl = (LAS float*)lds;
    for (int j = vcu; j < 202; j += G) {
        if (j < 192) {
            const bool isS = j < 128; const int jj = isS ? j : j - 128;
            const int b = isS ? (jj >> 6) : (jj >> 5), r0 = (isS ? (jj & 63) : (jj & 31)) * 1024, h = r0 >> 13, r = r0 + 2 * tid;
            if (isS) { if (tid < CPB) dl[tid] = ((const float*)(a.ws + WS_SDEC))[(size_t)(b * CPB + tid) * 8 + h]; }
            else { for (int i = tid; i < CPB * 64; i += NTHR) dl[i] = ((const float*)(a.ws + WS_GDEC))[(size_t)(b * CPB + (i >> 6)) * 256 + h * 64 + (i & 63)]; }
            const int cstride = isS ? 131072 : 65536;
            const __amdgpu_buffer_rsrc_t rs = __builtin_amdgcn_make_buffer_rsrc((void*)(a.ws + (isS ? WS_SSD : WS_GLA) + (size_t)b * CPB * cstride), (short)0, CPB * cstride, 0x00020000);
            __syncthreads();
            float s0 = 0.f, s1 = 0.f; const int d = r & 63;
#pragma unroll 1
            for (int n0 = 0; n0 < CPB; n0 += 64) { unsigned kv[64];
#pragma unroll
                for (int q = 0; q < 64; ++q) kv[q] = __builtin_amdgcn_raw_buffer_load_b32(rs, r * 2, (n0 + q) * cstride, 0);
                asm volatile("s_waitcnt vmcnt(0)" ::: "memory");
#pragma unroll
                for (int q = 0; q < 64; ++q) { float d0, d1; if (isS) { d0 = dl[n0 + q]; d1 = d0; } else { const f32x2 dd = *(const LAS f32x2*)(dl + (n0 + q) * 64 + d); d0 = dd.x; d1 = dd.y; }
                    __builtin_amdgcn_raw_buffer_store_b32(pk2(s0, s1), rs, r * 2, (n0 + q) * cstride, 0); s0 = d0 * s0 + bflo(kv[q]); s1 = d1 * s1 + bfhi(kv[q]);
                    if ((q & 15) == 15) PIN_MEM(); } }
            __syncthreads();
        } else if (j < 200) {
            const int e2 = (j - 192) * NTHR + tid, b = e2 >> 11, gn = e2 & 2047;
            const float* A64 = (const float*)(a.ws + WS_S5T + (size_t)l * S5T_LAYER + S5T_A64); const float ar = A64[gn * 2], ai = A64[gn * 2 + 1];
            f32x2* p = (f32x2*)(a.ws + WS_S5ST) + (size_t)b * CPB * 2048 + gn; float sr = 0.f, si = 0.f;
#pragma unroll 1
            for (int n0 = 0; n0 < CPB; n0 += 32) { f32x2 ev[32];
#pragma unroll
                for (int q = 0; q < 32; ++q) ev[q] = p[(size_t)(n0 + q) * 2048];
                asm volatile("s_waitcnt vmcnt(0)" ::: "memory");
#pragma unroll
                for (int q = 0; q < 32; ++q) { const f32x2 o = {sr, si}; p[(size_t)(n0 + q) * 2048] = o; const float nr = ar * sr - ai * si + ev[q].x, ni = ar * si + ai * sr + ev[q].y; sr = nr; si = ni; } }
        } else {
            const int e2 = (j - 200) * NTHR + tid, b = e2 >> 9, ch = e2 & 511;
            const f32x2* E = (const f32x2*)(a.ws + WS_LRUE) + (size_t)b * CPB * 512 + ch; float* H = (float*)(a.ws + WS_LRUH) + (size_t)b * CPB * 512 + ch; float hs = 0.f;
#pragma unroll 1
            for (int n0 = 0; n0 < CPB; n0 += 32) { f32x2 ev[32];
#pragma unroll
                for (int q = 0; q < 32; ++q) ev[q] = E[(size_t)(n0 + q) * 512];
#pragma unroll
                for (int q = 0; q < 32; ++q) { H[(size_t)(n0 + q) * 512] = hs; hs = ev[q].x * hs + ev[q].y; } }
        }
    }
}

__device__ __forceinline__ void final_norm(const Args& a, int vcu, int G) {
    const int tid = opaque_tid(), lane = tid & 63, wave = tid >> 6; const int gw = vcu * NWAVES + wave, NGW = G * NWAVES;
    const float* rowss = (const float*)(a.ws + WS_PART) + (size_t)DEPTH * T * 16;
    for (int m = gw; m < T; m += NGW) {
        float rsum = 0.f;
#pragma unroll
        for (int q = 0; q < 16; ++q) rsum += rowss[(size_t)m * 16 + q];
        const float rstd = 1.0f / sqrtf(rsum * (1.0f / 1024.0f) + EPS);
        const GAS v2u* xr = (const GAS v2u*)((const bf16*)(a.ws + WS_XBF) + (size_t)m * DM) + lane; GAS f32x4* orow = (GAS f32x4*)(a.out + (size_t)m * DM) + lane; const GAS f32x4* wr = (const GAS f32x4*)(a.in[I_NFW]) + lane;
        v2u xv[4];
#pragma unroll
        for (int j = 0; j < 4; ++j) xv[j] = xr[64 * j];
#pragma unroll
        for (int j = 0; j < 4; ++j) { const f32x4 w = wr[64 * j]; f32x4 v = (f32x4){bflo(xv[j].x), bfhi(xv[j].x), bflo(xv[j].y), bfhi(xv[j].y)}; v = v * rstd * w; orow[64 * j] = v; }
    }
}

#define XB_TMO      128
#define XB_XCNT(j)  (256  + 64 * (j))
#define XB_XSUB(j)  (1280 + 64 * (j))
#define XB_XGEN(j)  (2304 + 64 * (j))
#define XB_TOP      3328
#define XB_TOPGEN   3392
#define XCD_BAR_WORDS 3456
#define XB_SPIN_CAP (1u << 22)
__device__ __forceinline__ unsigned xb_ld(unsigned* p)              { return __hip_atomic_load(p, __ATOMIC_RELAXED, __HIP_MEMORY_SCOPE_AGENT); }
__device__ __forceinline__ unsigned xb_add(unsigned* p, unsigned v) { return __hip_atomic_fetch_add(p, v, __ATOMIC_RELAXED, __HIP_MEMORY_SCOPE_AGENT); }
__device__ __forceinline__ unsigned xb_xcc_id() { return (unsigned)__builtin_amdgcn_s_getreg((3 << 11) | 20) & 0xFu; }
#define XB_SPIN(cond, bar) do { unsigned _sp = 0; while (cond) { __builtin_amdgcn_s_sleep(1); \
    if ((++_sp & 255u) == 0u) { if (xb_ld(&(bar)[XB_TMO])) break; if (_sp > XB_SPIN_CAP) { atomicAdd(&(bar)[XB_TMO], 1u); break; } } } } while (0)
struct XcdBarrier { unsigned* bar; unsigned x; volatile LAS unsigned* st; };
__device__ __forceinline__ XcdBarrier xcd_barrier_post(unsigned* bar, volatile LAS unsigned* st) {
    XcdBarrier b; b.bar = bar; b.x = xb_xcc_id(); b.st = st;
    if (threadIdx.x == 0) (void)xb_add(&bar[XB_XCNT(b.x)], 1u);
    return b;
}
__device__ __forceinline__ void xcd_barrier_complete(unsigned* bar, unsigned x, unsigned& nloc, unsigned& nx) {
    const unsigned G = gridDim.x * gridDim.y * gridDim.z;
    unsigned sum, cnt, mine, sp = 0u;
    for (;;) {
        sum = 0u; cnt = 0u; mine = 0u;
#pragma unroll
        for (unsigned j = 0; j < 16; ++j) { const unsigned c = xb_ld(&bar[XB_XCNT(j)]); sum += c; cnt += (c > 0u) ? 1u : 0u; mine = (j == x) ? c : mine; }
        if (sum == G) break;
        __builtin_amdgcn_s_sleep(1);
        if ((++sp & 255u) == 0u) { if (xb_ld(&bar[XB_TMO])) break; if (sp > XB_SPIN_CAP) { atomicAdd(&bar[XB_TMO], 1u); break; } }
    }
    nloc = mine > 0u ? mine : 1u; nx = cnt > 0u ? cnt : 1u;
}
__device__ __forceinline__ void xcd_barrier(const XcdBarrier& b) {
    asm volatile("s_waitcnt vmcnt(0)" ::: "memory");
    __syncthreads();
    if (threadIdx.x == 0) {
        unsigned* bar = b.bar;
        __builtin_amdgcn_s_waitcnt(0);
        unsigned nloc = b.st[0], nx = b.st[1];
        if (nloc == 0u) { xcd_barrier_complete(bar, b.x, nloc, nx); b.st[0] = nloc; b.st[1] = nx; }
        const unsigned old = xb_add(&bar[XB_XSUB(b.x)], 1u);
        const unsigned gen = old / nloc;
        if (old + 1u == (gen + 1u) * nloc) {
            __builtin_amdgcn_fence(__ATOMIC_RELEASE, "agent");
            asm volatile("s_waitcnt vmcnt(0)" ::: "memory");
            const unsigned og = xb_add(&bar[XB_TOP], 1u);
            const unsigned tg = og / nx;
            if (og + 1u == (tg + 1u) * nx) xb_add(&bar[XB_TOPGEN], 1u);
            else XB_SPIN(xb_ld(&bar[XB_TOPGEN]) == tg, bar);
            __builtin_amdgcn_fence(__ATOMIC_ACQUIRE, "agent");
            xb_add(&bar[XB_XGEN(b.x)], 1u);
            asm volatile("s_waitcnt vmcnt(0)" ::: "memory");
        } else {
            XB_SPIN(xb_ld(&bar[XB_XGEN(b.x)]) == gen, bar);
            __builtin_amdgcn_fence(__ATOMIC_ACQUIRE, "agent");
            asm volatile("s_waitcnt vmcnt(0)" ::: "memory");
        }
    }
    __syncthreads();
}

constexpr int N_PHASES = 2 + 5 * DEPTH;
__global__ void __launch_bounds__(NTHR, 2) mega_fwd(Args args) {
    extern __shared__ __attribute__((aligned(16))) unsigned char lds_raw[];
    LAS unsigned char* lds = (LAS unsigned char*)lds_raw;
    const int G = gridDim.x, bx = blockIdx.x; const int vcu = (G % 8 == 0) ? (bx % 8) * (G / 8) + bx / 8 : bx;
    const int lo = args.ph_lo, hi = args.ph_hi;
    float* rowss = (float*)(args.ws + WS_PART);
    volatile LAS unsigned* bst = (volatile LAS unsigned*)(lds + LDS_BYTES - 64);
    if (threadIdx.x < 2) bst[threadIdx.x] = 0u;
    __syncthreads();
    XcdBarrier xbar = xcd_barrier_post((unsigned*)(args.ws + WS_CTL), bst);
    constexpr int N_EXTRA = PROBE_DUP == 0 ? 0 : (PROBE_DUP == 3 ? 4 : 1);
    for (int sq = lo; sq < hi + N_EXTRA; ++sq) {
        int ph = sq;
        if (PROBE_DUP == 1) ph = sq <= 1 ? sq : sq - 1;
        if (PROBE_DUP == 2) ph = sq <= 2 ? sq : sq - 1;
        if (PROBE_DUP == 3) ph = sq <= 4 ? sq : sq - 4;
        if (PROBE_DUP == 4) ph = sq <= 5 ? sq : sq - 1;
        if (PROBE_DUP == 5) ph = sq <= 0 ? sq : sq - 1;
        if (PROBE_DUP == 6) ph = sq <= N_PHASES - 1 ? sq : sq - 1;
        if (ph == 0) { if (DBG_MASK & 1) p0_prologue(args, lds, vcu, G); }
        else if (ph == N_PHASES - 1) { if (DBG_MASK & 256) final_norm(args, vcu, G); }
        else {
            const int l = (ph - 1) / 5, sub = (ph - 1) % 5;
            if (sub == 0) { if (DBG_MASK & 2) {
                pg8::Gemm g{(const bf16*)args.out, (const bf16*)(args.ws + WS_WIN) + (size_t)l * NPAD * DM, T, PJ, DM, DM, 512};
                pg8::StaticOrder S; S.init(T, PJ, G, bx);
                pg8::EpiProj E{(bf16*)(args.ws + WS_PROJ), (float*)(args.ws + WS_EX), rowss + (size_t)l * T * 16, PJ};
                pg8::gemm_phase<pg8::EpiProj, pg8::StaticOrder, true, true>(lds, g, S, E);
                for (int c = vcu; c < NCHUNK; c += G) ex_chunk(args, l, c); }
            } else if (sub == 1 || sub == 3) {
                const bool fin = (sub == 3);
                for (int c = vcu; c < NCHUNK; c += G) {
                    if (PROBE_MIX == 1 && !fin) lru_chunk(args, l, c, false, lds); if (PROBE_MIX == 9 && !fin) lru_chunk(args, l, c, false, lds, false, true); if (PROBE_MIX == 5 && fin) lru_chunk(args, l, c, true, lds, true);
                    if (fin) lru_out(args, l, c); else lru_chunk(args, l, c, false, lds);
                    if (PROBE_MIX == 2 && !fin) s5_chunk(args, l, c, false, lds); if (PROBE_MIX == 6 && fin) s5_chunk(args, l, c, true, lds, true);
                    s5_chunk(args, l, c, fin, lds);
                    if (PROBE_MIX == 3 && !fin) gla_chunk(args, l, c, false, lds); if (PROBE_MIX == 7 && fin) gla_chunk(args, l, c, true, lds, true);
                    gla_chunk(args, l, c, fin, lds);
                    if (PROBE_MIX == 4 && !fin) ssd_chunk(args, l, c, false, lds); if (PROBE_MIX == 8 && fin) ssd_chunk(args, l, c, true, lds, true);
                    ssd_chunk(args, l, c, fin, lds); }
            } else if (sub == 2) { if (DBG_MASK & 64) scan_phase(args, l, vcu, G, lds); }
            else if (DBG_MASK & 128) {
                pg8::Gemm g{(const bf16*)(args.ws + WS_PROJ), (const bf16*)(args.ws + WS_WOUT) + (size_t)l * DM * 2048, T, DM, 2048, PJ, 1280};
                pg8::StaticOrder S; S.init(T, DM, G, bx);
                pg8::EpiOut E{l == 0 ? args.in[I_X] : nullptr, (const bf16*)args.out, l == DEPTH - 1 ? (bf16*)(args.ws + WS_XBF) : (bf16*)args.out, rowss + (size_t)(l + 1) * T * 16};
                pg8::gemm_phase<pg8::EpiOut, pg8::StaticOrder, true, true>(lds, g, S, E);
            }
        }
        if (sq + 1 < hi + N_EXTRA) { xcd_barrier(xbar); }
    }
}

extern "C" void kernel_launch(void* const* d_in, const int* in_sizes, int n_in, void* d_out, int out_size, void* d_ws, size_t ws_size, hipStream_t stream) {
    static int grid = 0;
    if (grid == 0) {
        if (n_in != 31 || out_size != T * DM || ws_size < WS_END) { fprintf(stderr, "kernel_launch: unexpected shapes (n_in %d out %d ws %zu need %zu)\n", n_in, out_size, ws_size, (size_t)WS_END); grid = -1; return; }
        int dev = 0, cus = 0, per_cu = 0;
        if (hipGetDevice(&dev) != hipSuccess || hipDeviceGetAttribute(&cus, hipDeviceAttributeMultiprocessorCount, dev) != hipSuccess) { grid = -1; return; }
        if (hipFuncSetAttribute((const void*)mega_fwd, hipFuncAttributeMaxDynamicSharedMemorySize, LDS_BYTES) != hipSuccess) { fprintf(stderr, "kernel_launch: hipFuncSetAttribute failed\n"); grid = -1; return; }
        if (hipOccupancyMaxActiveBlocksPerMultiprocessor(&per_cu, (const void*)mega_fwd, NTHR, LDS_BYTES) != hipSuccess || per_cu < 1) { fprintf(stderr, "kernel_launch: occupancy query says %d blocks/CU\n", per_cu); (void)hipGetLastError(); per_cu = 1; }
        grid = cus;
        fprintf(stderr, "kernel_launch: grid %d (per_cu %d)\n", grid, per_cu);
    }
    if (grid < 0) return;
    (void)hipMemsetAsync((char*)d_ws + WS_CTL, 0, CTL_ZERO_BYTES, stream);
    Args a{};
    for (int i = 0; i < 31; ++i) a.in[i] = (const float*)d_in[i];
    a.out = (float*)d_out; a.ws = (unsigned char*)d_ws;
#if MK_PER_PHASE
    for (int ph = 0; ph < N_PHASES; ++ph) { a.ph_lo = ph; a.ph_hi = ph + 1; hipLaunchKernelGGL(mega_fwd, dim3(grid), dim3(NTHR), LDS_BYTES, stream, a); }
#else
    a.ph_lo = 0; a.ph_hi = N_PHASES;
    void* kargs[] = {&a};
    hipError_t e = hipLaunchCooperativeKernel((const void*)mega_fwd, dim3(grid), dim3(NTHR), kargs, LDS_BYTES, stream);
    if (e != hipSuccess) fprintf(stderr, "kernel_launch: cooperative launch failed: %s\n", hipGetErrorString(e));
#endif
}
```

```cpp
#include <hip/hip_runtime.h>
#include <hip/hip_cooperative_groups.h>
#include <cstdio>
#include <cstdint>
namespace cg = cooperative_groups;

#ifndef DBG_MASK
#define DBG_MASK 0xFFF
#endif
#ifndef PROBE_DUP
#define PROBE_DUP 0
#endif
#ifndef PROBE_MIX
#define PROBE_MIX 0
#endif
#ifndef MK_PER_PHASE
#define MK_PER_PHASE 0
#endif

namespace pg8 {
#define PG8_LAS __attribute__((address_space(3)))
typedef unsigned short bf16_t;
typedef short bf16x8 __attribute__((ext_vector_type(8)));
typedef float f32x4 __attribute__((ext_vector_type(4)));
typedef unsigned u32x4 __attribute__((ext_vector_type(4)));
typedef unsigned u32x2 __attribute__((ext_vector_type(2)));
constexpr int BM = 256, BK = 64, HALF = 128, HTB = HALF * BK * 2, STAGE_BYTES = 8 * HTB, NXCD = 8, WGM = 8;

__host__ __device__ __forceinline__ int lds_byte(int r, int c) { const int st = (r >> 4) * 2 + (c >> 5), rr = r & 15, cc = c & 31, ob = rr * 64 + cc * 2; return st * 1024 + (ob ^ (((ob >> 9) & 1) << 5)); }
__host__ __device__ __forceinline__ void stage_rc(int b, int& R, int& C) { const int st = b / 1024, sb = b % 1024, swz = sb ^ (((sb >> 9) & 1) << 5); R = (st >> 1) * 16 + swz / 64; C = (st & 1) * 32 + (swz % 64) / 2; }
__host__ __device__ __forceinline__ int perm32(int rho) { const int n = rho >> 4, i = rho & 15; return 8 * (i >> 2) + 4 * n + (i & 3); }

struct Unit { int pm, pn; };
struct Gemm { const bf16_t* A; const bf16_t* Bt; int M, N, K, lda, segcols; };

struct StaticOrder {
    int nM, nN, nwg, G, c;
    __host__ __device__ void init(int M, int N, int G_, int c_) { nM = M / BM; nN = N / BM; nwg = nM * nN; G = G_; c = c_; }
    __host__ __device__ bool next(int i, Unit& u) const {
        const long L = (long)i * G + c; if (L >= nwg) return false;
        int wgid = (int)L; { const int q = nwg / NXCD, r = nwg % NXCD, xcd = wgid % NXCD, off = wgid / NXCD; wgid = (xcd < r ? xcd * (q + 1) : r * (q + 1) + (xcd - r) * q) + off; }
        const int nig = WGM * nN, gid = wgid / nig, fm = gid * WGM, gsz = (nM - fm) < WGM ? (nM - fm) : WGM;
        u.pm = fm + ((wgid % nig) % gsz); u.pn = (wgid % nig) / gsz; return true;
    }
};

__device__ __forceinline__ unsigned cvt_pk_bf16(float lo, float hi) { unsigned r; asm volatile("v_cvt_pk_bf16_f32 %0, %1, %2" : "=v"(r) : "v"(lo), "v"(hi)); return r; }

struct EpiProj {
    static constexpr bool PERM = true;
    bf16_t* P; float* EX; const float* rowss; int pj;
    __device__ __forceinline__ void operator()(const f32x4 (&acc)[2][2][4][2], const Unit& u, int wr, int wc, int fr, int fq) const {
        const int row0 = u.pm * BM + wr * 64 + fr;
#pragma unroll
        for (int ai = 0; ai < 2; ++ai)
#pragma unroll
            for (int m = 0; m < 4; ++m) {
                const int row = row0 + ai * HALF + m * 16;
                const f32x4* pp = (const f32x4*)(rowss + (size_t)row * 16); const f32x4 p0 = pp[0], p1 = pp[1], p2 = pp[2], p3 = pp[3];
                const float rsum = (((p0[0] + p0[1]) + (p0[2] + p0[3])) + ((p1[0] + p1[1]) + (p1[2] + p1[3]))) + (((p2[0] + p2[1]) + (p2[2] + p2[3])) + ((p3[0] + p3[1]) + (p3[2] + p3[3])));
                const float rstd = 1.0f / sqrtf(rsum * (1.0f / 1024.0f) + 1e-6f);
                if (u.pn < 20) {
                    bf16_t* rowp = P + (size_t)row * pj + u.pn * BM + wc * 32 + 8 * fq;
#pragma unroll
                    for (int bj = 0; bj < 2; ++bj) { const f32x4 v0 = acc[ai][bj][m][0] * rstd, v1 = acc[ai][bj][m][1] * rstd;
                        u32x4 w; w.x = cvt_pk_bf16(v0[0], v0[1]); w.y = cvt_pk_bf16(v0[2], v0[3]); w.z = cvt_pk_bf16(v1[0], v1[1]); w.w = cvt_pk_bf16(v1[2], v1[3]);
                        *(u32x4*)(rowp + bj * HALF) = w; }
                } else if (wc == 0) {
                    float* ep = EX + (size_t)row * 32 + 8 * fq;
                    *(f32x4*)(ep) = acc[ai][0][m][0] * rstd; *(f32x4*)(ep + 4) = acc[ai][0][m][1] * rstd;
                }
            }
    }
};
struct EpiOut {
    static constexpr bool PERM = false;
    const float* Xf; const bf16_t* XBin; bf16_t* XBout; float* rowss_next;
    __device__ __forceinline__ void operator()(const f32x4 (&acc)[2][2][4][2], const Unit& u, int wr, int wc, int fr, int fq) const {
        const int row0 = u.pm * BM + wr * 64 + fr, col0 = u.pn * BM + wc * 32 + 4 * fq;
#pragma unroll
        for (int ai = 0; ai < 2; ++ai)
#pragma unroll
            for (int mh = 0; mh < 2; ++mh) {
                f32x4 xo[2][2][2];
                if (Xf) {
#pragma unroll
                    for (int m = 0; m < 2; ++m)
#pragma unroll
                        for (int bj = 0; bj < 2; ++bj)
#pragma unroll
                            for (int n = 0; n < 2; ++n) xo[m][bj][n] = *(const f32x4*)(Xf + (size_t)(row0 + ai * HALF + (2 * mh + m) * 16) * 1024 + col0 + bj * HALF + n * 16);
                } else {
#pragma unroll
                    for (int m = 0; m < 2; ++m)
#pragma unroll
                        for (int bj = 0; bj < 2; ++bj)
#pragma unroll
                            for (int n = 0; n < 2; ++n) { const u32x2 w = *(const u32x2*)(XBin + (size_t)(row0 + ai * HALF + (2 * mh + m) * 16) * 1024 + col0 + bj * HALF + n * 16);
                                xo[m][bj][n] = (f32x4){__builtin_bit_cast(float, w.x << 16), __builtin_bit_cast(float, w.x & 0xffff0000u), __builtin_bit_cast(float, w.y << 16), __builtin_bit_cast(float, w.y & 0xffff0000u)}; }
                }
#pragma unroll
                for (int m = 0; m < 2; ++m) {
                    const int mm = 2 * mh + m, row = row0 + ai * HALF + mm * 16; float ss = 0.f;
#pragma unroll
                    for (int bj = 0; bj < 2; ++bj)
#pragma unroll
                        for (int n = 0; n < 2; ++n) { const size_t off = (size_t)row * 1024 + col0 + bj * HALF + n * 16;
                            const f32x4 xn = xo[m][bj][n] + acc[ai][bj][mm][n];
                            u32x2 w; w.x = cvt_pk_bf16(xn[0], xn[1]); w.y = cvt_pk_bf16(xn[2], xn[3]); *(u32x2*)(XBout + off) = w;
                            ss += (xn[0] * xn[0] + xn[1] * xn[1]) + (xn[2] * xn[2] + xn[3] * xn[3]); }
                    ss += __shfl_xor(ss, 16); ss += __shfl_xor(ss, 32);
                    if (fq == 0) rowss_next[(size_t)row * 16 + u.pn * 4 + wc] = ss;
                }
            }
    }
};

__device__ __forceinline__ int opaque_tid() { int t = threadIdx.x; asm volatile("" : "+v"(t)); return t; }
template <class Epi, class Sched, bool ALIGN_EPI = false, bool SP2 = false>
__device__ __forceinline__ void gemm_phase(PG8_LAS unsigned char* lds, const Gemm g, const Sched& S, const Epi& E) {
    const int tid = opaque_tid(), wid = __builtin_amdgcn_readfirstlane(tid >> 6), lane = tid & 63, wr = wid >> 2, wc = wid & 3, fr = lane & 15, fq = lane >> 4;
    const int K = g.K, nt = K / BK, lda = g.lda;
    unsigned voffA[2], voffB[2];
#pragma unroll
    for (int i = 0; i < 2; ++i) { int R, C; stage_rc(tid * 16 + i * 8192, R, C); const int Rb = Epi::PERM ? ((R & ~31) + perm32(R & 31)) : R;
        voffA[i] = (unsigned)(R * lda + C) * 2u; voffB[i] = (unsigned)(Rb * K + C) * 2u; }
    const size_t kstep = (size_t)(BK * 2);
    const size_t segB = (size_t)g.segcols * 2;
    const size_t hstepA = (size_t)HALF * lda * 2, hstepB = (size_t)HALF * K * 2;
    const size_t tstepA = 2 * hstepA, tstepB = 2 * hstepB;
    const unsigned ldsw = (unsigned)wid * 1024u;
    const int aoff = lds_byte(wr * 64 + fr, fq * 8), boff = lds_byte(wc * 32 + fr, fq * 8);
#define PG8_KA(t) ((size_t)((t) >> 3) * segB + (size_t)((t) & 7) * kstep)
#define PG8_SA(b, h) (((b) * 2 + (h)) * HTB)
#define PG8_SB(b, h) ((4 + (b) * 2 + (h)) * HTB)
#define PG8_STAGE(bufoff, gbase, voff) do { _Pragma("unroll") for (int _i = 0; _i < 2; ++_i) \
        __builtin_amdgcn_global_load_lds((const unsigned*)((const char*)(gbase) + (voff)[_i]), (PG8_LAS unsigned*)(lds + (bufoff) + ldsw + _i * 8192), 16, 0, 0); } while (0)
#define PG8_LDA(dst, b, h) do { _Pragma("unroll") for (int m = 0; m < 4; ++m) _Pragma("unroll") for (int k = 0; k < 2; ++k) dst[m][k] = *(const PG8_LAS bf16x8*)(lds + PG8_SA(b, h) + aoff + m * 2048 + k * 1024); } while (0)
#define PG8_LDB(dst, b, h) do { _Pragma("unroll") for (int n = 0; n < 2; ++n) _Pragma("unroll") for (int k = 0; k < 2; ++k) dst[n][k] = *(const PG8_LAS bf16x8*)(lds + PG8_SB(b, h) + boff + n * 2048 + k * 1024); } while (0)
#define PG8_MMA(ai, bj, At, Bt) do { __builtin_amdgcn_s_setprio(1); _Pragma("unroll") for (int m = 0; m < 4; ++m) _Pragma("unroll") for (int n = 0; n < 2; ++n) _Pragma("unroll") for (int k = 0; k < 2; ++k) \
        acc[ai][bj][m][n] = __builtin_amdgcn_mfma_f32_16x16x32_bf16(Bt[n][k], At[m][k], acc[ai][bj][m][n], 0, 0, 0); __builtin_amdgcn_s_setprio(0); } while (0)
#define PG8_WAIT_V(n) asm volatile("s_waitcnt vmcnt(" #n ")" ::: "memory")
#define PG8_WAIT_L(n) asm volatile("s_waitcnt lgkmcnt(" #n ")" ::: "memory")
#define PG8_BAR __builtin_amdgcn_s_barrier()
#define PG8_SCHED __builtin_amdgcn_sched_barrier(0)
    Unit cur, nxt; int ui = 0;
    if (!S.next(0, cur)) return;
    f32x4 acc[2][2][4][2];
#pragma unroll
    for (int a = 0; a < 2; ++a)
#pragma unroll
        for (int b = 0; b < 2; ++b)
#pragma unroll
            for (int m = 0; m < 4; ++m)
#pragma unroll
                for (int n = 0; n < 2; ++n) acc[a][b][m][n] = (f32x4){0.f, 0.f, 0.f, 0.f};
    bf16x8 At[4][2], B0[2][2], B1[2][2];
    const char* cA = (const char*)g.A + (size_t)cur.pm * tstepA; const char* cB = (const char*)g.Bt + (size_t)cur.pn * tstepB;
    if constexpr (SP2) {
        PG8_STAGE(PG8_SB(0, 0), cB, voffB); PG8_STAGE(PG8_SB(0, 1), cB + hstepB, voffB); PG8_STAGE(PG8_SA(0, 0), cA, voffA); PG8_STAGE(PG8_SA(0, 1), cA + hstepA, voffA);
        if (wr == 1) PG8_BAR;
        PG8_WAIT_V(2); PG8_BAR;
        PG8_STAGE(PG8_SB(1, 0), cB + kstep, voffB); PG8_STAGE(PG8_SA(1, 0), cA + kstep, voffA); PG8_STAGE(PG8_SB(1, 1), cB + hstepB + kstep, voffB);
        PG8_WAIT_V(6); PG8_BAR;
    } else {
        PG8_STAGE(PG8_SB(0, 0), cB, voffB); PG8_STAGE(PG8_SA(0, 0), cA, voffA); PG8_STAGE(PG8_SB(0, 1), cB + hstepB, voffB); PG8_STAGE(PG8_SA(0, 1), cA + hstepA, voffA);
        if (wr == 1) PG8_BAR;
        PG8_WAIT_V(4); PG8_BAR;
        PG8_STAGE(PG8_SB(1, 0), cB + kstep, voffB); PG8_STAGE(PG8_SA(1, 0), cA + kstep, voffA); PG8_STAGE(PG8_SB(1, 1), cB + hstepB + kstep, voffB);
        PG8_WAIT_V(6); PG8_BAR;
    }
    for (;;) {
        const bool has_next = S.next(ui + 1, nxt);
        const char* nA = has_next ? (const char*)g.A + (size_t)nxt.pm * tstepA : cA; const char* nB = has_next ? (const char*)g.Bt + (size_t)nxt.pn * tstepB : cB;
        for (int t = 0; t < nt; t += 2) {
            const bool last = (t == nt - 2);
            const char* a1 = cA + PG8_KA(t + 1);
            const char* a2 = last ? nA : cA + PG8_KA(t + 2); const char* b2 = last ? nB : cB + (size_t)(t + 2) * kstep;
            const char* a3 = a2 + kstep; const char* b3 = b2 + kstep;
            if constexpr (SP2) {
            PG8_LDB(B0, 0, 0); PG8_LDB(B1, 0, 1); PG8_SCHED; PG8_LDA(At, 0, 0); PG8_STAGE(PG8_SA(1, 1), a1 + hstepA, voffA);
            PG8_WAIT_V(8); PG8_WAIT_L(0); PG8_BAR; PG8_MMA(0, 0, At, B0); PG8_MMA(0, 1, At, B1); PG8_BAR; PG8_SCHED;
            PG8_LDA(At, 0, 1); PG8_STAGE(PG8_SB(0, 0), b2, voffB); PG8_STAGE(PG8_SB(0, 1), b2 + hstepB, voffB); PG8_STAGE(PG8_SA(0, 0), a2, voffA);
            PG8_WAIT_V(8); PG8_WAIT_L(0); PG8_BAR; PG8_MMA(1, 0, At, B0); PG8_MMA(1, 1, At, B1); PG8_BAR; PG8_SCHED;
            PG8_LDB(B0, 1, 0); PG8_LDB(B1, 1, 1); PG8_SCHED; PG8_LDA(At, 1, 0); PG8_STAGE(PG8_SA(0, 1), a2 + hstepA, voffA);
            PG8_WAIT_V(8); PG8_WAIT_L(0); PG8_BAR; PG8_MMA(0, 0, At, B0); PG8_MMA(0, 1, At, B1); PG8_BAR; PG8_SCHED;
            PG8_LDA(At, 1, 1); PG8_STAGE(PG8_SB(1, 0), b3, voffB); PG8_STAGE(PG8_SB(1, 1), b3 + hstepB, voffB); PG8_STAGE(PG8_SA(1, 0), a3, voffA);
            PG8_WAIT_V(8); PG8_WAIT_L(0); PG8_BAR; PG8_MMA(1, 0, At, B0); PG8_MMA(1, 1, At, B1); PG8_BAR; PG8_SCHED;
            } else {
            PG8_LDB(B0, 0, 0); PG8_SCHED; PG8_LDA(At, 0, 0); PG8_STAGE(PG8_SA(1, 1), a1 + hstepA, voffA);
            PG8_WAIT_L(8); PG8_BAR; PG8_WAIT_L(0); PG8_MMA(0, 0, At, B0); PG8_BAR; PG8_SCHED;
            PG8_LDB(B1, 0, 1); PG8_STAGE(PG8_SB(0, 0), b2, voffB);
            PG8_BAR; PG8_WAIT_L(0); PG8_MMA(0, 1, At, B1); PG8_BAR;
            PG8_LDA(At, 0, 1); PG8_STAGE(PG8_SA(0, 0), a2, voffA);
            PG8_BAR; PG8_WAIT_L(0); PG8_MMA(1, 0, At, B0); PG8_BAR; PG8_SCHED;
            PG8_STAGE(PG8_SB(0, 1), b2 + hstepB, voffB);
            PG8_WAIT_V(6); PG8_BAR; PG8_MMA(1, 1, At, B1); PG8_BAR;
            PG8_LDB(B0, 1, 0); PG8_SCHED; PG8_LDA(At, 1, 0); PG8_STAGE(PG8_SA(0, 1), a2 + hstepA, voffA);
            PG8_WAIT_L(8); PG8_BAR; PG8_WAIT_L(0); PG8_MMA(0, 0, At, B0); PG8_BAR; PG8_SCHED;
            PG8_LDB(B1, 1, 1); PG8_STAGE(PG8_SB(1, 0), b3, voffB);
            PG8_BAR; PG8_WAIT_L(0); PG8_MMA(0, 1, At, B1); PG8_BAR;
            PG8_LDA(At, 1, 1); PG8_STAGE(PG8_SA(1, 0), a3, voffA);
            PG8_BAR; PG8_WAIT_L(0); PG8_MMA(1, 0, At, B0); PG8_BAR; PG8_SCHED;
            PG8_STAGE(PG8_SB(1, 1), b3 + hstepB, voffB);
            PG8_WAIT_V(6); PG8_BAR; PG8_MMA(1, 1, At, B1); PG8_BAR;
            }
        }
        if constexpr (ALIGN_EPI) { if (wr == 0) PG8_BAR; }
        E(acc, cur, wr, wc, fr, fq);
        if (!has_next) break;
#pragma unroll
        for (int a = 0; a < 2; ++a)
#pragma unroll
            for (int b = 0; b < 2; ++b)
#pragma unroll
                for (int m = 0; m < 4; ++m)
#pragma unroll
                    for (int n = 0; n < 2; ++n) acc[a][b][m][n] = (f32x4){0.f, 0.f, 0.f, 0.f};
        cur = nxt; cA = nA; cB = nB; ++ui;
        if constexpr (ALIGN_EPI) { if (wr == 1) PG8_BAR; }
    }
    PG8_WAIT_V(0);
    if constexpr (!ALIGN_EPI) { if (wr == 0) PG8_BAR; }
    PG8_BAR;
#undef PG8_KA
#undef PG8_SA
#undef PG8_SB
#undef PG8_STAGE
#undef PG8_LDA
#undef PG8_LDB
#undef PG8_MMA
#undef PG8_WAIT_V
#undef PG8_WAIT_L
#undef PG8_BAR
#undef PG8_SCHED
}
}

constexpr int NWAVES = 8, NTHR = 512;
constexpr int DM = 1024, BATCH = 2, SEQ = 8192, DEPTH = 4, T = BATCH * SEQ;
constexpr int DIN = 5144, PJ = 5120, NPAD = 5152, NCHUNK = T / 64, CPB = SEQ / 64;
constexpr float EPS = 1e-6f;
constexpr int A_Z = 0, A_X = 512, C_Q = 1024, B_Z = 1280, B_U = 1792, C_K = 2304, C_Z = 2560, C_V = 3072, D_CM = 3584, D_Z = 3840, D_XS = 4352, D_BM = 4864;
constexpr int O_AX = 0, O_AZ = 512, O_BU = 1024, O_BZ = 1536, O_CQ = 2048, O_CK = 2304, O_CV = 2560, O_CZ = 3072, O_CG = 3584, O_DZ = 3600, O_DXBC = 4112, O_DDT = 5136;
__host__ __device__ __forceinline__ int orig_col(int j) {
    if (j < 512) return O_AZ + j;
    if (j < 1024) return O_AX + (j - 512);
    if (j < 1280) return O_CQ + (j - 1024);
    if (j < 1792) return O_BZ + (j - 1280);
    if (j < 2304) return O_BU + (j - 1792);
    if (j < 2560) return O_CK + (j - 2304);
    if (j < 3072) return O_CZ + (j - 2560);
    if (j < 3584) return O_CV + (j - 3072);
    if (j < 3840) return O_DXBC + 768 + (j - 3584);
    if (j < 4352) return O_DZ + (j - 3840);
    if (j < 4864) return O_DXBC + (j - 4352);
    if (j < 5120) return O_DXBC + 512 + (j - 4864);
    if (j < 5136) return O_CG + (j - 5120);
    if (j < 5144) return O_DDT + (j - 5136);
    return -1;
}
constexpr size_t MiB = 1u << 20;
constexpr size_t WS_CTL = 0, CTL_ZERO_BYTES = 1 * MiB;
constexpr size_t CTL_ROWSS = 512 * 1024;
constexpr size_t WS_WIN = 1 * MiB;
constexpr size_t WS_WOUT = 43 * MiB;
constexpr size_t WS_S5T = 59 * MiB;
constexpr size_t WS_PROJ = 75 * MiB;
constexpr size_t WS_EX = 235 * MiB;
constexpr size_t WS_GLA = 237 * MiB;
constexpr size_t WS_SSD = 253 * MiB;
constexpr size_t WS_XBF = WS_SSD;
constexpr size_t WS_S5ST = 285 * MiB;
constexpr size_t WS_LRUE = 289 * MiB;
constexpr size_t WS_LRUH = 290 * MiB;
constexpr size_t WS_GDEC = 291 * MiB;
constexpr size_t WS_SDEC = 292 * MiB;
constexpr size_t WS_PART = 293 * MiB;
constexpr size_t WS_GLUT = 298 * MiB;
constexpr size_t WS_LRW = 300 * MiB;
constexpr size_t WS_END = 301 * MiB;
constexpr size_t S5T_AB = 0;
constexpr size_t S5T_A64 = 16384;
constexpr size_t S5T_BC = 65536;
constexpr size_t S5T_CC = 196608;
constexpr size_t S5T_PW = 327680;
constexpr size_t S5T_KT = 1048576;
constexpr size_t S5T_LAYER = 4 * MiB;

constexpr int LDS_BYTES = 155648;

#define GAS __attribute__((address_space(1)))
#define LAS __attribute__((address_space(3)))
typedef unsigned short bf16;
typedef unsigned v4u __attribute__((ext_vector_type(4)));
typedef float f32x4 __attribute__((ext_vector_type(4)));

__device__ __forceinline__ unsigned f2bf(float f) { unsigned u = __builtin_bit_cast(unsigned, f); return (u + 0x7fffu + ((u >> 16) & 1u)) >> 16; }
__device__ __forceinline__ unsigned pk2(float lo, float hi) { return f2bf(lo) | (f2bf(hi) << 16); }
__device__ __forceinline__ float bf2f(unsigned h) { return __builtin_bit_cast(float, (h & 0xffffu) << 16); }
__device__ __forceinline__ float bflo(unsigned w) { return __builtin_bit_cast(float, w << 16); }
__device__ __forceinline__ float bfhi(unsigned w) { return __builtin_bit_cast(float, w & 0xffff0000u); }
__device__ __forceinline__ float fexp(float x) { return __builtin_amdgcn_exp2f(x * 1.4426950408889634f); }
__device__ __forceinline__ float frcp(float x) { return __builtin_amdgcn_rcpf(x); }
__device__ __forceinline__ float sigm(float x) { return frcp(1.0f + fexp(-x)); }
__device__ __forceinline__ float silu(float x) { return x * frcp(1.0f + fexp(-x)); }
__device__ __forceinline__ float softplus(float x) { return fmaxf(x, 0.f) + __builtin_amdgcn_logf(1.0f + fexp(-fabsf(x))) * 0.6931471805599453f; }
__device__ __forceinline__ float gelu_tanh(float x) { const float u = 0.7978845608028654f * (x + 0.044715f * x * x * x); return x * frcp(1.0f + fexp(-2.0f * u)); }
__device__ __forceinline__ float neg_expm1(float x) { const float s = -x * (1.0f + x * (0.5f + x * (0.16666667f + x * 0.041666668f))); const float d = 1.0f - fexp(x); return fabsf(x) < 0.03f ? s : d; }
__device__ __forceinline__ float fsqrt(float x) { return __builtin_amdgcn_sqrtf(x); }
__device__ __forceinline__ float frsq(float x) { return __builtin_amdgcn_rsqf(x); }
__device__ __forceinline__ float wave_sum(float v) {
#pragma unroll
    for (int o = 1; o < 64; o <<= 1) v += __shfl_xor(v, o);
    return v;
}

__device__ __forceinline__ int opaque_tid() { int t = threadIdx.x; asm volatile("" : "+v"(t)); return t; }
typedef short bf16x8 __attribute__((ext_vector_type(8)));
typedef short bf16x4 __attribute__((ext_vector_type(4)));
typedef float f32x2 __attribute__((ext_vector_type(2)));
typedef unsigned v2u __attribute__((ext_vector_type(2)));
__device__ __forceinline__ f32x4 mfma32(bf16x8 x, bf16x8 y, f32x4 c) { return __builtin_amdgcn_mfma_f32_16x16x32_bf16(x, y, c, 0, 0, 0); }
__device__ __forceinline__ f32x4 mfma16(bf16x4 x, bf16x4 y, f32x4 c) { return __builtin_amdgcn_mfma_f32_16x16x16bf16_1k(x, y, c, 0, 0, 0); }
typedef short v4i16_t __attribute__((ext_vector_type(4)));
__device__ __forceinline__ bf16x8 tr_frag(const LAS bf16* p, int pitch) {
    const v4i16_t x = __builtin_amdgcn_ds_read_tr16_b64_v4i16((LAS v4i16_t*)p), y = __builtin_amdgcn_ds_read_tr16_b64_v4i16((LAS v4i16_t*)(p + 4 * pitch));
    return (bf16x8){x[0], x[1], x[2], x[3], y[0], y[1], y[2], y[3]};
}
#define PIN_MEM() asm volatile("" ::: "memory")
struct Args { const float* in[31]; float* out; unsigned char* ws; int ph_lo, ph_hi; };
enum { I_X = 0, I_NORMW, I_WIN, I_LCW, I_LCB, I_LWR, I_LBR, I_LWI, I_LBI, I_LL, I_SLR, I_SLI, I_SLDT, I_SBR, I_SBI, I_SCR, I_SCI, I_SD, I_SGW, I_SGB,
       I_GWG, I_GBG, I_GNW, I_DCW, I_DCB, I_DDTB, I_DALOG, I_DD, I_DNW, I_WOUT, I_NFW };

template <bool MAPPED>
__device__ __forceinline__ void p0_transpose_item(const float* W, int K, int ldw, int nblk, const float* kscale, bf16* WT, LAS float* scr, int item, int lane) {
    const int kb = item / nblk, nb = item % nblk, k0 = 64 * kb, n0 = 32 * nb;
    const int myc = n0 + (lane & 31); const int oc = MAPPED ? orig_col(myc) : myc;
    const int c = lane & 7; float ksc[8];
    { float vv[32]; const int occ = oc >= 0 ? oc : 0;
#pragma unroll
      for (int i = 0; i < 32; ++i) { const int kk = 2 * i + (lane >> 5); vv[i] = W[(size_t)(k0 + kk) * ldw + occ]; }
#pragma unroll
      for (int q = 0; q < 8; ++q) ksc[q] = kscale ? kscale[k0 + 8 * c + q] : 1.0f;
      PIN_MEM();
#pragma unroll
      for (int i = 0; i < 32; ++i) { const int kk = 2 * i + (lane >> 5); scr[kk * 33 + (lane & 31)] = oc >= 0 ? vv[i] : 0.f; } }
    asm volatile("s_waitcnt lgkmcnt(0)" ::: "memory");
#pragma unroll
    for (int j = 0; j < 4; ++j) { const int n = (lane >> 3) + 8 * j; const LAS float* s = scr + (8 * c) * 33 + n;
        v4u o; o.x = pk2(s[0 * 33] * ksc[0], s[1 * 33] * ksc[1]); o.y = pk2(s[2 * 33] * ksc[2], s[3 * 33] * ksc[3]); o.z = pk2(s[4 * 33] * ksc[4], s[5 * 33] * ksc[5]); o.w = pk2(s[6 * 33] * ksc[6], s[7 * 33] * ksc[7]);
        *(GAS v4u*)(WT + (size_t)(n0 + n) * K + k0 + 8 * c) = o; }
    asm volatile("s_waitcnt lgkmcnt(0)" ::: "memory");
}

__device__ __forceinline__ void p0_s5_tables(const Args& a, LAS unsigned char* lds, int item) {
    const int tid = opaque_tid(); const int l = item >> 6, g = (item >> 1) & 31, dh = item & 1;
    LAS f32x2* P = (LAS f32x2*)lds;
    LAS f32x2* BL = P + 32 * 64;
    LAS f32x2* CL = BL + 64 * 16;
    unsigned char* tb = a.ws + WS_S5T + (size_t)l * S5T_LAYER;
    const float dt = expf(a.in[I_SLDT][l * 32 + g]);
    const float* LR = a.in[I_SLR] + l * 2048 + g * 64; const float* LI = a.in[I_SLI] + l * 2048 + g * 64;
    for (int idx = tid; idx < 2048; idx += NTHR) { const int dd = idx >> 6, n = idx & 63, d = dh * 32 + dd;
        const float m = expf(LR[n] * dt * (float)d), ang = LI[n] * dt * (float)d; const f32x2 v = {m * cosf(ang), m * sinf(ang)}; P[dd * 64 + n] = v;
        if (dh == 0 && d <= 16) ((f32x2*)(tb + S5T_PW))[(g * 64 + n) * 17 + d] = v;
        if (dh == 0 && d == 1) ((f32x2*)(tb + S5T_AB))[g * 64 + n] = v; }
    for (int idx = tid; idx < 1024; idx += NTHR) { const int n = idx >> 4, q = idx & 15; const float lr = LR[n], li = LI[n];
        const float mag = expf(lr * dt), abr = mag * cosf(li * dt), abi = mag * sinf(li * dt), den = lr * lr + li * li, nr = abr - 1.0f;
        const float cr = (nr * lr + abi * li) / den, ci = (abi * lr - nr * li) / den;
        const float br = a.in[I_SBR][((size_t)(l * 32 + g) * 64 + n) * 16 + q], bi = a.in[I_SBI][((size_t)(l * 32 + g) * 64 + n) * 16 + q];
        const f32x2 v = {cr * br - ci * bi, cr * bi + ci * br}; BL[n * 16 + q] = v;
        if (dh == 0) { bf16* BC = (bf16*)(tb + S5T_BC); BC[(g * 128 + n) * 16 + q] = (bf16)f2bf(v.x); BC[(g * 128 + 64 + n) * 16 + q] = (bf16)f2bf(v.y); } }
    for (int idx = tid; idx < 1024; idx += NTHR) { const int p = idx >> 6, n = idx & 63;
        const f32x2 v = {a.in[I_SCR][((size_t)(l * 32 + g) * 16 + p) * 64 + n], a.in[I_SCI][((size_t)(l * 32 + g) * 16 + p) * 64 + n]}; CL[p * 64 + n] = v;
        if (dh == 0) { bf16* CC = (bf16*)(tb + S5T_CC); CC[(g * 16 + p) * 128 + 2 * n] = (bf16)f2bf(v.x); CC[(g * 16 + p) * 128 + 2 * n + 1] = (bf16)f2bf(-v.y); } }
    if (dh == 0 && tid < 64) { const float m64 = expf(64.0f * LR[tid] * dt), ang = 64.0f * LI[tid] * dt; const f32x2 v = {m64 * cosf(ang), m64 * sinf(ang)}; ((f32x2*)(tb + S5T_A64))[g * 64 + tid] = v; }
    __syncthreads();
    { const int pq = tid & 255, p = pq >> 4, q = pq & 15, dq = tid >> 8; float s[16];
#pragma unroll
      for (int i = 0; i < 16; ++i) s[i] = 0.f;
#pragma unroll 1
      for (int nh = 0; nh < 4; ++nh) { float cbr[16], cbi[16];
#pragma unroll
          for (int n = 0; n < 16; ++n) { const f32x2 cv = CL[p * 64 + nh * 16 + n], bv = BL[(nh * 16 + n) * 16 + q]; cbr[n] = cv.x * bv.x - cv.y * bv.y; cbi[n] = cv.x * bv.y + cv.y * bv.x; }
#pragma unroll
          for (int i = 0; i < 16; ++i) { const LAS f32x2* pp = P + (dq * 16 + i) * 64 + nh * 16; float t = 0.f;
#pragma unroll
              for (int n = 0; n < 16; ++n) { const f32x2 pw = pp[n]; t += cbr[n] * pw.x - cbi[n] * pw.y; }
              s[i] += t; } }
      bf16* KT = (bf16*)(tb + S5T_KT);
#pragma unroll
      for (int i = 0; i < 16; ++i) KT[((size_t)(g * 64 + dh * 32 + dq * 16 + i) * 16 + p) * 16 + q] = (bf16)f2bf(s[i]); }
    __syncthreads();
}

__device__ __forceinline__ void p0_prologue(const Args& a, LAS unsigned char* lds, int vcu, int G) {
    const int tid = opaque_tid(), lane = tid & 63, wave = __builtin_amdgcn_readfirstlane(tid >> 6);
    for (int item = vcu; item < DEPTH * 64; item += G) p0_s5_tables(a, lds, item);
    for (int idx = vcu * NTHR + tid; idx < DEPTH * 2 * 8 * 64 * 64; idx += G * NTHR) { const int i = idx & 63, j = (idx >> 6) & 63, h = (idx >> 12) & 7, gate = (idx >> 15) & 1, l = idx >> 16;
        ((bf16*)(a.ws + WS_LRW))[idx] = (bf16)f2bf(a.in[gate ? I_LWI : I_LWR][((size_t)(l * 8 + h) * 64 + i) * 64 + j]); }
    LAS float* scr = (LAS float*)(lds + wave * 16384);
    const int gw = vcu * NWAVES + wave, NGW = G * NWAVES;
    for (int it = gw; it < DEPTH * 128; it += NGW) { const int l = it >> 7;
        p0_transpose_item<false>(a.in[I_SGW] + (size_t)l * 512 * 512, 512, 512, 16, nullptr, (bf16*)(a.ws + WS_GLUT) + (size_t)l * 512 * 512, scr, it & 127, lane); }
    constexpr int I_IN = (DM / 64) * (NPAD / 32), I_OUT = (2048 / 64) * (DM / 32);
    for (int it = gw; it < DEPTH * (I_IN + I_OUT); it += NGW) {
        const int l = it / (I_IN + I_OUT); int r = it % (I_IN + I_OUT);
        if (r < I_IN) p0_transpose_item<true>(a.in[I_WIN] + (size_t)l * DM * DIN, DM, DIN, NPAD / 32, a.in[I_NORMW] + l * DM, (bf16*)(a.ws + WS_WIN) + (size_t)l * NPAD * DM, scr, r, lane);
        else p0_transpose_item<false>(a.in[I_WOUT] + (size_t)l * 2048 * DM, 2048, DM, DM / 32, nullptr, (bf16*)(a.ws + WS_WOUT) + (size_t)l * DM * 2048, scr, r - I_IN, lane);
    }
    float* rowss0 = (float*)(a.ws + WS_PART);
    for (int m0 = gw; m0 < T; m0 += 4 * NGW) {
        f32x4 v[4][4];
#pragma unroll
        for (int r = 0; r < 4; ++r)
#pragma unroll
            for (int j = 0; j < 4; ++j) v[r][j] = ((const GAS f32x4*)(a.in[I_X] + (size_t)(m0 + r * NGW) * DM) + lane)[64 * j];
        PIN_MEM();
#pragma unroll
        for (int r = 0; r < 4; ++r) { const int m = m0 + r * NGW; float s = 0.f;
            GAS unsigned long long* o8 = (GAS unsigned long long*)((bf16*)a.out + (size_t)m * DM) + lane;
#pragma unroll
            for (int j = 0; j < 4; ++j) { const f32x4 x = v[r][j]; s += (x.x * x.x + x.y * x.y) + (x.z * x.z + x.w * x.w);
                o8[64 * j] = (unsigned long long)pk2(x.x, x.y) | ((unsigned long long)pk2(x.z, x.w) << 32); }
            s = wave_sum(s); if (lane < 16) rowss0[(size_t)m * 16 + lane] = lane == 0 ? s : 0.f; }
    }
}

__device__ __forceinline__ void ex_chunk(const Args& a, int l, int c) {
    const int tid = opaque_tid(), lane = tid & 63, w = __builtin_amdgcn_readfirstlane(tid >> 6), l15 = lane & 15, lq = lane >> 4;
    const int nt = w & 1, tt = w >> 1, t = c * 64 + 16 * tt + l15;
    const bf16* wp = (const bf16*)(a.ws + WS_WIN) + ((size_t)l * NPAD + PJ + 16 * nt + l15) * DM + 8 * lq;
    const bf16* xp = (const bf16*)a.out + (size_t)t * DM + 8 * lq;
    const float* rs = (const float*)(a.ws + WS_PART) + (size_t)l * T * 16 + (size_t)t * 16;
    const f32x4 p0 = *(const GAS f32x4*)(rs), p1 = *(const GAS f32x4*)(rs + 4), p2 = *(const GAS f32x4*)(rs + 8), p3 = *(const GAS f32x4*)(rs + 12);
    f32x4 acc = (f32x4){0.f, 0.f, 0.f, 0.f};
#pragma unroll 1
    for (int kb = 0; kb < 4; ++kb) { bf16x8 xf[8], yf[8];
#pragma unroll
        for (int k8 = 0; k8 < 8; ++k8) { xf[k8] = *(const GAS bf16x8*)(wp + 32 * (kb * 8 + k8)); yf[k8] = *(const GAS bf16x8*)(xp + 32 * (kb * 8 + k8)); }
        PIN_MEM();
#pragma unroll
        for (int k8 = 0; k8 < 8; ++k8) acc = mfma32(xf[k8], yf[k8], acc); }
    const float rsum = (((p0[0] + p0[1]) + (p0[2] + p0[3])) + ((p1[0] + p1[1]) + (p1[2] + p1[3]))) + (((p2[0] + p2[1]) + (p2[2] + p2[3])) + ((p3[0] + p3[1]) + (p3[2] + p3[3])));
    const float rstd = frsq(rsum * (1.0f / 1024.0f) + EPS);
    *(GAS f32x4*)((float*)(a.ws + WS_EX) + (size_t)t * 32 + 16 * nt + 4 * lq) = acc * rstd;
}

template <int CTRL> __device__ __forceinline__ float dppf(float old, float v) { return __builtin_bit_cast(float, __builtin_amdgcn_update_dpp(__builtin_bit_cast(int, old), __builtin_bit_cast(int, v), CTRL, 0xF, 0xF, false)); }
template <int CTRL> __device__ __forceinline__ float dppz(float v) { return __builtin_bit_cast(float, __builtin_amdgcn_update_dpp(0, __builtin_bit_cast(int, v), CTRL, 0xF, 0xF, true)); }
#define LRU_S4(SH) \
    "v_fmac_f32_dpp %4, %4, %0 row_shr:" #SH " row_mask:0xf bank_mask:0xf\n v_fmac_f32_dpp %5, %5, %1 row_shr:" #SH " row_mask:0xf bank_mask:0xf\n" \
    "v_fmac_f32_dpp %6, %6, %2 row_shr:" #SH " row_mask:0xf bank_mask:0xf\n v_fmac_f32_dpp %7, %7, %3 row_shr:" #SH " row_mask:0xf bank_mask:0xf\n" \
    "v_mul_f32_dpp %0, %0, %0 row_shr:" #SH " row_mask:0xf bank_mask:0xf\n v_mul_f32_dpp %1, %1, %1 row_shr:" #SH " row_mask:0xf bank_mask:0xf\n" \
    "v_mul_f32_dpp %2, %2, %2 row_shr:" #SH " row_mask:0xf bank_mask:0xf\n v_mul_f32_dpp %3, %3, %3 row_shr:" #SH " row_mask:0xf bank_mask:0xf\n"
__device__ __forceinline__ void lru_scan4(float (&A)[4], float (&B)[4]) {
    asm("s_nop 1\n" LRU_S4(1) LRU_S4(2) LRU_S4(4) LRU_S4(8) "s_nop 1\n"
        : "+v"(A[0]), "+v"(A[1]), "+v"(A[2]), "+v"(A[3]), "+v"(B[0]), "+v"(B[1]), "+v"(B[2]), "+v"(B[3]));
}
#define LRU_SCAN_STEP(CTRL) do { const float Ap = dppf<CTRL>(1.0f, A[mt]), Bp = dppf<CTRL>(0.0f, B[mt]); B[mt] = A[mt] * Bp + B[mt]; A[mt] = A[mt] * Ap; } while (0)
__device__ __forceinline__ void lru_chunk(const Args& a, int l, int c, bool fin, LAS unsigned char* lds, bool dry = false, bool conv_only = false) {
    const int tid = opaque_tid(), lane = tid & 63, h = __builtin_amdgcn_readfirstlane(tid >> 6), l15 = lane & 15, lq = lane >> 4;
    const int t0 = c * 64; const bool hp = (c % CPB) != 0;
    bf16* PR = (bf16*)(a.ws + WS_PROJ);
    bf16x8 yf[4][2];
#pragma unroll
    for (int ks = 0; ks < 2; ++ks) {
        const int i0 = h * 64 + 32 * ks + 8 * lq; float cw[4][8], cb[8];
#pragma unroll
        for (int v = 0; v < 4; ++v) { const f32x4 w0 = *(const GAS f32x4*)(a.in[I_LCW] + (size_t)(l * 4 + v) * 512 + i0), w1 = *(const GAS f32x4*)(a.in[I_LCW] + (size_t)(l * 4 + v) * 512 + i0 + 4);
            cw[v][0] = w0[0]; cw[v][1] = w0[1]; cw[v][2] = w0[2]; cw[v][3] = w0[3]; cw[v][4] = w1[0]; cw[v][5] = w1[1]; cw[v][6] = w1[2]; cw[v][7] = w1[3]; }
        { const f32x4 b0 = *(const GAS f32x4*)(a.in[I_LCB] + l * 512 + i0), b1 = *(const GAS f32x4*)(a.in[I_LCB] + l * 512 + i0 + 4);
          cb[0] = b0[0]; cb[1] = b0[1]; cb[2] = b0[2]; cb[3] = b0[3]; cb[4] = b1[0]; cb[5] = b1[1]; cb[6] = b1[2]; cb[7] = b1[3]; }
#pragma unroll
        for (int mt = 0; mt < 4; ++mt) { const int t = 16 * mt + l15; float u[8];
#pragma unroll
            for (int q = 0; q < 8; ++q) u[q] = cb[q];
#pragma unroll
            for (int v = 0; v < 4; ++v) { const int tt = t - 3 + v; const int row = (t0 + tt) < 0 ? 0 : (t0 + tt);
                v4u raw = *(const GAS v4u*)(PR + (size_t)row * PJ + A_X + i0);
                if (!(tt >= 0 || hp)) raw = (v4u){0u, 0u, 0u, 0u};
                u[0] += cw[v][0] * bflo(raw.x); u[1] += cw[v][1] * bfhi(raw.x); u[2] += cw[v][2] * bflo(raw.y); u[3] += cw[v][3] * bfhi(raw.y);
                u[4] += cw[v][4] * bflo(raw.z); u[5] += cw[v][5] * bfhi(raw.z); u[6] += cw[v][6] * bflo(raw.w); u[7] += cw[v][7] * bfhi(raw.w); }
            v4u pk; pk.x = pk2(u[0], u[1]); pk.y = pk2(u[2], u[3]); pk.z = pk2(u[4], u[5]); pk.w = pk2(u[6], u[7]); yf[mt][ks] = __builtin_bit_cast(bf16x8, pk); }
    }
    if (conv_only) {
#pragma unroll
        for (int mt = 0; mt < 4; ++mt) { asm volatile("" :: "v"(yf[mt][0]), "v"(yf[mt][1])); }
        return; }
    const bf16* WRt = (const bf16*)(a.ws + WS_LRW) + (size_t)((l * 2 + 0) * 8 + h) * 4096; const bf16* WIt = (const bf16*)(a.ws + WS_LRW) + (size_t)((l * 2 + 1) * 8 + h) * 4096;
#define LRU_LOADS(J, XR, XI, BR, BI, LL) do { const int ch0_ = h * 64 + 16 * (J) + 4 * lq; \
        _Pragma("unroll") for (int ks = 0; ks < 2; ++ks) { XR[ks] = *(const GAS bf16x8*)(WRt + (size_t)(16 * (J) + l15) * 64 + 32 * ks + 8 * lq); XI[ks] = *(const GAS bf16x8*)(WIt + (size_t)(16 * (J) + l15) * 64 + 32 * ks + 8 * lq); } \
        BR = *(const GAS f32x4*)(a.in[I_LBR] + l * 512 + ch0_); BI = *(const GAS f32x4*)(a.in[I_LBI] + l * 512 + ch0_); LL = *(const GAS f32x4*)(a.in[I_LL] + l * 512 + ch0_); \
        } while (0)
    bf16x8 cxr[2], cxi[2], nxr[2], nxi[2]; f32x4 br4, bi4, ll4, nbr, nbi, nll;
    LRU_LOADS(0, cxr, cxi, br4, bi4, ll4);
#pragma unroll 1
    for (int jt = 0; jt < 4; ++jt) {
        const int jn = jt < 3 ? jt + 1 : 3;
        LRU_LOADS(jn, nxr, nxi, nbr, nbi, nll);
        const int ch0 = h * 64 + 16 * jt + 4 * lq;
        f32x4 hin4 = (f32x4){0.f, 0.f, 0.f, 0.f}; v2u czv[4];
#pragma unroll
        for (int mt = 0; mt < 4; ++mt) czv[mt] = (v2u){0u, 0u};
        if (fin) { hin4 = *(const GAS f32x4*)((const float*)(a.ws + WS_LRUH) + (size_t)c * 512 + ch0);
#pragma unroll
            for (int mt = 0; mt < 4; ++mt) czv[mt] = *(const GAS v2u*)(PR + (size_t)(t0 + 16 * mt + l15) * PJ + A_Z + ch0); }
        PIN_MEM();
        f32x4 ar[4], ai[4], au[4];
#pragma unroll
        for (int mt = 0; mt < 4; ++mt) { ar[mt] = (f32x4){0.f, 0.f, 0.f, 0.f}; ai[mt] = ar[mt]; au[mt] = ar[mt]; }
#pragma unroll
        for (int ks = 0; ks < 2; ++ks) {
            bf16x8 xu = (bf16x8){0, 0, 0, 0, 0, 0, 0, 0};
#pragma unroll
            for (int e = 0; e < 8; ++e) xu[e] = (32 * ks + 8 * lq + e == 16 * jt + l15) ? (short)0x3F80 : (short)0;
#pragma unroll
            for (int mt = 0; mt < 4; ++mt) { ar[mt] = mfma32(cxr[ks], yf[mt][ks], ar[mt]); ai[mt] = mfma32(cxi[ks], yf[mt][ks], ai[mt]); au[mt] = mfma32(xu, yf[mt][ks], au[mt]); }
        }
        float hv[4][4]; unsigned cpk[4][4];
#pragma unroll
        for (int r = 0; r < 4; ++r) {
            const float sp = softplus(-ll4[r]); float A[4], B[4];
#pragma unroll
            for (int mt = 0; mt < 4; ++mt) { const float rg = sigm(ar[mt][r] + br4[r]), ig = sigm(ai[mt][r] + bi4[r]); const float la = -8.0f * rg * sp;
                A[mt] = fexp(la); B[mt] = fsqrt((1.0f - A[mt]) * (1.0f + A[mt])) * ig * au[mt][r]; }
            lru_scan4(A, B);
            float Ac = 1.0f, Bc = 0.0f;
#pragma unroll
            for (int mt = 0; mt < 4; ++mt) { B[mt] = A[mt] * Bc + B[mt]; A[mt] = A[mt] * Ac; Ac = dppz<0x15F>(A[mt]); Bc = dppz<0x15F>(B[mt]); }
            if (fin) {
#pragma unroll
                for (int mt = 0; mt < 4; ++mt) hv[mt][r] = B[mt] + A[mt] * hin4[r];
            } else {
#pragma unroll
                for (int mt = 0; mt < 4; ++mt) cpk[mt][r] = pk2(A[mt], B[mt]);
                if (l15 == 15) { float* E = (float*)(a.ws + WS_LRUE) + ((size_t)c * 512 + ch0 + r) * 2; E[0] = A[3]; E[1] = B[3]; }
            }
        }
        if (!fin) {
#pragma unroll
            for (int mt = 0; mt < 4; ++mt) { v4u o; o.x = cpk[mt][0]; o.y = cpk[mt][1]; o.z = cpk[mt][2]; o.w = cpk[mt][3];
                *(GAS v4u*)((unsigned*)a.out + (size_t)8388608 + (size_t)(t0 + 16 * mt + l15) * 512 + ch0) = o; }
        }
        if (fin) {
#pragma unroll
            for (int mt = 0; mt < 4; ++mt) { GAS v2u* zp = (GAS v2u*)(PR + (size_t)(t0 + 16 * mt + l15) * PJ + A_Z + ch0); const v2u zv = czv[mt];
                v2u o; o.x = pk2(hv[mt][0] * silu(bflo(zv.x)), hv[mt][1] * silu(bfhi(zv.x))); o.y = pk2(hv[mt][2] * silu(bflo(zv.y)), hv[mt][3] * silu(bfhi(zv.y))); if (dry) asm volatile("" :: "v"(o.x), "v"(o.y)); else *zp = o; }
        }
#pragma unroll
        for (int ks = 0; ks < 2; ++ks) { cxr[ks] = nxr[ks]; cxi[ks] = nxi[ks]; }
        br4 = nbr; bi4 = nbi; ll4 = nll;
    }
#undef LRU_LOADS
}

__device__ __forceinline__ void lru_out(const Args& a, int l, int c, bool dry = false) {
    const int tid = opaque_tid(), cg = tid & 63, tq = tid >> 6; const int t0 = c * 64;
    bf16* PR = (bf16*)(a.ws + WS_PROJ); const unsigned* LC = (const unsigned*)a.out + (size_t)8388608;
    const f32x4 h0 = *(const GAS f32x4*)((const float*)(a.ws + WS_LRUH) + (size_t)c * 512 + 8 * cg), h1 = *(const GAS f32x4*)((const float*)(a.ws + WS_LRUH) + (size_t)c * 512 + 8 * cg + 4);
    v4u p0[8], p1[8], zz[8];
#pragma unroll
    for (int i = 0; i < 8; ++i) { const size_t t = (size_t)(t0 + 8 * tq + i);
        p0[i] = *(const GAS v4u*)(LC + t * 512 + 8 * cg); p1[i] = *(const GAS v4u*)(LC + t * 512 + 8 * cg + 4); zz[i] = *(const GAS v4u*)(PR + t * PJ + A_Z + 8 * cg); }
    PIN_MEM();
#pragma unroll
    for (int i = 0; i < 8; ++i) { const size_t t = (size_t)(t0 + 8 * tq + i);
        const float y0 = (bfhi(p0[i].x) + bflo(p0[i].x) * h0[0]) * silu(bflo(zz[i].x)), y1 = (bfhi(p0[i].y) + bflo(p0[i].y) * h0[1]) * silu(bfhi(zz[i].x));
        const float y2 = (bfhi(p0[i].z) + bflo(p0[i].z) * h0[2]) * silu(bflo(zz[i].y)), y3 = (bfhi(p0[i].w) + bflo(p0[i].w) * h0[3]) * silu(bfhi(zz[i].y));
        const float y4 = (bfhi(p1[i].x) + bflo(p1[i].x) * h1[0]) * silu(bflo(zz[i].z)), y5 = (bfhi(p1[i].y) + bflo(p1[i].y) * h1[1]) * silu(bfhi(zz[i].z));
        const float y6 = (bfhi(p1[i].z) + bflo(p1[i].z) * h1[2]) * silu(bflo(zz[i].w)), y7 = (bfhi(p1[i].w) + bflo(p1[i].w) * h1[3]) * silu(bfhi(zz[i].w));
        v4u o; o.x = pk2(y0, y1); o.y = pk2(y2, y3); o.z = pk2(y4, y5); o.w = pk2(y6, y7);
        if (dry) asm volatile("" :: "v"(o.x), "v"(o.y), "v"(o.z), "v"(o.w)); else *(GAS v4u*)(PR + t * PJ + A_Z + 8 * cg) = o; }
}

constexpr int UBP = 520;
__device__ __forceinline__ void s5_local(const Args& a, int l, int c) {
    const int tid = opaque_tid(), lane = tid & 63, w = __builtin_amdgcn_readfirstlane(tid >> 6), l15 = lane & 15, lq = lane >> 4;
    const int t0 = c * 64;
    const bf16* PR = (const bf16*)(a.ws + WS_PROJ);
    const unsigned char* tb = a.ws + WS_S5T + (size_t)l * S5T_LAYER;
    const bf16* BC = (const bf16*)(tb + S5T_BC); const f32x2* PW = (const f32x2*)(tb + S5T_PW);
    f32x2* ST = (f32x2*)(a.ws + WS_S5ST) + (size_t)c * 2048;
#pragma unroll 2
    for (int k = 0; k < 4; ++k) {
        const int g = 4 * w + k; bf16x4 yf[4], xr[4], xi[4]; f32x2 wb[4][4], st[4][4];
#pragma unroll
        for (int nt = 0; nt < 4; ++nt) yf[nt] = *(const GAS bf16x4*)(PR + (size_t)(t0 + 16 * nt + l15) * PJ + B_U + g * 16 + 4 * lq);
#pragma unroll
        for (int mt = 0; mt < 4; ++mt) { xr[mt] = *(const GAS bf16x4*)(BC + ((size_t)g * 128 + 16 * mt + l15) * 16 + 4 * lq); xi[mt] = *(const GAS bf16x4*)(BC + ((size_t)g * 128 + 64 + 16 * mt + l15) * 16 + 4 * lq);
#pragma unroll
            for (int r = 0; r < 4; ++r) { const int n = 16 * mt + 4 * lq + r; wb[mt][r] = PW[(g * 64 + n) * 17 + (15 - l15)]; st[mt][r] = PW[(g * 64 + n) * 17 + 16]; } }
        PIN_MEM();
#pragma unroll
        for (int mt = 0; mt < 4; ++mt) {
            f32x4 ar[4], ai[4];
#pragma unroll
            for (int nt = 0; nt < 4; ++nt) { ar[nt] = mfma16(xr[mt], yf[nt], (f32x4){0.f, 0.f, 0.f, 0.f}); ai[nt] = mfma16(xi[mt], yf[nt], (f32x4){0.f, 0.f, 0.f, 0.f}); }
#pragma unroll
            for (int r = 0; r < 4; ++r) {
                const int n = 16 * mt + 4 * lq + r; const f32x2 s16 = st[mt][r];
                float er = 0.f, ei = 0.f, wr = wb[mt][r].x, wi = wb[mt][r].y;
#pragma unroll
                for (int nt = 3; nt >= 0; --nt) { const float br = ar[nt][r], bi = ai[nt][r]; er += wr * br - wi * bi; ei += wr * bi + wi * br;
                    const float nwr = wr * s16.x - wi * s16.y, nwi = wr * s16.y + wi * s16.x; wr = nwr; wi = nwi; }
                er += dppz<0x111>(er); ei += dppz<0x111>(ei); er += dppz<0x112>(er); ei += dppz<0x112>(ei);
                er += dppz<0x114>(er); ei += dppz<0x114>(ei); er += dppz<0x118>(er); ei += dppz<0x118>(ei);
                if (l15 == 15) { const f32x2 v = {er, ei}; ST[g * 64 + n] = v; }
            }
        }
    }
}
__device__ __forceinline__ void s5_out(const Args& a, int l, int c, LAS unsigned char* lds, bool dry = false) {
    const int tid = opaque_tid(), lane = tid & 63, w = __builtin_amdgcn_readfirstlane(tid >> 6), l15 = lane & 15, lq = lane >> 4;
    const int t0 = c * 64;
    LAS bf16* ub = (LAS bf16*)lds;
    bf16* PR = (bf16*)(a.ws + WS_PROJ);
    { v4u ut[8];
#pragma unroll
      for (int i = 0; i < 8; ++i) { const int idx = tid + NTHR * i, row = idx >> 6, c8 = idx & 63; ut[i] = *(const GAS v4u*)(PR + (size_t)(t0 + row) * PJ + B_U + c8 * 8); }
      PIN_MEM();
      for (int idx = tid; idx < 16 * 65; idx += NTHR) { const int row = idx / 65, c8 = idx % 65; *(LAS v4u*)(ub + row * UBP + c8 * 8) = (v4u){0u, 0u, 0u, 0u}; }
#pragma unroll
      for (int i = 0; i < 8; ++i) { const int idx = tid + NTHR * i, row = idx >> 6, c8 = idx & 63; *(LAS v4u*)(ub + (16 + row) * UBP + c8 * 8) = ut[i]; } }
    __syncthreads();
    const unsigned char* tb = a.ws + WS_S5T + (size_t)l * S5T_LAYER;
    const bf16* KT = (const bf16*)(tb + S5T_KT); const bf16* CC = (const bf16*)(tb + S5T_CC); const f32x2* PW = (const f32x2*)(tb + S5T_PW);
    const f32x2* ST = (const f32x2*)(a.ws + WS_S5ST) + (size_t)c * 2048;
#define S5_KLOAD(dst, kb) do { _Pragma("unroll") for (int k8 = 0; k8 < 8; ++k8) dst[k8] = *(const GAS bf16x8*)(kp + (size_t)(2 * ((kb) * 8 + k8)) * 256); } while (0)
#define S5_KMMA(src, kb) do { _Pragma("unroll") for (int k8 = 0; k8 < 8; ++k8) { _Pragma("unroll") for (int it = (kb); it < 4; ++it) { \
        const bf16x8 yf = *(const LAS bf16x8*)(up + (16 * it - 2 * ((kb) * 8 + k8)) * UBP); acc[it] = mfma32(src[k8], yf, acc[it]); } } } while (0)
#pragma unroll 1
    for (int k = 0; k < 4; ++k) {
        const int g = 4 * w + k; f32x4 acc[4];
#pragma unroll
        for (int it = 0; it < 4; ++it) acc[it] = (f32x4){0.f, 0.f, 0.f, 0.f};
        const bf16* kp = KT + ((size_t)(g * 64 + (lq >> 1)) * 16 + l15) * 16 + 8 * (lq & 1);
        const LAS bf16* up = ub + (16 + l15 - (lq >> 1)) * UBP + g * 16 + 8 * (lq & 1);
        bf16x8 ka[8], kc[8];
        S5_KLOAD(ka, 0); S5_KLOAD(kc, 1); PIN_MEM();
        S5_KMMA(ka, 0);
        S5_KLOAD(ka, 2); PIN_MEM();
        S5_KMMA(kc, 1);
        bf16x8 xfc[4]; f32x2 pb[4][4], ps[4][4], sv[4][4];
        S5_KLOAD(kc, 3);
#pragma unroll
        for (int ks2 = 0; ks2 < 4; ++ks2) { xfc[ks2] = *(const GAS bf16x8*)(CC + ((size_t)g * 16 + l15) * 128 + 32 * ks2 + 8 * lq);
#pragma unroll
            for (int m = 0; m < 4; ++m) { const int n = 16 * ks2 + 4 * lq + m; pb[ks2][m] = PW[(g * 64 + n) * 17 + l15 + 1]; ps[ks2][m] = PW[(g * 64 + n) * 17 + 16]; sv[ks2][m] = ST[g * 64 + n]; } }
        const f32x4 dsk = *(const GAS f32x4*)(a.in[I_SD] + l * 512 + g * 16 + 4 * lq);
        PIN_MEM();
        S5_KMMA(ka, 2);
        S5_KMMA(kc, 3);
#pragma unroll
        for (int ks2 = 0; ks2 < 4; ++ks2) {
            float pr[4], pi[4];
#pragma unroll
            for (int m = 0; m < 4; ++m) { pr[m] = pb[ks2][m].x; pi[m] = pb[ks2][m].y; }
#pragma unroll
            for (int it = 0; it < 4; ++it) {
                v4u zz; unsigned zw[4];
#pragma unroll
                for (int m = 0; m < 4; ++m) { const float sr = sv[ks2][m].x, si = sv[ks2][m].y, qr = ps[ks2][m].x, qi = ps[ks2][m].y;
                    const float zr = pr[m] * sr - pi[m] * si, zi = pr[m] * si + pi[m] * sr; zw[m] = pk2(zr, zi);
                    const float nr = pr[m] * qr - pi[m] * qi, ni = pr[m] * qi + pi[m] * qr; pr[m] = nr; pi[m] = ni; }
                zz.x = zw[0]; zz.y = zw[1]; zz.z = zw[2]; zz.w = zw[3];
                acc[it] = mfma32(xfc[ks2], __builtin_bit_cast(bf16x8, zz), acc[it]);
            }
        }
#pragma unroll
        for (int it = 0; it < 4; ++it) { LAS v2u* p = (LAS v2u*)(ub + (16 + 16 * it + l15) * UBP + g * 16 + 4 * lq); const v2u uv = *p;
            const float y0 = gelu_tanh(acc[it][0] + dsk[0] * bflo(uv.x)), y1 = gelu_tanh(acc[it][1] + dsk[1] * bfhi(uv.x)), y2 = gelu_tanh(acc[it][2] + dsk[2] * bflo(uv.y)), y3 = gelu_tanh(acc[it][3] + dsk[3] * bfhi(uv.y));
            v2u o; o.x = pk2(y0, y1); o.y = pk2(y2, y3); *p = o; }
    }
#undef S5_KLOAD
#undef S5_KMMA
    {
        f32x4 acc[4][4]; v2u zv[4][4]; f32x4 gb[4];
        const bf16* wp = (const bf16*)(a.ws + WS_GLUT) + (size_t)l * 512 * 512 + (size_t)(64 * w + l15) * 512 + 8 * lq;
        bf16x8 xa[4], xb[4];
#pragma unroll
        for (int jt = 0; jt < 4; ++jt) { xa[jt] = *(const GAS bf16x8*)(wp + (size_t)(16 * jt) * 512); gb[jt] = *(const GAS f32x4*)(a.in[I_SGB] + l * 512 + 64 * w + 16 * jt + 4 * lq);
#pragma unroll
            for (int tt = 0; tt < 4; ++tt) { zv[jt][tt] = *(const GAS v2u*)(PR + (size_t)(t0 + 16 * tt + l15) * PJ + B_Z + 64 * w + 16 * jt + 4 * lq); acc[jt][tt] = (f32x4){0.f, 0.f, 0.f, 0.f}; } }
        PIN_MEM();
        __syncthreads();
        const LAS bf16* yp = ub + (16 + l15) * UBP + 8 * lq;
#define S5_GMMA(xf, ks) do { bf16x8 yf[4]; _Pragma("unroll") for (int tt = 0; tt < 4; ++tt) yf[tt] = *(const LAS bf16x8*)(yp + (16 * tt) * UBP + 32 * (ks)); \
        _Pragma("unroll") for (int jt = 0; jt < 4; ++jt) _Pragma("unroll") for (int tt = 0; tt < 4; ++tt) acc[jt][tt] = mfma32(xf[jt], yf[tt], acc[jt][tt]); } while (0)
#pragma unroll 1
        for (int k2 = 0; k2 < 8; ++k2) {
#pragma unroll
            for (int jt = 0; jt < 4; ++jt) xb[jt] = *(const GAS bf16x8*)(wp + (size_t)(16 * jt) * 512 + 32 * (2 * k2 + 1));
            PIN_MEM();
            S5_GMMA(xa, 2 * k2);
            const int kn = k2 < 7 ? 2 * k2 + 2 : 15;
#pragma unroll
            for (int jt = 0; jt < 4; ++jt) xa[jt] = *(const GAS bf16x8*)(wp + (size_t)(16 * jt) * 512 + 32 * kn);
            PIN_MEM();
            S5_GMMA(xb, 2 * k2 + 1);
        }
#undef S5_GMMA
#pragma unroll
        for (int jt = 0; jt < 4; ++jt) { const int j0 = 64 * w + 16 * jt + 4 * lq;
#pragma unroll
            for (int tt = 0; tt < 4; ++tt) { const int t = 16 * tt + l15; const v2u yv = *(const LAS v2u*)(ub + (16 + t) * UBP + j0);
                GAS v2u* zp = (GAS v2u*)(PR + (size_t)(t0 + t) * PJ + B_Z + j0); const v2u zz = zv[jt][tt];
                const float o0 = bflo(yv.x) * sigm(acc[jt][tt][0] + gb[jt][0]) * silu(bflo(zz.x)), o1 = bfhi(yv.x) * sigm(acc[jt][tt][1] + gb[jt][1]) * silu(bfhi(zz.x));
                const float o2 = bflo(yv.y) * sigm(acc[jt][tt][2] + gb[jt][2]) * silu(bflo(zz.y)), o3 = bfhi(yv.y) * sigm(acc[jt][tt][3] + gb[jt][3]) * silu(bfhi(zz.y));
                v2u o; o.x = pk2(o0, o1); o.y = pk2(o2, o3); if (dry) asm volatile("" :: "v"(o.x), "v"(o.y)); else *zp = o; } }
    }
    __syncthreads();
}

__device__ __forceinline__ void s5_chunk(const Args& a, int l, int c, bool fin, LAS unsigned char* lds, bool dry = false) { if (fin) s5_out(a, l, c, lds, dry); else s5_local(a, l, c); }

constexpr int QP = 264, VPF = 520, SPP = 72;
constexpr int GLA_QD = 0, GLA_KI = 33792, GLA_VV = 67584, GLA_SS = 134144, GLA_GT = 134144, GLA_GLW = 136192;
__device__ __forceinline__ void gla_chunk(const Args& a, int l, int c, bool fin, LAS unsigned char* lds, bool dry = false) {
    const int tid = opaque_tid(), lane = tid & 63, w = __builtin_amdgcn_readfirstlane(tid >> 6), l15 = lane & 15, lq = lane >> 4; const int t0 = c * 64;
    LAS bf16* QD = (LAS bf16*)(lds + GLA_QD); LAS bf16* KI = (LAS bf16*)(lds + GLA_KI); LAS bf16* VV = (LAS bf16*)(lds + GLA_VV); LAS bf16* SS = (LAS bf16*)(lds + GLA_SS);
    LAS float* GT = (LAS float*)(lds + GLA_GT); LAS float* GLW = (LAS float*)(lds + GLA_GLW);
    bf16* PR = (bf16*)(a.ws + WS_PROJ); const float* EX = (const float*)(a.ws + WS_EX);
    bf16* KV = (bf16*)(a.ws + WS_GLA) + (size_t)c * 32768;
    const int d = tid & 255, half = tid >> 8; float g[32]; unsigned short kraw[32], qraw[32];
    { float wg[16]; v4u vt[8];
      const f32x2 glr = *(const GAS f32x2*)(EX + (size_t)(t0 + (tid >> 3)) * 32 + 2 * (tid & 7));
#pragma unroll
      for (int r = 0; r < 16; ++r) wg[r] = a.in[I_GWG][(size_t)(l * 16 + r) * 256 + d];
      const float bg = a.in[I_GBG][l * 256 + d];
#pragma unroll
      for (int i = 0; i < 8; ++i) { const int idx = tid + NTHR * i, row = idx >> 6, c8 = idx & 63; vt[i] = *(const GAS v4u*)(PR + (size_t)(t0 + row) * PJ + C_V + c8 * 8); }
#pragma unroll
      for (int tt = 0; tt < 32; ++tt) { kraw[tt] = PR[(size_t)(t0 + 32 * half + tt) * PJ + C_K + d]; qraw[tt] = PR[(size_t)(t0 + 32 * half + tt) * PJ + C_Q + d]; }
      PIN_MEM();
      *(LAS f32x2*)(GLW + (tid >> 3) * 16 + 2 * (tid & 7)) = glr;
#pragma unroll
      for (int i = 0; i < 8; ++i) { const int idx = tid + NTHR * i, row = idx >> 6, c8 = idx & 63; *(LAS v4u*)(VV + row * VPF + c8 * 8) = vt[i]; }
      __syncthreads();
      float run = 0.f;
#pragma unroll
      for (int tt = 0; tt < 32; ++tt) { const LAS f32x4* gl = (const LAS f32x4*)(GLW + (32 * half + tt) * 16); const f32x4 g0 = gl[0], g1 = gl[1], g2 = gl[2], g3 = gl[3];
          float lg = bg + ((g0[0] * wg[0] + g0[1] * wg[1]) + (g0[2] * wg[2] + g0[3] * wg[3])) + ((g1[0] * wg[4] + g1[1] * wg[5]) + (g1[2] * wg[6] + g1[3] * wg[7]))
                        + ((g2[0] * wg[8] + g2[1] * wg[9]) + (g2[2] * wg[10] + g2[3] * wg[11])) + ((g3[0] * wg[12] + g3[1] * wg[13]) + (g3[2] * wg[14] + g3[3] * wg[15]));
          run += -softplus(-lg) * (1.0f / 16.0f); g[tt] = run; }
      GT[half * 256 + d] = run; }
    __syncthreads();
    { const float tot0 = GT[d], tot1 = GT[256 + d], off = half ? tot0 : 0.f, glast = tot0 + tot1;
      const float kofs = fin ? 0.f : glast;
#pragma unroll
      for (int tt = 0; tt < 32; ++tt) { const int t = 32 * half + tt; const float gc = g[tt] + off; const float kx = bf2f(kraw[tt]), qx = bf2f(qraw[tt]);
          QD[t * QP + d] = (bf16)f2bf(qx * 0.125f * fexp(gc)); KI[t * QP + d] = (bf16)f2bf(kx * fexp(kofs - gc)); }
      if (!fin && half == 0) ((float*)(a.ws + WS_GDEC))[(size_t)c * 256 + d] = fexp(glast); }
    __syncthreads();
    if (!fin) {
        const int h = w >> 1, eh = w & 1; f32x4 acc[4][4];
#pragma unroll
        for (int dt = 0; dt < 4; ++dt)
#pragma unroll
            for (int et = 0; et < 4; ++et) acc[dt][et] = (f32x4){0.f, 0.f, 0.f, 0.f};
#pragma unroll
        for (int ks = 0; ks < 2; ++ks) { bf16x8 xf[4], yf[4];
#pragma unroll
            for (int dt = 0; dt < 4; ++dt) xf[dt] = tr_frag(KI + (32 * ks + 8 * lq + (l15 >> 2)) * QP + h * 64 + 16 * dt + 4 * (l15 & 3), QP);
#pragma unroll
            for (int et = 0; et < 4; ++et) yf[et] = tr_frag(VV + (32 * ks + 8 * lq + (l15 >> 2)) * VPF + h * 128 + 64 * eh + 16 * et + 4 * (l15 & 3), VPF);
#pragma unroll
            for (int dt = 0; dt < 4; ++dt)
#pragma unroll
                for (int et = 0; et < 4; ++et) acc[dt][et] = mfma32(xf[dt], yf[et], acc[dt][et]); }
#pragma unroll
        for (int dt = 0; dt < 4; ++dt)
#pragma unroll
            for (int et = 0; et < 4; ++et) { v2u o; o.x = pk2(acc[dt][et][0], acc[dt][et][1]); o.y = pk2(acc[dt][et][2], acc[dt][et][3]);
                *(GAS v2u*)(KV + ((size_t)h * 128 + 64 * eh + 16 * et + l15) * 64 + 16 * dt + 4 * lq) = o; }
    } else {
#pragma unroll 1
        for (int rd = 0; rd < 2; ++rd) {
            const int hl = w >> 2, it = w & 3, h = 2 * rd + hl, i = 16 * it + l15; LAS bf16* SSw = SS + w * 16 * SPP;
            bf16x8 pf[2][8]; v2u zv[8]; f32x4 nw[8];
#pragma unroll
            for (int ks = 0; ks < 2; ++ks)
#pragma unroll
                for (int et = 0; et < 8; ++et) pf[ks][et] = *(const GAS bf16x8*)(KV + ((size_t)h * 128 + 16 * et + l15) * 64 + 32 * ks + 8 * lq);
#pragma unroll
            for (int et = 0; et < 8; ++et) { zv[et] = *(const GAS v2u*)(PR + (size_t)(t0 + i) * PJ + C_Z + h * 128 + 16 * et + 4 * lq); nw[et] = *(const GAS f32x4*)(a.in[I_GNW] + l * 128 + 16 * et + 4 * lq); }
            PIN_MEM();
#pragma unroll
            for (int jt = 0; jt < 4; ++jt) { v2u o = (v2u){0u, 0u};
                if (jt <= it) { f32x4 s = (f32x4){0.f, 0.f, 0.f, 0.f};
#pragma unroll
                    for (int ks = 0; ks < 2; ++ks) { const bf16x8 xf = *(const LAS bf16x8*)(KI + (16 * jt + l15) * QP + h * 64 + 32 * ks + 8 * lq), yf = *(const LAS bf16x8*)(QD + (16 * it + l15) * QP + h * 64 + 32 * ks + 8 * lq);
                        s = mfma32(xf, yf, s); }
                    const int j0 = 16 * jt + 4 * lq;
                    o.x = pk2(j0 <= i ? s[0] : 0.f, j0 + 1 <= i ? s[1] : 0.f); o.y = pk2(j0 + 2 <= i ? s[2] : 0.f, j0 + 3 <= i ? s[3] : 0.f); }
                *(LAS v2u*)(SSw + l15 * SPP + 16 * jt + 4 * lq) = o; }
            f32x4 oa[8];
#pragma unroll
            for (int et = 0; et < 8; ++et) oa[et] = (f32x4){0.f, 0.f, 0.f, 0.f};
#pragma unroll
            for (int ks = 0; ks < 2; ++ks) { if (32 * ks <= 16 * it + 15) { const bf16x8 yf = *(const LAS bf16x8*)(SSw + l15 * SPP + 32 * ks + 8 * lq);
#pragma unroll
                for (int et = 0; et < 8; ++et) { const bf16x8 xf = tr_frag(VV + (32 * ks + 8 * lq + (l15 >> 2)) * VPF + h * 128 + 16 * et + 4 * (l15 & 3), VPF); oa[et] = mfma32(xf, yf, oa[et]); } } }
#pragma unroll
            for (int ks = 0; ks < 2; ++ks) { const bf16x8 yf = *(const LAS bf16x8*)(QD + (16 * it + l15) * QP + h * 64 + 32 * ks + 8 * lq);
#pragma unroll
                for (int et = 0; et < 8; ++et) oa[et] = mfma32(pf[ks][et], yf, oa[et]); }
            float ss = 0.f;
#pragma unroll
            for (int et = 0; et < 8; ++et) ss += (oa[et][0] * oa[et][0] + oa[et][1] * oa[et][1]) + (oa[et][2] * oa[et][2] + oa[et][3] * oa[et][3]);
            ss += __shfl_xor(ss, 16); ss += __shfl_xor(ss, 32);
            const float rstd = frsq(ss * (1.0f / 128.0f) + EPS);
#pragma unroll
            for (int et = 0; et < 8; ++et) { GAS v2u* zp = (GAS v2u*)(PR + (size_t)(t0 + i) * PJ + C_Z + h * 128 + 16 * et + 4 * lq);
                v2u o; o.x = pk2(oa[et][0] * rstd * nw[et][0] * silu(bflo(zv[et].x)), oa[et][1] * rstd * nw[et][1] * silu(bfhi(zv[et].x)));
                o.y = pk2(oa[et][2] * rstd * nw[et][2] * silu(bflo(zv[et].y)), oa[et][3] * rstd * nw[et][3] * silu(bfhi(zv[et].y)));
                if (dry) asm volatile("" :: "v"(o.x), "v"(o.y)); else *zp = o; }
        }
    }
    __syncthreads();
}

constexpr int XSP = 520, BMP = 264, MP = 72;
constexpr int SSD_XS = 0, SSD_CM = 66560, SSD_BM = 100352, SSD_M = 100352, SSD_DT = 137216, SSD_AC = 139264, SSD_SQ = 141312;
__device__ __forceinline__ void ssd_chunk(const Args& a, int l, int c, bool fin, LAS unsigned char* lds, bool dry = false) {
    const int tid = opaque_tid(), lane = tid & 63, w = __builtin_amdgcn_readfirstlane(tid >> 6), l15 = lane & 15, lq = lane >> 4; const int t0 = c * 64;
    const bool hp = (c % CPB) != 0;
    LAS bf16* XS = (LAS bf16*)(lds + SSD_XS); LAS bf16* CM = (LAS bf16*)(lds + SSD_CM); LAS bf16* BM = (LAS bf16*)(lds + SSD_BM); LAS bf16* MM = (LAS bf16*)(lds + SSD_M);
    LAS float* dtl = (LAS float*)(lds + SSD_DT); LAS float* acl = (LAS float*)(lds + SSD_AC); LAS float* ssq = (LAS float*)(lds + SSD_SQ);
    bf16* PR = (bf16*)(a.ws + WS_PROJ); const float* EX = (const float*)(a.ws + WS_EX);
    bf16* STT = (bf16*)(a.ws + WS_SSD) + (size_t)c * 65536;
    { const int h = w; const float bias = a.in[I_DDTB][l * 8 + h], av = -expf(a.in[I_DALOG][l * 8 + h]);
      const float dt = softplus(EX[(size_t)(t0 + lane) * 32 + 16 + h] + bias); float cum = dt * av;
#pragma unroll
      for (int off = 1; off < 64; off <<= 1) { const float pv = __shfl_up(cum, off); if (lane >= off) cum += pv; }
      dtl[lane * 8 + h] = dt; acl[lane * 8 + h] = cum; }
    __syncthreads();
    { const int cg = tid & 127, seg = tid >> 7; int mycol, wch, pitch; LAS bf16* dst;
      if (cg < 64) { mycol = D_XS + 8 * cg; wch = 8 * cg; dst = XS + 8 * cg; pitch = XSP; }
      else if (cg < 96) { mycol = D_BM + 8 * (cg - 64); wch = 512 + 8 * (cg - 64); dst = BM + 8 * (cg - 64); pitch = BMP; }
      else { mycol = D_CM + 8 * (cg - 96); wch = 768 + 8 * (cg - 96); dst = CM + 8 * (cg - 96); pitch = BMP; }
      if (fin || cg < 96) {
          float wgt[4][8], cb[8];
          const float* cw = a.in[I_DCW] + (size_t)l * 4 * 1024 + wch;
#pragma unroll
          for (int v = 0; v < 4; ++v) { const f32x4 w0 = *(const GAS f32x4*)(cw + v * 1024), w1 = *(const GAS f32x4*)(cw + v * 1024 + 4);
              wgt[v][0] = w0[0]; wgt[v][1] = w0[1]; wgt[v][2] = w0[2]; wgt[v][3] = w0[3]; wgt[v][4] = w1[0]; wgt[v][5] = w1[1]; wgt[v][6] = w1[2]; wgt[v][7] = w1[3]; }
          { const f32x4 b0 = *(const GAS f32x4*)(a.in[I_DCB] + l * 1024 + wch), b1 = *(const GAS f32x4*)(a.in[I_DCB] + l * 1024 + wch + 4);
            cb[0] = b0[0]; cb[1] = b0[1]; cb[2] = b0[2]; cb[3] = b0[3]; cb[4] = b1[0]; cb[5] = b1[1]; cb[6] = b1[2]; cb[7] = b1[3]; }
          const int hh = cg >> 3; const float aL = acl[63 * 8 + (hh & 7)];
          v4u raws[19];
#pragma unroll
          for (int r = 0; r < 19; ++r) { const int t = 16 * seg - 3 + r; const int row = (t0 + t) < 0 ? 0 : (t0 + t); raws[r] = *(const GAS v4u*)(PR + (size_t)row * PJ + mycol); }
          PIN_MEM();
          float x3[8], x2[8], x1[8];
#pragma unroll
          for (int q = 0; q < 8; ++q) { x3[q] = 0.f; x2[q] = 0.f; x1[q] = 0.f; }
#pragma unroll
          for (int r = 0; r < 19; ++r) {
              const int t = 16 * seg - 3 + r; v4u raw = raws[r];
              if (!(t >= 0 || hp)) raw = (v4u){0u, 0u, 0u, 0u};
              float x0[8]; x0[0] = bflo(raw.x); x0[1] = bfhi(raw.x); x0[2] = bflo(raw.y); x0[3] = bfhi(raw.y); x0[4] = bflo(raw.z); x0[5] = bfhi(raw.z); x0[6] = bflo(raw.w); x0[7] = bfhi(raw.w);
              if (r >= 3) {
                  float sc = 1.0f; if (!fin && cg < 64) sc = fexp(aL - acl[t * 8 + hh]) * dtl[t * 8 + hh];
                  float o[8];
#pragma unroll
                  for (int q = 0; q < 8; ++q) o[q] = silu(cb[q] + wgt[0][q] * x3[q] + wgt[1][q] * x2[q] + wgt[2][q] * x1[q] + wgt[3][q] * x0[q]) * sc;
                  v4u pk; pk.x = pk2(o[0], o[1]); pk.y = pk2(o[2], o[3]); pk.z = pk2(o[4], o[5]); pk.w = pk2(o[6], o[7]);
                  *(LAS v4u*)(dst + t * pitch) = pk;
              }
#pragma unroll
              for (int q = 0; q < 8; ++q) { x3[q] = x2[q]; x2[q] = x1[q]; x1[q] = x0[q]; }
          }
      } }
    __syncthreads();
    if (!fin) {
        const int h = w, g = h >> 2;
#pragma unroll 1
        for (int sh = 0; sh < 2; ++sh) {
            f32x4 acc[4][4];
#pragma unroll
            for (int st = 0; st < 4; ++st)
#pragma unroll
                for (int pt = 0; pt < 4; ++pt) acc[st][pt] = (f32x4){0.f, 0.f, 0.f, 0.f};
#pragma unroll
            for (int ks = 0; ks < 2; ++ks) {
                bf16x8 xf[4], yf[4];
#pragma unroll
                for (int st = 0; st < 4; ++st) xf[st] = tr_frag(BM + (32 * ks + 8 * lq + (l15 >> 2)) * BMP + g * 128 + 64 * sh + 16 * st + 4 * (l15 & 3), BMP);
#pragma unroll
                for (int pt = 0; pt < 4; ++pt) yf[pt] = tr_frag(XS + (32 * ks + 8 * lq + (l15 >> 2)) * XSP + h * 64 + 16 * pt + 4 * (l15 & 3), XSP);
#pragma unroll
                for (int st = 0; st < 4; ++st)
#pragma unroll
                    for (int pt = 0; pt < 4; ++pt) acc[st][pt] = mfma32(xf[st], yf[pt], acc[st][pt]);
            }
#pragma unroll
            for (int st = 0; st < 4; ++st)
#pragma unroll
                for (int pt = 0; pt < 4; ++pt) { v2u o; o.x = pk2(acc[st][pt][0], acc[st][pt][1]); o.y = pk2(acc[st][pt][2], acc[st][pt][3]);
                    *(GAS v2u*)(STT + ((size_t)h * 64 + 16 * pt + l15) * 128 + 64 * sh + 16 * st + 4 * lq) = o; }
        }
        if (lane == 0) ((float*)(a.ws + WS_SDEC))[(size_t)c * 8 + h] = fexp(acl[63 * 8 + h]);
    } else {
        const int gC = w >> 2, itC = w & 3; f32x4 cbt[4];
#pragma unroll
        for (int jt = 0; jt < 4; ++jt) cbt[jt] = (f32x4){0.f, 0.f, 0.f, 0.f};
#pragma unroll
        for (int ks = 0; ks < 4; ++ks) {
            const bf16x8 yf = *(const LAS bf16x8*)(CM + (16 * itC + l15) * BMP + gC * 128 + 32 * ks + 8 * lq);
#pragma unroll
            for (int jt = 0; jt < 4; ++jt) { const bf16x8 xf = *(const LAS bf16x8*)(BM + (16 * jt + l15) * BMP + gC * 128 + 32 * ks + 8 * lq); cbt[jt] = mfma32(xf, yf, cbt[jt]); }
        }
        __syncthreads();
        f32x4 yv[2][4][2];
#pragma unroll 1
        for (int rd = 0; rd < 2; ++rd) {
            bf16x8 pfr[4][4]; v2u zvr[2][4];
            { const int ms_ = w >> 1, half_ = w & 1, g_ = ms_ >> 1, h_ = g_ * 4 + 2 * rd + (ms_ & 1);
#pragma unroll
              for (int ks = 0; ks < 4; ++ks)
#pragma unroll
                  for (int pt = 0; pt < 4; ++pt) pfr[ks][pt] = *(const GAS bf16x8*)(STT + ((size_t)h_ * 64 + 16 * pt + l15) * 128 + 32 * ks + 8 * lq);
#pragma unroll
              for (int i2 = 0; i2 < 2; ++i2)
#pragma unroll
                  for (int pt = 0; pt < 4; ++pt) zvr[i2][pt] = *(const GAS v2u*)(PR + (size_t)(t0 + 16 * (2 * half_ + i2) + l15) * PJ + D_Z + h_ * 64 + 16 * pt + 4 * lq);
              PIN_MEM(); }
            { const int i = 16 * itC + l15;
#pragma unroll
              for (int hh = 0; hh < 2; ++hh) { const int h = gC * 4 + 2 * rd + hh; const float ai = acl[i * 8 + h];
#pragma unroll
                  for (int jt = 0; jt < 4; ++jt) { float mv[4];
#pragma unroll
                      for (int r = 0; r < 4; ++r) { const int j = 16 * jt + 4 * lq + r; mv[r] = (j <= i) ? cbt[jt][r] * fexp(ai - acl[j * 8 + h]) * dtl[j * 8 + h] : 0.f; }
                      v2u o; o.x = pk2(mv[0], mv[1]); o.y = pk2(mv[2], mv[3]); *(LAS v2u*)(MM + ((gC * 2 + hh) * 64 + i) * MP + 16 * jt + 4 * lq) = o; } } }
            __syncthreads();
            { const int ms = w >> 1, half = w & 1, g = ms >> 1, h = g * 4 + 2 * rd + (ms & 1);
              f32x4 a1[4][2], a2[4][2];
#pragma unroll
              for (int pt = 0; pt < 4; ++pt)
#pragma unroll
                  for (int i2 = 0; i2 < 2; ++i2) { a1[pt][i2] = (f32x4){0.f, 0.f, 0.f, 0.f}; a2[pt][i2] = (f32x4){0.f, 0.f, 0.f, 0.f}; }
#pragma unroll
              for (int ks = 0; ks < 2; ++ks) { if (ks <= half) {
                  bf16x8 xf[4];
#pragma unroll
                  for (int pt = 0; pt < 4; ++pt) xf[pt] = tr_frag(XS + (32 * ks + 8 * lq + (l15 >> 2)) * XSP + h * 64 + 16 * pt + 4 * (l15 & 3), XSP);
#pragma unroll
                  for (int i2 = 0; i2 < 2; ++i2) { const bf16x8 yf = *(const LAS bf16x8*)(MM + (ms * 64 + 16 * (2 * half + i2) + l15) * MP + 32 * ks + 8 * lq);
#pragma unroll
                      for (int pt = 0; pt < 4; ++pt) a1[pt][i2] = mfma32(xf[pt], yf, a1[pt][i2]); } } }
#pragma unroll
              for (int ks = 0; ks < 4; ++ks) {
#pragma unroll
                  for (int i2 = 0; i2 < 2; ++i2) { const bf16x8 yf = *(const LAS bf16x8*)(CM + (16 * (2 * half + i2) + l15) * BMP + g * 128 + 32 * ks + 8 * lq);
#pragma unroll
                      for (int pt = 0; pt < 4; ++pt) a2[pt][i2] = mfma32(pfr[ks][pt], yf, a2[pt][i2]); } }
              const float Dh = a.in[I_DD][l * 8 + h];
#pragma unroll
              for (int i2 = 0; i2 < 2; ++i2) { const int i = 16 * (2 * half + i2) + l15; const float ea = fexp(acl[i * 8 + h]); float s2 = 0.f;
#pragma unroll
                  for (int pt = 0; pt < 4; ++pt) { const int ch = h * 64 + 16 * pt + 4 * lq;
                      const v2u xv = *(const LAS v2u*)(XS + i * XSP + ch); const v2u zv = zvr[i2][pt];
                      f32x4 y; y[0] = (a1[pt][i2][0] + ea * a2[pt][i2][0] + Dh * bflo(xv.x)) * silu(bflo(zv.x)); y[1] = (a1[pt][i2][1] + ea * a2[pt][i2][1] + Dh * bfhi(xv.x)) * silu(bfhi(zv.x));
                      y[2] = (a1[pt][i2][2] + ea * a2[pt][i2][2] + Dh * bflo(xv.y)) * silu(bflo(zv.y)); y[3] = (a1[pt][i2][3] + ea * a2[pt][i2][3] + Dh * bfhi(xv.y)) * silu(bfhi(zv.y));
                      if (rd == 0) yv[0][pt][i2] = y; else yv[1][pt][i2] = y;
                      s2 += (y[0] * y[0] + y[1] * y[1]) + (y[2] * y[2] + y[3] * y[3]); }
                  s2 += __shfl_xor(s2, 16); s2 += __shfl_xor(s2, 32);
                  if (lq == 0) ssq[i * 8 + h] = s2; } }
            __syncthreads();
        }
        { const int ms = w >> 1, half = w & 1, g = ms >> 1;
#pragma unroll
          for (int rd = 0; rd < 2; ++rd) { const int h = g * 4 + 2 * rd + (ms & 1);
#pragma unroll
              for (int i2 = 0; i2 < 2; ++i2) { const int i = 16 * (2 * half + i2) + l15; const LAS float* sq = ssq + i * 8;
                  const float rstd = frsq((((sq[0] + sq[1]) + (sq[2] + sq[3])) + ((sq[4] + sq[5]) + (sq[6] + sq[7]))) * (1.0f / 512.0f) + EPS);
#pragma unroll
                  for (int pt = 0; pt < 4; ++pt) { const int ch = h * 64 + 16 * pt + 4 * lq; const f32x4 nw = *(const GAS f32x4*)(a.in[I_DNW] + l * 512 + ch); const f32x4 y = yv[rd][pt][i2];
                      v2u o; o.x = pk2(y[0] * rstd * nw[0], y[1] * rstd * nw[1]); o.y = pk2(y[2] * rstd * nw[2], y[3] * rstd * nw[3]);
                      if (dry) asm volatile("" :: "v"(o.x), "v"(o.y)); else *(GAS v2u*)(PR + (size_t)(t0 + i) * PJ + D_Z + ch) = o; } } } }
    }
    __syncthreads();
}

__device__ __forceinline__ void scan_phase(const Args& a, int l, int vcu, int G, LAS unsigned char* lds) {
    const int tid = opaque_tid();
    LAS float* dl = (LAS float*)lds;
    for (int j = vcu; j < 202; j += G) {
        if (j < 192) {
            const bool isS = j < 128; const int jj = isS ? j : j - 128;
            const int b = isS ? (jj >> 6) : (jj >> 5), r0 = (isS ? (jj & 63) : (jj & 31)) * 1024, h = r0 >> 13, r = r0 + 2 * tid;
            if (isS) { if (tid < CPB) dl[tid] = ((const float*)(a.ws + WS_SDEC))[(size_t)(b * CPB + tid) * 8 + h]; }
            else { for (int i = tid; i < CPB * 64; i += NTHR) dl[i] = ((const float*)(a.ws + WS_GDEC))[(size_t)(b * CPB + (i >> 6)) * 256 + h * 64 + (i & 63)]; }
            const int cstride = isS ? 131072 : 65536;
            const __amdgpu_buffer_rsrc_t rs = __builtin_amdgcn_make_buffer_rsrc((void*)(a.ws + (isS ? WS_SSD : WS_GLA) + (size_t)b * CPB * cstride), (short)0, CPB * cstride, 0x00020000);
            __syncthreads();
            float s0 = 0.f, s1 = 0.f; const int d = r & 63;
#pragma unroll 1
            for (int n0 = 0; n0 < CPB; n0 += 64) { unsigned kv[64];
#pragma unroll
                for (int q = 0; q < 64; ++q) kv[q] = __builtin_amdgcn_raw_buffer_load_b32(rs, r * 2, (n0 + q) * cstride, 0);
                asm volatile("s_waitcnt vmcnt(0)" ::: "memory");
#pragma unroll
                for (int q = 0; q < 64; ++q) { float d0, d1; if (isS) { d0 = dl[n0 + q]; d1 = d0; } else { const f32x2 dd = *(const LAS f32x2*)(dl + (n0 + q) * 64 + d); d0 = dd.x; d1 = dd.y; }
                    __builtin_amdgcn_raw_buffer_store_b32(pk2(s0, s1), rs, r * 2, (n0 + q) * cstride, 0); s0 = d0 * s0 + bflo(kv[q]); s1 = d1 * s1 + bfhi(kv[q]);
                    if ((q & 15) == 15) PIN_MEM(); } }
            __syncthreads();
        } else if (j < 200) {
            const int e2 = (j - 192) * NTHR + tid, b = e2 >> 11, gn = e2 & 2047;
            const float* A64 = (const float*)(a.ws + WS_S5T + (size_t)l * S5T_LAYER + S5T_A64); const float ar = A64[gn * 2], ai = A64[gn * 2 + 1];
            f32x2* p = (f32x2*)(a.ws + WS_S5ST) + (size_t)b * CPB * 2048 + gn; float sr = 0.f, si = 0.f;
#pragma unroll 1
            for (int n0 = 0; n0 < CPB; n0 += 32) { f32x2 ev[32];
#pragma unroll
                for (int q = 0; q < 32; ++q) ev[q] = p[(size_t)(n0 + q) * 2048];
                asm volatile("s_waitcnt vmcnt(0)" ::: "memory");
#pragma unroll
                for (int q = 0; q < 32; ++q) { const f32x2 o = {sr, si}; p[(size_t)(n0 + q) * 2048] = o; const float nr = ar * sr - ai * si + ev[q].x, ni = ar * si + ai * sr + ev[q].y; sr = nr; si = ni; } }
        } else {
            const int e2 = (j - 200) * NTHR + tid, b = e2 >> 9, ch = e2 & 511;
            const f32x2* E = (const f32x2*)(a.ws + WS_LRUE) + (size_t)b * CPB * 512 + ch; float* H = (float*)(a.ws + WS_LRUH) + (size_t)b * CPB * 512 + ch; float hs = 0.f;
#pragma unroll 1
            for (int n0 = 0; n0 < CPB; n0 += 32) { f32x2 ev[32];
#pragma unroll
                for (int q = 0; q < 32; ++q) ev[q] = E[(size_t)(n0 + q) * 512];
#pragma unroll
                for (int q = 0; q < 32; ++q) { H[(size_t)(n0 + q) * 512] = hs; hs = ev[q].x * hs + ev[q].y; } }
        }
    }
}

__device__ __forceinline__ void final_norm(const Args& a, int vcu, int G) {
    const int tid = opaque_tid(), lane = tid & 63, wave = tid >> 6; const int gw = vcu * NWAVES + wave, NGW = G * NWAVES;
    const float* rowss = (const float*)(a.ws + WS_PART) + (size_t)DEPTH * T * 16;
    for (int m = gw; m < T; m += NGW) {
        float rsum = 0.f;
#pragma unroll
        for (int q = 0; q < 16; ++q) rsum += rowss[(size_t)m * 16 + q];
        const float rstd = 1.0f / sqrtf(rsum * (1.0f / 1024.0f) + EPS);
        const GAS v2u* xr = (const GAS v2u*)((const bf16*)(a.ws + WS_XBF) + (size_t)m * DM) + lane; GAS f32x4* orow = (GAS f32x4*)(a.out + (size_t)m * DM) + lane; const GAS f32x4* wr = (const GAS f32x4*)(a.in[I_NFW]) + lane;
        v2u xv[4];
#pragma unroll
        for (int j = 0; j < 4; ++j) xv[j] = xr[64 * j];
#pragma unroll
        for (int j = 0; j < 4; ++j) { const f32x4 w = wr[64 * j]; f32x4 v = (f32x4){bflo(xv[j].x), bfhi(xv[j].x), bflo(xv[j].y), bfhi(xv[j].y)}; v = v * rstd * w; orow[64 * j] = v; }
    }
}

#define XB_TMO      128
#define XB_XCNT(j)  (256  + 64 * (j))
#define XB_XSUB(j)  (1280 + 64 * (j))
#define XB_XGEN(j)  (2304 + 64 * (j))
#define XB_TOP      3328
#define XB_TOPGEN   3392
#define XCD_BAR_WORDS 3456
#define XB_SPIN_CAP (1u << 22)
__device__ __forceinline__ unsigned xb_ld(unsigned* p)              { return __hip_atomic_load(p, __ATOMIC_RELAXED, __HIP_MEMORY_SCOPE_AGENT); }
__device__ __forceinline__ unsigned xb_add(unsigned* p, unsigned v) { return __hip_atomic_fetch_add(p, v, __ATOMIC_RELAXED, __HIP_MEMORY_SCOPE_AGENT); }
__device__ __forceinline__ unsigned xb_xcc_id() { return (unsigned)__builtin_amdgcn_s_getreg((3 << 11) | 20) & 0xFu; }
#define XB_SPIN(cond, bar) do { unsigned _sp = 0; while (cond) { __builtin_amdgcn_s_sleep(1); \
    if ((++_sp & 255u) == 0u) { if (xb_ld(&(bar)[XB_TMO])) break; if (_sp > XB_SPIN_CAP) { atomicAdd(&(bar)[XB_TMO], 1u); break; } } } } while (0)
struct XcdBarrier { unsigned* bar; unsigned x; volatile LAS unsigned* st; };
__device__ __forceinline__ XcdBarrier xcd_barrier_post(unsigned* bar, volatile LAS unsigned* st) {
    XcdBarrier b; b.bar = bar; b.x = xb_xcc_id(); b.st = st;
    if (threadIdx.x == 0) (void)xb_add(&bar[XB_XCNT(b.x)], 1u);
    return b;
}
__device__ __forceinline__ void xcd_barrier_complete(unsigned* bar, unsigned x, unsigned& nloc, unsigned& nx) {
    const unsigned G = gridDim.x * gridDim.y * gridDim.z;
    unsigned sum, cnt, mine, sp = 0u;
    for (;;) {
        sum = 0u; cnt = 0u; mine = 0u;
#pragma unroll
        for (unsigned j = 0; j < 16; ++j) { const unsigned c = xb_ld(&bar[XB_XCNT(j)]); sum += c; cnt += (c > 0u) ? 1u : 0u; mine = (j == x) ? c : mine; }
        if (sum == G) break;
        __builtin_amdgcn_s_sleep(1);
        if ((++sp & 255u) == 0u) { if (xb_ld(&bar[XB_TMO])) break; if (sp > XB_SPIN_CAP) { atomicAdd(&bar[XB_TMO], 1u); break; } }
    }
    nloc = mine > 0u ? mine : 1u; nx = cnt > 0u ? cnt : 1u;
}
__device__ __forceinline__ void xcd_barrier(const XcdBarrier& b) {
    asm volatile("s_waitcnt vmcnt(0)" ::: "memory");
    __syncthreads();
    if (threadIdx.x == 0) {
        unsigned* bar = b.bar;
        __builtin_amdgcn_s_waitcnt(0);
        unsigned nloc = b.st[0], nx = b.st[1];
        if (nloc == 0u) { xcd_barrier_complete(bar, b.x, nloc, nx); b.st[0] = nloc; b.st[1] = nx; }
        const unsigned old = xb_add(&bar[XB_XSUB(b.x)], 1u);
        const unsigned gen = old / nloc;
        if (old + 1u == (gen + 1u) * nloc) {
            __builtin_amdgcn_fence(__ATOMIC_RELEASE, "agent");
            asm volatile("s_waitcnt vmcnt(0)" ::: "memory");
            const unsigned og = xb_add(&bar[XB_TOP], 1u);
            const unsigned tg = og / nx;
            if (og + 1u == (tg + 1u) * nx) xb_add(&bar[XB_TOPGEN], 1u);
            else XB_SPIN(xb_ld(&bar[XB_TOPGEN]) == tg, bar);
            __builtin_amdgcn_fence(__ATOMIC_ACQUIRE, "agent");
            xb_add(&bar[XB_XGEN(b.x)], 1u);
            asm volatile("s_waitcnt vmcnt(0)" ::: "memory");
        } else {
            XB_SPIN(xb_ld(&bar[XB_XGEN(b.x)]) == gen, bar);
            __builtin_amdgcn_fence(__ATOMIC_ACQUIRE, "agent");
            asm volatile("s_waitcnt vmcnt(0)" ::: "memory");
        }
    }
    __syncthreads();
}

constexpr int N_PHASES = 2 + 5 * DEPTH;
__global__ void __launch_bounds__(NTHR, 2) mega_fwd(Args args) {
    extern __shared__ __attribute__((aligned(16))) unsigned char lds_raw[];
    LAS unsigned char* lds = (LAS unsigned char*)lds_raw;
    const int G = gridDim.x, bx = blockIdx.x; const int vcu = (G % 8 == 0) ? (bx % 8) * (G / 8) + bx / 8 : bx;
    const int lo = args.ph_lo, hi = args.ph_hi;
    float* rowss = (float*)(args.ws + WS_PART);
    volatile LAS unsigned* bst = (volatile LAS unsigned*)(lds + LDS_BYTES - 64);
    if (threadIdx.x < 2) bst[threadIdx.x] = 0u;
    __syncthreads();
    XcdBarrier xbar = xcd_barrier_post((unsigned*)(args.ws + WS_CTL), bst);
    constexpr int N_EXTRA = PROBE_DUP == 0 ? 0 : (PROBE_DUP == 3 ? 4 : 1);
    for (int sq = lo; sq < hi + N_EXTRA; ++sq) {
        int ph = sq;
        if (PROBE_DUP == 1) ph = sq <= 1 ? sq : sq - 1;
        if (PROBE_DUP == 2) ph = sq <= 2 ? sq : sq - 1;
        if (PROBE_DUP == 3) ph = sq <= 4 ? sq : sq - 4;
        if (PROBE_DUP == 4) ph = sq <= 5 ? sq : sq - 1;
        if (PROBE_DUP == 5) ph = sq <= 0 ? sq : sq - 1;
        if (PROBE_DUP == 6) ph = sq <= N_PHASES - 1 ? sq : sq - 1;
        if (ph == 0) { if (DBG_MASK & 1) p0_prologue(args, lds, vcu, G); }
        else if (ph == N_PHASES - 1) { if (DBG_MASK & 256) final_norm(args, vcu, G); }
        else {
            const int l = (ph - 1) / 5, sub = (ph - 1) % 5;
            if (sub == 0) { if (DBG_MASK & 2) {
                pg8::Gemm g{(const bf16*)args.out, (const bf16*)(args.ws + WS_WIN) + (size_t)l * NPAD * DM, T, PJ, DM, DM, 512};
                pg8::StaticOrder S; S.init(T, PJ, G, bx);
                pg8::EpiProj E{(bf16*)(args.ws + WS_PROJ), (float*)(args.ws + WS_EX), rowss + (size_t)l * T * 16, PJ};
                pg8::gemm_phase<pg8::EpiProj, pg8::StaticOrder, true, true>(lds, g, S, E);
                for (int c = vcu; c < NCHUNK; c += G) ex_chunk(args, l, c); }
            } else if (sub == 1 || sub == 3) {
                const bool fin = (sub == 3);
                for (int c = vcu; c < NCHUNK; c += G) {
                    if (PROBE_MIX == 1 && !fin) lru_chunk(args, l, c, false, lds); if (PROBE_MIX == 9 && !fin) lru_chunk(args, l, c, false, lds, false, true); if (PROBE_MIX == 5 && fin) lru_chunk(args, l, c, true, lds, true);
                    if (fin) lru_out(args, l, c); else lru_chunk(args, l, c, false, lds);
                    if (PROBE_MIX == 2 && !fin) s5_chunk(args, l, c, false, lds); if (PROBE_MIX == 6 && fin) s5_chunk(args, l, c, true, lds, true);
                    s5_chunk(args, l, c, fin, lds);
                    if (PROBE_MIX == 3 && !fin) gla_chunk(args, l, c, false, lds); if (PROBE_MIX == 7 && fin) gla_chunk(args, l, c, true, lds, true);
                    gla_chunk(args, l, c, fin, lds);
                    if (PROBE_MIX == 4 && !fin) ssd_chunk(args, l, c, false, lds); if (PROBE_MIX == 8 && fin) ssd_chunk(args, l, c, true, lds, true);
                    ssd_chunk(args, l, c, fin, lds); }
            } else if (sub == 2) { if (DBG_MASK & 64) scan_phase(args, l, vcu, G, lds); }
            else if (DBG_MASK & 128) {
                pg8::Gemm g{(const bf16*)(args.ws + WS_PROJ), (const bf16*)(args.ws + WS_WOUT) + (size_t)l * DM * 2048, T, DM, 2048, PJ, 1280};
                pg8::StaticOrder S; S.init(T, DM, G, bx);
                pg8::EpiOut E{l == 0 ? args.in[I_X] : nullptr, (const bf16*)args.out, l == DEPTH - 1 ? (bf16*)(args.ws + WS_XBF) : (bf16*)args.out, rowss + (size_t)(l + 1) * T * 16};
                pg8::gemm_phase<pg8::EpiOut, pg8::StaticOrder, true, true>(lds, g, S, E);
            }
        }
        if (sq + 1 < hi + N_EXTRA) { xcd_barrier(xbar); }
    }
}

extern "C" void kernel_launch(void* const* d_in, const int* in_sizes, int n_in, void* d_out, int out_size, void* d_ws, size_t ws_size, hipStream_t stream) {
    static int grid = 0;
    if (grid == 0) {
        if (n_in != 31 || out_size != T * DM || ws_size < WS_END) { fprintf(stderr, "kernel_launch: unexpected shapes (n_in %d out %d ws %zu need %zu)\n", n_in, out_size, ws_size, (size_t)WS_END); grid = -1; return; }
        int dev = 0, cus = 0, per_cu = 0;
        if (hipGetDevice(&dev) != hipSuccess || hipDeviceGetAttribute(&cus, hipDeviceAttributeMultiprocessorCount, dev) != hipSuccess) { grid = -1; return; }
        if (hipFuncSetAttribute((const void*)mega_fwd, hipFuncAttributeMaxDynamicSharedMemorySize, LDS_BYTES) != hipSuccess) { fprintf(stderr, "kernel_launch: hipFuncSetAttribute failed\n"); grid = -1; return; }
        if (hipOccupancyMaxActiveBlocksPerMultiprocessor(&per_cu, (const void*)mega_fwd, NTHR, LDS_BYTES) != hipSuccess || per_cu < 1) { fprintf(stderr, "kernel_launch: occupancy query says %d blocks/CU\n", per_cu); (void)hipGetLastError(); per_cu = 1; }
        grid = cus;
        fprintf(stderr, "kernel_launch: grid %d (per_cu %d)\n", grid, per_cu);
    }
    if (grid < 0) return;
    (void)hipMemsetAsync((char*)d_ws + WS_CTL, 0, CTL_ZERO_BYTES, stream);
    Args a{};
    for (int i = 0; i < 31; ++i) a.in[i] = (const float*)d_in[i];
    a.out = (float*)d_out; a.ws = (unsigned char*)d_ws;
#if MK_PER_PHASE
    for (int ph = 0; ph < N_PHASES; ++ph) { a.ph_lo = ph; a.ph_hi = ph + 1; hipLaunchKernelGGL(mega_fwd, dim3(grid), dim3(NTHR), LDS_BYTES, stream, a); }
#else
    a.ph_lo = 0; a.ph_hi = N_PHASES;
    void* kargs[] = {&a};
    hipError_t e = hipLaunchCooperativeKernel((const void*)mega_fwd, dim3(grid), dim3(NTHR), kargs, LDS_BYTES, stream);
    if (e != hipSuccess) fprintf(stderr, "kernel_launch: cooperative launch failed: %s\n", hipGetErrorString(e));
#endif
}
```

```cpp
#include <hip/hip_runtime.h>
#include <hip/hip_cooperative_groups.h>
#include <cstdio>
#include <cstdint>
namespace cg = cooperative_groups;

#ifndef DBG_MASK
#define DBG_MASK 0xFFF
#endif
#ifndef PROBE_DUP
#define PROBE_DUP 0
#endif
#ifndef PROBE_MIX
#define PROBE_MIX 0
#endif
#ifndef MK_PER_PHASE
#define MK_PER_PHASE 0
#endif

namespace pg8 {
#define PG8_LAS __attribute__((address_space(3)))
typedef unsigned short bf16_t;
typedef short bf16x8 __attribute__((ext_vector_type(8)));
typedef float f32x4 __attribute__((ext_vector_type(4)));
typedef unsigned u32x4 __attribute__((ext_vector_type(4)));
typedef unsigned u32x2 __attribute__((ext_vector_type(2)));
constexpr int BM = 256, BK = 64, HALF = 128, HTB = HALF * BK * 2, STAGE_BYTES = 8 * HTB, NXCD = 8, WGM = 8;

__host__ __device__ __forceinline__ int lds_byte(int r, int c) { const int st = (r >> 4) * 2 + (c >> 5), rr = r & 15, cc = c & 31, ob = rr * 64 + cc * 2; return st * 1024 + (ob ^ (((ob >> 9) & 1) << 5)); }
__host__ __device__ __forceinline__ void stage_rc(int b, int& R, int& C) { const int st = b / 1024, sb = b % 1024, swz = sb ^ (((sb >> 9) & 1) << 5); R = (st >> 1) * 16 + swz / 64; C = (st & 1) * 32 + (swz % 64) / 2; }
__host__ __device__ __forceinline__ int perm32(int rho) { const int n = rho >> 4, i = rho & 15; return 8 * (i >> 2) + 4 * n + (i & 3); }

struct Unit { int pm, pn; };
struct Gemm { const bf16_t* A; const bf16_t* Bt; int M, N, K, lda, segcols; };

struct StaticOrder {
    int nM, nN, nwg, G, c;
    __host__ __device__ void init(int M, int N, int G_, int c_) { nM = M / BM; nN = N / BM; nwg = nM * nN; G = G_; c = c_; }
    __host__ __device__ bool next(int i, Unit& u) const {
        const long L = (long)i * G + c; if (L >= nwg) return false;
        int wgid = (int)L; { const int q = nwg / NXCD, r = nwg % NXCD, xcd = wgid % NXCD, off = wgid / NXCD; wgid = (xcd < r ? xcd * (q + 1) : r * (q + 1) + (xcd - r) * q) + off; }
        const int nig = WGM * nN, gid = wgid / nig, fm = gid * WGM, gsz = (nM - fm) < WGM ? (nM - fm) : WGM;
        u.pm = fm + ((wgid % nig) % gsz); u.pn = (wgid % nig) / gsz; return true;
    }
};

__device__ __forceinline__ unsigned cvt_pk_bf16(float lo, float hi) { unsigned r; asm volatile("v_cvt_pk_bf16_f32 %0, %1, %2" : "=v"(r) : "v"(lo), "v"(hi)); return r; }

struct EpiProj {
    static constexpr bool PERM = true, PRELOAD = false;
    bf16_t* P; float* EX; const float* rowss; int pj;
    __device__ __forceinline__ void operator()(const f32x4 (&acc)[2][2][4][2], const Unit& u, int wr, int wc, int fr, int fq) const {
        const int row0 = u.pm * BM + wr * 64 + fr;
#pragma unroll
        for (int ai = 0; ai < 2; ++ai)
#pragma unroll
            for (int m = 0; m < 4; ++m) {
                const int row = row0 + ai * HALF + m * 16;
                const f32x4* pp = (const f32x4*)(rowss + (size_t)row * 16); const f32x4 p0 = pp[0], p1 = pp[1], p2 = pp[2], p3 = pp[3];
                const float rsum = (((p0[0] + p0[1]) + (p0[2] + p0[3])) + ((p1[0] + p1[1]) + (p1[2] + p1[3]))) + (((p2[0] + p2[1]) + (p2[2] + p2[3])) + ((p3[0] + p3[1]) + (p3[2] + p3[3])));
                const float rstd = 1.0f / sqrtf(rsum * (1.0f / 1024.0f) + 1e-6f);
                if (u.pn < 20) {
                    bf16_t* rowp = P + (size_t)row * pj + u.pn * BM + wc * 32 + 8 * fq;
#pragma unroll
                    for (int bj = 0; bj < 2; ++bj) { const f32x4 v0 = acc[ai][bj][m][0] * rstd, v1 = acc[ai][bj][m][1] * rstd;
                        u32x4 w; w.x = cvt_pk_bf16(v0[0], v0[1]); w.y = cvt_pk_bf16(v0[2], v0[3]); w.z = cvt_pk_bf16(v1[0], v1[1]); w.w = cvt_pk_bf16(v1[2], v1[3]);
                        *(u32x4*)(rowp + bj * HALF) = w; }
                } else if (wc == 0) {
                    float* ep = EX + (size_t)row * 32 + 8 * fq;
                    *(f32x4*)(ep) = acc[ai][0][m][0] * rstd; *(f32x4*)(ep + 4) = acc[ai][0][m][1] * rstd;
                }
            }
    }
};
struct EpiOut {
    static constexpr bool PERM = false, PRELOAD = true;
    const float* Xf; const bf16_t* XBin; bf16_t* XBout; float* rowss_next;
    __device__ __forceinline__ void preload(f32x4 (&acc)[2][2][4][2], u32x2 (&xr)[2][2][4][2], const Unit& u, int wr, int wc, int fr, int fq) const {
        const int row0 = u.pm * BM + wr * 64 + fr, col0 = u.pn * BM + wc * 32 + 4 * fq;
#pragma unroll
        for (int ai = 0; ai < 2; ++ai)
#pragma unroll
            for (int bj = 0; bj < 2; ++bj)
#pragma unroll
                for (int m = 0; m < 4; ++m)
#pragma unroll
                    for (int n = 0; n < 2; ++n) { const size_t off = (size_t)(row0 + ai * HALF + m * 16) * 1024 + col0 + bj * HALF + n * 16;
                        xr[ai][bj][m][n] = *(const u32x2*)(XBin + off); }
    }
    __device__ __forceinline__ void reinit(f32x4 (&acc)[2][2][4][2], const Unit& u, int wr, int wc, int fr, int fq) const {
        const int row0 = u.pm * BM + wr * 64 + fr, col0 = u.pn * BM + wc * 32 + 4 * fq;
#pragma unroll
        for (int ai = 0; ai < 2; ++ai)
#pragma unroll
            for (int bj = 0; bj < 2; ++bj)
#pragma unroll
                for (int m = 0; m < 4; ++m)
#pragma unroll
                    for (int n = 0; n < 2; ++n) { const u32x2 w = *(const u32x2*)(XBin + (size_t)(row0 + ai * HALF + m * 16) * 1024 + col0 + bj * HALF + n * 16);
                        acc[ai][bj][m][n] = (f32x4){__builtin_bit_cast(float, w.x << 16), __builtin_bit_cast(float, w.x & 0xffff0000u), __builtin_bit_cast(float, w.y << 16), __builtin_bit_cast(float, w.y & 0xffff0000u)}; }
    }
    __device__ __forceinline__ void expand(f32x4 (&acc)[2][2][4][2], const u32x2 (&xr)[2][2][4][2]) const {
#pragma unroll
        for (int ai = 0; ai < 2; ++ai)
#pragma unroll
            for (int bj = 0; bj < 2; ++bj)
#pragma unroll
                for (int m = 0; m < 4; ++m)
#pragma unroll
                    for (int n = 0; n < 2; ++n) { const u32x2 w = xr[ai][bj][m][n];
                        acc[ai][bj][m][n] = (f32x4){__builtin_bit_cast(float, w.x << 16), __builtin_bit_cast(float, w.x & 0xffff0000u), __builtin_bit_cast(float, w.y << 16), __builtin_bit_cast(float, w.y & 0xffff0000u)}; }
    }
    __device__ __forceinline__ void operator()(const f32x4 (&acc)[2][2][4][2], const Unit& u, int wr, int wc, int fr, int fq) const {
        const int row0 = u.pm * BM + wr * 64 + fr, col0 = u.pn * BM + wc * 32 + 4 * fq;
#pragma unroll
        for (int ai = 0; ai < 2; ++ai)
#pragma unroll
            for (int mm = 0; mm < 4; ++mm) {
                const int row = row0 + ai * HALF + mm * 16; float ss = 0.f;
#pragma unroll
                for (int bj = 0; bj < 2; ++bj)
#pragma unroll
                    for (int n = 0; n < 2; ++n) { const size_t off = (size_t)row * 1024 + col0 + bj * HALF + n * 16;
                        const f32x4 xn = acc[ai][bj][mm][n];
                        u32x2 w; w.x = cvt_pk_bf16(xn[0], xn[1]); w.y = cvt_pk_bf16(xn[2], xn[3]); *(u32x2*)(XBout + off) = w;
                        ss += (xn[0] * xn[0] + xn[1] * xn[1]) + (xn[2] * xn[2] + xn[3] * xn[3]); }
                ss += __shfl_xor(ss, 16); ss += __shfl_xor(ss, 32);
                if (fq == 0) rowss_next[(size_t)row * 16 + u.pn * 4 + wc] = ss;
            }
    }
};

__device__ __forceinline__ int opaque_tid() { int t = threadIdx.x; asm volatile("" : "+v"(t)); return t; }
template <class Epi, class Sched, bool ALIGN_EPI = false, bool SP2 = false>
__device__ __forceinline__ void gemm_phase(PG8_LAS unsigned char* lds, const Gemm g, const Sched& S, const Epi& E) {
    const int tid = opaque_tid(), wid = __builtin_amdgcn_readfirstlane(tid >> 6), lane = tid & 63, wr = wid >> 2, wc = wid & 3, fr = lane & 15, fq = lane >> 4;
    const int K = g.K, nt = K / BK, lda = g.lda;
    unsigned voffA[2], voffB[2];
#pragma unroll
    for (int i = 0; i < 2; ++i) { int R, C; stage_rc(tid * 16 + i * 8192, R, C); const int Rb = Epi::PERM ? ((R & ~31) + perm32(R & 31)) : R;
        voffA[i] = (unsigned)(R * lda + C) * 2u; voffB[i] = (unsigned)(Rb * K + C) * 2u; }
    const size_t kstep = (size_t)(BK * 2);
    const size_t segB = (size_t)g.segcols * 2;
    const size_t hstepA = (size_t)HALF * lda * 2, hstepB = (size_t)HALF * K * 2;
    const size_t tstepA = 2 * hstepA, tstepB = 2 * hstepB;
    const unsigned ldsw = (unsigned)wid * 1024u;
    const int aoff = lds_byte(wr * 64 + fr, fq * 8), boff = lds_byte(wc * 32 + fr, fq * 8);
#define PG8_KA(t) ((size_t)((t) >> 3) * segB + (size_t)((t) & 7) * kstep)
#define PG8_SA(b, h) (((b) * 2 + (h)) * HTB)
#define PG8_SB(b, h) ((4 + (b) * 2 + (h)) * HTB)
#define PG8_STAGE(bufoff, gbase, voff) do { _Pragma("unroll") for (int _i = 0; _i < 2; ++_i) \
        __builtin_amdgcn_global_load_lds((const unsigned*)((const char*)(gbase) + (voff)[_i]), (PG8_LAS unsigned*)(lds + (bufoff) + ldsw + _i * 8192), 16, 0, 0); } while (0)
#define PG8_LDA(dst, b, h) do { _Pragma("unroll") for (int m = 0; m < 4; ++m) _Pragma("unroll") for (int k = 0; k < 2; ++k) dst[m][k] = *(const PG8_LAS bf16x8*)(lds + PG8_SA(b, h) + aoff + m * 2048 + k * 1024); } while (0)
#define PG8_LDB(dst, b, h) do { _Pragma("unroll") for (int n = 0; n < 2; ++n) _Pragma("unroll") for (int k = 0; k < 2; ++k) dst[n][k] = *(const PG8_LAS bf16x8*)(lds + PG8_SB(b, h) + boff + n * 2048 + k * 1024); } while (0)
#define PG8_MMA(ai, bj, At, Bt) do { __builtin_amdgcn_s_setprio(1); _Pragma("unroll") for (int m = 0; m < 4; ++m) _Pragma("unroll") for (int n = 0; n < 2; ++n) _Pragma("unroll") for (int k = 0; k < 2; ++k) \
        acc[ai][bj][m][n] = __builtin_amdgcn_mfma_f32_16x16x32_bf16(Bt[n][k], At[m][k], acc[ai][bj][m][n], 0, 0, 0); __builtin_amdgcn_s_setprio(0); } while (0)
#define PG8_WAIT_V(n) asm volatile("s_waitcnt vmcnt(" #n ")" ::: "memory")
#define PG8_WAIT_L(n) asm volatile("s_waitcnt lgkmcnt(" #n ")" ::: "memory")
#define PG8_BAR __builtin_amdgcn_s_barrier()
#define PG8_SCHED __builtin_amdgcn_sched_barrier(0)
    Unit cur, nxt; int ui = 0;
    if (!S.next(0, cur)) return;
    f32x4 acc[2][2][4][2];
#pragma unroll
    for (int a = 0; a < 2; ++a)
#pragma unroll
        for (int b = 0; b < 2; ++b)
#pragma unroll
            for (int m = 0; m < 4; ++m)
#pragma unroll
                for (int n = 0; n < 2; ++n) acc[a][b][m][n] = (f32x4){0.f, 0.f, 0.f, 0.f};
    bf16x8 At[4][2], B0[2][2], B1[2][2];
    const char* cA = (const char*)g.A + (size_t)cur.pm * tstepA; const char* cB = (const char*)g.Bt + (size_t)cur.pn * tstepB;
    if constexpr (SP2) {
        u32x2 xr[2][2][4][2];
        if constexpr (Epi::PRELOAD) E.preload(acc, xr, cur, wr, wc, fr, fq);
        PG8_STAGE(PG8_SB(0, 0), cB, voffB); PG8_STAGE(PG8_SB(0, 1), cB + hstepB, voffB); PG8_STAGE(PG8_SA(0, 0), cA, voffA); PG8_STAGE(PG8_SA(0, 1), cA + hstepA, voffA);
        if (wr == 1) PG8_BAR;
        PG8_WAIT_V(2); PG8_BAR;
        if constexpr (Epi::PRELOAD) E.expand(acc, xr);
        PG8_STAGE(PG8_SB(1, 0), cB + kstep, voffB); PG8_STAGE(PG8_SA(1, 0), cA + kstep, voffA); PG8_STAGE(PG8_SB(1, 1), cB + hstepB + kstep, voffB);
        PG8_WAIT_V(6); PG8_BAR;
    } else {
        PG8_STAGE(PG8_SB(0, 0), cB, voffB); PG8_STAGE(PG8_SA(0, 0), cA, voffA); PG8_STAGE(PG8_SB(0, 1), cB + hstepB, voffB); PG8_STAGE(PG8_SA(0, 1), cA + hstepA, voffA);
        if (wr == 1) PG8_BAR;
        PG8_WAIT_V(4); PG8_BAR;
        PG8_STAGE(PG8_SB(1, 0), cB + kstep, voffB); PG8_STAGE(PG8_SA(1, 0), cA + kstep, voffA); PG8_STAGE(PG8_SB(1, 1), cB + hstepB + kstep, voffB);
        PG8_WAIT_V(6); PG8_BAR;
    }
    for (;;) {
        const bool has_next = S.next(ui + 1, nxt);
        const char* nA = has_next ? (const char*)g.A + (size_t)nxt.pm * tstepA : cA; const char* nB = has_next ? (const char*)g.Bt + (size_t)nxt.pn * tstepB : cB;
        for (int t = 0; t < nt; t += 2) {
            const bool last = (t == nt - 2);
            const char* a1 = cA + PG8_KA(t + 1);
            const char* a2 = last ? nA : cA + PG8_KA(t + 2); const char* b2 = last ? nB : cB + (size_t)(t + 2) * kstep;
            const char* a3 = a2 + kstep; const char* b3 = b2 + kstep;
            if constexpr (SP2) {
            PG8_LDB(B0, 0, 0); PG8_LDB(B1, 0, 1); PG8_SCHED; PG8_LDA(At, 0, 0); PG8_STAGE(PG8_SA(1, 1), a1 + hstepA, voffA);
            PG8_WAIT_V(8); PG8_WAIT_L(0); PG8_BAR; PG8_MMA(0, 0, At, B0); PG8_MMA(0, 1, At, B1); PG8_BAR; PG8_SCHED;
            PG8_LDA(At, 0, 1); PG8_STAGE(PG8_SB(0, 0), b2, voffB); PG8_STAGE(PG8_SB(0, 1), b2 + hstepB, voffB); PG8_STAGE(PG8_SA(0, 0), a2, voffA);
            PG8_WAIT_V(8); PG8_WAIT_L(0); PG8_BAR; PG8_MMA(1, 0, At, B0); PG8_MMA(1, 1, At, B1); PG8_BAR; PG8_SCHED;
            PG8_LDB(B0, 1, 0); PG8_LDB(B1, 1, 1); PG8_SCHED; PG8_LDA(At, 1, 0); PG8_STAGE(PG8_SA(0, 1), a2 + hstepA, voffA);
            PG8_WAIT_V(8); PG8_WAIT_L(0); PG8_BAR; PG8_MMA(0, 0, At, B0); PG8_MMA(0, 1, At, B1); PG8_BAR; PG8_SCHED;
            PG8_LDA(At, 1, 1); PG8_STAGE(PG8_SB(1, 0), b3, voffB); PG8_STAGE(PG8_SB(1, 1), b3 + hstepB, voffB); PG8_STAGE(PG8_SA(1, 0), a3, voffA);
            PG8_WAIT_V(8); PG8_WAIT_L(0); PG8_BAR; PG8_MMA(1, 0, At, B0); PG8_MMA(1, 1, At, B1); PG8_BAR; PG8_SCHED;
            } else {
            PG8_LDB(B0, 0, 0); PG8_SCHED; PG8_LDA(At, 0, 0); PG8_STAGE(PG8_SA(1, 1), a1 + hstepA, voffA);
            PG8_WAIT_L(8); PG8_BAR; PG8_WAIT_L(0); PG8_MMA(0, 0, At, B0); PG8_BAR; PG8_SCHED;
            PG8_LDB(B1, 0, 1); PG8_STAGE(PG8_SB(0, 0), b2, voffB);
            PG8_BAR; PG8_WAIT_L(0); PG8_MMA(0, 1, At, B1); PG8_BAR;
            PG8_LDA(At, 0, 1); PG8_STAGE(PG8_SA(0, 0), a2, voffA);
            PG8_BAR; PG8_WAIT_L(0); PG8_MMA(1, 0, At, B0); PG8_BAR; PG8_SCHED;
            PG8_STAGE(PG8_SB(0, 1), b2 + hstepB, voffB);
            PG8_WAIT_V(6); PG8_BAR; PG8_MMA(1, 1, At, B1); PG8_BAR;
            PG8_LDB(B0, 1, 0); PG8_SCHED; PG8_LDA(At, 1, 0); PG8_STAGE(PG8_SA(0, 1), a2 + hstepA, voffA);
            PG8_WAIT_L(8); PG8_BAR; PG8_WAIT_L(0); PG8_MMA(0, 0, At, B0); PG8_BAR; PG8_SCHED;
            PG8_LDB(B1, 1, 1); PG8_STAGE(PG8_SB(1, 0), b3, voffB);
            PG8_BAR; PG8_WAIT_L(0); PG8_MMA(0, 1, At, B1); PG8_BAR;
            PG8_LDA(At, 1, 1); PG8_STAGE(PG8_SA(1, 0), a3, voffA);
            PG8_BAR; PG8_WAIT_L(0); PG8_MMA(1, 0, At, B0); PG8_BAR; PG8_SCHED;
            PG8_STAGE(PG8_SB(1, 1), b3 + hstepB, voffB);
            PG8_WAIT_V(6); PG8_BAR; PG8_MMA(1, 1, At, B1); PG8_BAR;
            }
        }
        if constexpr (ALIGN_EPI) { if (wr == 0) PG8_BAR; }
        E(acc, cur, wr, wc, fr, fq);
        if (!has_next) break;
        if constexpr (Epi::PRELOAD) E.reinit(acc, nxt, wr, wc, fr, fq);
        else {
#pragma unroll
        for (int a = 0; a < 2; ++a)
#pragma unroll
            for (int b = 0; b < 2; ++b)
#pragma unroll
                for (int m = 0; m < 4; ++m)
#pragma unroll
                    for (int n = 0; n < 2; ++n) acc[a][b][m][n] = (f32x4){0.f, 0.f, 0.f, 0.f};
        }
        cur = nxt; cA = nA; cB = nB; ++ui;
        if constexpr (ALIGN_EPI) { if (wr == 1) PG8_BAR; }
    }
    PG8_WAIT_V(0);
    if constexpr (!ALIGN_EPI) { if (wr == 0) PG8_BAR; }
    PG8_BAR;
#undef PG8_KA
#undef PG8_SA
#undef PG8_SB
#undef PG8_STAGE
#undef PG8_LDA
#undef PG8_LDB
#undef PG8_MMA
#undef PG8_WAIT_V
#undef PG8_WAIT_L
#undef PG8_BAR
#undef PG8_SCHED
}
}

constexpr int NWAVES = 8, NTHR = 512;
constexpr int DM = 1024, BATCH = 2, SEQ = 8192, DEPTH = 4, T = BATCH * SEQ;
constexpr int DIN = 5144, PJ = 5120, NPAD = 5152, NCHUNK = T / 64, CPB = SEQ / 64;
constexpr float EPS = 1e-6f;
constexpr int A_Z = 0, A_X = 512, C_Q = 1024, B_Z = 1280, B_U = 1792, C_K = 2304, C_Z = 2560, C_V = 3072, D_CM = 3584, D_Z = 3840, D_XS = 4352, D_BM = 4864;
constexpr int O_AX = 0, O_AZ = 512, O_BU = 1024, O_BZ = 1536, O_CQ = 2048, O_CK = 2304, O_CV = 2560, O_CZ = 3072, O_CG = 3584, O_DZ = 3600, O_DXBC = 4112, O_DDT = 5136;
__host__ __device__ __forceinline__ int orig_col(int j) {
    if (j < 512) return O_AZ + j;
    if (j < 1024) return O_AX + (j - 512);
    if (j < 1280) return O_CQ + (j - 1024);
    if (j < 1792) return O_BZ + (j - 1280);
    if (j < 2304) return O_BU + (j - 1792);
    if (j < 2560) return O_CK + (j - 2304);
    if (j < 3072) return O_CZ + (j - 2560);
    if (j < 3584) return O_CV + (j - 3072);
    if (j < 3840) return O_DXBC + 768 + (j - 3584);
    if (j < 4352) return O_DZ + (j - 3840);
    if (j < 4864) return O_DXBC + (j - 4352);
    if (j < 5120) return O_DXBC + 512 + (j - 4864);
    if (j < 5136) return O_CG + (j - 5120);
    if (j < 5144) return O_DDT + (j - 5136);
    return -1;
}
constexpr size_t MiB = 1u << 20;
constexpr size_t WS_CTL = 0, CTL_ZERO_BYTES = 1 * MiB;
constexpr size_t CTL_ROWSS = 512 * 1024;
constexpr size_t WS_WIN = 1 * MiB;
constexpr size_t WS_WOUT = 43 * MiB;
constexpr size_t WS_S5T = 59 * MiB;
constexpr size_t WS_PROJ = 75 * MiB;
constexpr size_t WS_EX = 235 * MiB;
constexpr size_t WS_GLA = 237 * MiB;
constexpr size_t WS_SSD = 253 * MiB;
constexpr size_t WS_XBF = WS_SSD;
constexpr size_t WS_S5ST = 285 * MiB;
constexpr size_t WS_LRUE = 289 * MiB;
constexpr size_t WS_LRUH = 290 * MiB;
constexpr size_t WS_GDEC = 291 * MiB;
constexpr size_t WS_SDEC = 292 * MiB;
constexpr size_t WS_PART = 293 * MiB;
constexpr size_t WS_GLUT = 298 * MiB;
constexpr size_t WS_LRW = 300 * MiB;
constexpr size_t WS_END = 301 * MiB;
constexpr size_t S5T_AB = 0;
constexpr size_t S5T_A64 = 16384;
constexpr size_t S5T_BC = 65536;
constexpr size_t S5T_CC = 196608;
constexpr size_t S5T_PW = 327680;
constexpr size_t S5T_KT = 1048576;
constexpr size_t S5T_LAYER = 4 * MiB;

constexpr int LDS_BYTES = 155648;

#define GAS __attribute__((address_space(1)))
#define LAS __attribute__((address_space(3)))
typedef unsigned short bf16;
typedef unsigned v4u __attribute__((ext_vector_type(4)));
typedef float f32x4 __attribute__((ext_vector_type(4)));

__device__ __forceinline__ unsigned f2bf(float f) { unsigned u = __builtin_bit_cast(unsigned, f); return (u + 0x7fffu + ((u >> 16) & 1u)) >> 16; }
__device__ __forceinline__ unsigned pk2(float lo, float hi) { return f2bf(lo) | (f2bf(hi) << 16); }
__device__ __forceinline__ float bf2f(unsigned h) { return __builtin_bit_cast(float, (h & 0xffffu) << 16); }
__device__ __forceinline__ float bflo(unsigned w) { return __builtin_bit_cast(float, w << 16); }
__device__ __forceinline__ float bfhi(unsigned w) { return __builtin_bit_cast(float, w & 0xffff0000u); }
__device__ __forceinline__ float fexp(float x) { return __builtin_amdgcn_exp2f(x * 1.4426950408889634f); }
__device__ __forceinline__ float frcp(float x) { return __builtin_amdgcn_rcpf(x); }
__device__ __forceinline__ float sigm(float x) { return frcp(1.0f + fexp(-x)); }
__device__ __forceinline__ float silu(float x) { return x * frcp(1.0f + fexp(-x)); }
__device__ __forceinline__ float softplus(float x) { return fmaxf(x, 0.f) + __builtin_amdgcn_logf(1.0f + fexp(-fabsf(x))) * 0.6931471805599453f; }
__device__ __forceinline__ float gelu_tanh(float x) { const float u = 0.7978845608028654f * (x + 0.044715f * x * x * x); return x * frcp(1.0f + fexp(-2.0f * u)); }
__device__ __forceinline__ float neg_expm1(float x) { const float s = -x * (1.0f + x * (0.5f + x * (0.16666667f + x * 0.041666668f))); const float d = 1.0f - fexp(x); return fabsf(x) < 0.03f ? s : d; }
__device__ __forceinline__ float fsqrt(float x) { return __builtin_amdgcn_sqrtf(x); }
__device__ __forceinline__ float frsq(float x) { return __builtin_amdgcn_rsqf(x); }
__device__ __forceinline__ float wave_sum(float v) {
#pragma unroll
    for (int o = 1; o < 64; o <<= 1) v += __shfl_xor(v, o);
    return v;
}

__device__ __forceinline__ int opaque_tid() { int t = threadIdx.x; asm volatile("" : "+v"(t)); return t; }
typedef short bf16x8 __attribute__((ext_vector_type(8)));
typedef short bf16x4 __attribute__((ext_vector_type(4)));
typedef float f32x2 __attribute__((ext_vector_type(2)));
typedef unsigned v2u __attribute__((ext_vector_type(2)));
__device__ __forceinline__ f32x4 mfma32(bf16x8 x, bf16x8 y, f32x4 c) { return __builtin_amdgcn_mfma_f32_16x16x32_bf16(x, y, c, 0, 0, 0); }
__device__ __forceinline__ f32x4 mfma16(bf16x4 x, bf16x4 y, f32x4 c) { return __builtin_amdgcn_mfma_f32_16x16x16bf16_1k(x, y, c, 0, 0, 0); }
typedef short v4i16_t __attribute__((ext_vector_type(4)));
__device__ __forceinline__ bf16x8 tr_frag(const LAS bf16* p, int pitch) {
    const v4i16_t x = __builtin_amdgcn_ds_read_tr16_b64_v4i16((LAS v4i16_t*)p), y = __builtin_amdgcn_ds_read_tr16_b64_v4i16((LAS v4i16_t*)(p + 4 * pitch));
    return (bf16x8){x[0], x[1], x[2], x[3], y[0], y[1], y[2], y[3]};
}
#define PIN_MEM() asm volatile("" ::: "memory")
struct Args { const float* in[31]; float* out; unsigned char* ws; int ph_lo, ph_hi; };
enum { I_X = 0, I_NORMW, I_WIN, I_LCW, I_LCB, I_LWR, I_LBR, I_LWI, I_LBI, I_LL, I_SLR, I_SLI, I_SLDT, I_SBR, I_SBI, I_SCR, I_SCI, I_SD, I_SGW, I_SGB,
       I_GWG, I_GBG, I_GNW, I_DCW, I_DCB, I_DDTB, I_DALOG, I_DD, I_DNW, I_WOUT, I_NFW };

template <bool MAPPED>
__device__ __forceinline__ void p0_transpose_item(const float* W, int K, int ldw, int nblk, const float* kscale, bf16* WT, LAS float* scr, int item, int lane) {
    const int kb = item / nblk, nb = item % nblk, k0 = 64 * kb, n0 = 32 * nb;
    const int myc = n0 + (lane & 31); const int oc = MAPPED ? orig_col(myc) : myc;
    const int c = lane & 7; float ksc[8];
    { float vv[32]; const int occ = oc >= 0 ? oc : 0;
#pragma unroll
      for (int i = 0; i < 32; ++i) { const int kk = 2 * i + (lane >> 5); vv[i] = W[(size_t)(k0 + kk) * ldw + occ]; }
#pragma unroll
      for (int q = 0; q < 8; ++q) ksc[q] = kscale ? kscale[k0 + 8 * c + q] : 1.0f;
      PIN_MEM();
#pragma unroll
      for (int i = 0; i < 32; ++i) { const int kk = 2 * i + (lane >> 5); scr[kk * 33 + (lane & 31)] = oc >= 0 ? vv[i] : 0.f; } }
    asm volatile("s_waitcnt lgkmcnt(0)" ::: "memory");
#pragma unroll
    for (int j = 0; j < 4; ++j) { const int n = (lane >> 3) + 8 * j; const LAS float* s = scr + (8 * c) * 33 + n;
        v4u o; o.x = pk2(s[0 * 33] * ksc[0], s[1 * 33] * ksc[1]); o.y = pk2(s[2 * 33] * ksc[2], s[3 * 33] * ksc[3]); o.z = pk2(s[4 * 33] * ksc[4], s[5 * 33] * ksc[5]); o.w = pk2(s[6 * 33] * ksc[6], s[7 * 33] * ksc[7]);
        *(GAS v4u*)(WT + (size_t)(n0 + n) * K + k0 + 8 * c) = o; }
    asm volatile("s_waitcnt lgkmcnt(0)" ::: "memory");
}

__device__ __forceinline__ void p0_s5_tables(const Args& a, LAS unsigned char* lds, int item) {
    const int tid = opaque_tid(); const int l = item >> 6, g = (item >> 1) & 31, dh = item & 1;
    LAS f32x2* P = (LAS f32x2*)lds;
    LAS f32x2* BL = P + 32 * 64;
    LAS f32x2* CL = BL + 64 * 16;
    unsigned char* tb = a.ws + WS_S5T + (size_t)l * S5T_LAYER;
    const float dt = expf(a.in[I_SLDT][l * 32 + g]);
    const float* LR = a.in[I_SLR] + l * 2048 + g * 64; const float* LI = a.in[I_SLI] + l * 2048 + g * 64;
    for (int idx = tid; idx < 2048; idx += NTHR) { const int dd = idx >> 6, n = idx & 63, d = dh * 32 + dd;
        const float m = expf(LR[n] * dt * (float)d), ang = LI[n] * dt * (float)d; const f32x2 v = {m * cosf(ang), m * sinf(ang)}; P[dd * 64 + n] = v;
        if (dh == 0 && d <= 16) ((f32x2*)(tb + S5T_PW))[(g * 64 + n) * 17 + d] = v;
        if (dh == 0 && d == 1) ((f32x2*)(tb + S5T_AB))[g * 64 + n] = v; }
    for (int idx = tid; idx < 1024; idx += NTHR) { const int n = idx >> 4, q = idx & 15; const float lr = LR[n], li = LI[n];
        const float mag = expf(lr * dt), abr = mag * cosf(li * dt), abi = mag * sinf(li * dt), den = lr * lr + li * li, nr = abr - 1.0f;
        const float cr = (nr * lr + abi * li) / den, ci = (abi * lr - nr * li) / den;
        const float br = a.in[I_SBR][((size_t)(l * 32 + g) * 64 + n) * 16 + q], bi = a.in[I_SBI][((size_t)(l * 32 + g) * 64 + n) * 16 + q];
        const f32x2 v = {cr * br - ci * bi, cr * bi + ci * br}; BL[n * 16 + q] = v;
        if (dh == 0) { bf16* BC = (bf16*)(tb + S5T_BC); BC[(g * 128 + n) * 16 + q] = (bf16)f2bf(v.x); BC[(g * 128 + 64 + n) * 16 + q] = (bf16)f2bf(v.y); } }
    for (int idx = tid; idx < 1024; idx += NTHR) { const int p = idx >> 6, n = idx & 63;
        const f32x2 v = {a.in[I_SCR][((size_t)(l * 32 + g) * 16 + p) * 64 + n], a.in[I_SCI][((size_t)(l * 32 + g) * 16 + p) * 64 + n]}; CL[p * 64 + n] = v;
        if (dh == 0) { bf16* CC = (bf16*)(tb + S5T_CC); CC[(g * 16 + p) * 128 + 2 * n] = (bf16)f2bf(v.x); CC[(g * 16 + p) * 128 + 2 * n + 1] = (bf16)f2bf(-v.y); } }
    if (dh == 0 && tid < 64) { const float m64 = expf(64.0f * LR[tid] * dt), ang = 64.0f * LI[tid] * dt; const f32x2 v = {m64 * cosf(ang), m64 * sinf(ang)}; ((f32x2*)(tb + S5T_A64))[g * 64 + tid] = v; }
    __syncthreads();
    { const int pq = tid & 255, p = pq >> 4, q = pq & 15, dq = tid >> 8; float s[16];
#pragma unroll
      for (int i = 0; i < 16; ++i) s[i] = 0.f;
#pragma unroll 1
      for (int nh = 0; nh < 4; ++nh) { float cbr[16], cbi[16];
#pragma unroll
          for (int n = 0; n < 16; ++n) { const f32x2 cv = CL[p * 64 + nh * 16 + n], bv = BL[(nh * 16 + n) * 16 + q]; cbr[n] = cv.x * bv.x - cv.y * bv.y; cbi[n] = cv.x * bv.y + cv.y * bv.x; }
#pragma unroll
          for (int i = 0; i < 16; ++i) { const LAS f32x2* pp = P + (dq * 16 + i) * 64 + nh * 16; float t = 0.f;
#pragma unroll
              for (int n = 0; n < 16; ++n) { const f32x2 pw = pp[n]; t += cbr[n] * pw.x - cbi[n] * pw.y; }
              s[i] += t; } }
      bf16* KT = (bf16*)(tb + S5T_KT);
#pragma unroll
      for (int i = 0; i < 16; ++i) KT[((size_t)(g * 64 + dh * 32 + dq * 16 + i) * 16 + p) * 16 + q] = (bf16)f2bf(s[i]); }
    __syncthreads();
}

__device__ __forceinline__ void p0_prologue(const Args& a, LAS unsigned char* lds, int vcu, int G) {
    const int tid = opaque_tid(), lane = tid & 63, wave = __builtin_amdgcn_readfirstlane(tid >> 6);
    for (int item = vcu; item < DEPTH * 64; item += G) p0_s5_tables(a, lds, item);
    for (int idx = vcu * NTHR + tid; idx < DEPTH * 2 * 8 * 64 * 64; idx += G * NTHR) { const int i = idx & 63, j = (idx >> 6) & 63, h = (idx >> 12) & 7, gate = (idx >> 15) & 1, l = idx >> 16;
        ((bf16*)(a.ws + WS_LRW))[idx] = (bf16)f2bf(a.in[gate ? I_LWI : I_LWR][((size_t)(l * 8 + h) * 64 + i) * 64 + j]); }
    LAS float* scr = (LAS float*)(lds + wave * 16384);
    const int gw = vcu * NWAVES + wave, NGW = G * NWAVES;
    for (int it = gw; it < DEPTH * 128; it += NGW) { const int l = it >> 7;
        p0_transpose_item<false>(a.in[I_SGW] + (size_t)l * 512 * 512, 512, 512, 16, nullptr, (bf16*)(a.ws + WS_GLUT) + (size_t)l * 512 * 512, scr, it & 127, lane); }
    constexpr int I_IN = (DM / 64) * (NPAD / 32), I_OUT = (2048 / 64) * (DM / 32);
    for (int it = gw; it < DEPTH * (I_IN + I_OUT); it += NGW) {
        const int l = it / (I_IN + I_OUT); int r = it % (I_IN + I_OUT);
        if (r < I_IN) p0_transpose_item<true>(a.in[I_WIN] + (size_t)l * DM * DIN, DM, DIN, NPAD / 32, a.in[I_NORMW] + l * DM, (bf16*)(a.ws + WS_WIN) + (size_t)l * NPAD * DM, scr, r, lane);
        else p0_transpose_item<false>(a.in[I_WOUT] + (size_t)l * 2048 * DM, 2048, DM, DM / 32, nullptr, (bf16*)(a.ws + WS_WOUT) + (size_t)l * DM * 2048, scr, r - I_IN, lane);
    }
    float* rowss0 = (float*)(a.ws + WS_PART);
    for (int m0 = gw; m0 < T; m0 += 4 * NGW) {
        f32x4 v[4][4];
#pragma unroll
        for (int r = 0; r < 4; ++r)
#pragma unroll
            for (int j = 0; j < 4; ++j) v[r][j] = ((const GAS f32x4*)(a.in[I_X] + (size_t)(m0 + r * NGW) * DM) + lane)[64 * j];
        PIN_MEM();
#pragma unroll
        for (int r = 0; r < 4; ++r) { const int m = m0 + r * NGW; float s = 0.f;
            GAS unsigned long long* o8 = (GAS unsigned long long*)((bf16*)a.out + (size_t)m * DM) + lane;
#pragma unroll
            for (int j = 0; j < 4; ++j) { const f32x4 x = v[r][j]; s += (x.x * x.x + x.y * x.y) + (x.z * x.z + x.w * x.w);
                o8[64 * j] = (unsigned long long)pk2(x.x, x.y) | ((unsigned long long)pk2(x.z, x.w) << 32); }
            s = wave_sum(s); if (lane < 16) rowss0[(size_t)m * 16 + lane] = lane == 0 ? s : 0.f; }
    }
}

__device__ __forceinline__ void ex_chunk(const Args& a, int l, int c) {
    const int tid = opaque_tid(), lane = tid & 63, w = __builtin_amdgcn_readfirstlane(tid >> 6), l15 = lane & 15, lq = lane >> 4;
    const int nt = w & 1, tt = w >> 1, t = c * 64 + 16 * tt + l15;
    const bf16* wp = (const bf16*)(a.ws + WS_WIN) + ((size_t)l * NPAD + PJ + 16 * nt + l15) * DM + 8 * lq;
    const bf16* xp = (const bf16*)a.out + (size_t)t * DM + 8 * lq;
    const float* rs = (const float*)(a.ws + WS_PART) + (size_t)l * T * 16 + (size_t)t * 16;
    const f32x4 p0 = *(const GAS f32x4*)(rs), p1 = *(const GAS f32x4*)(rs + 4), p2 = *(const GAS f32x4*)(rs + 8), p3 = *(const GAS f32x4*)(rs + 12);
    f32x4 acc = (f32x4){0.f, 0.f, 0.f, 0.f};
#pragma unroll 1
    for (int kb = 0; kb < 4; ++kb) { bf16x8 xf[8], yf[8];
#pragma unroll
        for (int k8 = 0; k8 < 8; ++k8) { xf[k8] = *(const GAS bf16x8*)(wp + 32 * (kb * 8 + k8)); yf[k8] = *(const GAS bf16x8*)(xp + 32 * (kb * 8 + k8)); }
        PIN_MEM();
#pragma unroll
        for (int k8 = 0; k8 < 8; ++k8) acc = mfma32(xf[k8], yf[k8], acc); }
    const float rsum = (((p0[0] + p0[1]) + (p0[2] + p0[3])) + ((p1[0] + p1[1]) + (p1[2] + p1[3]))) + (((p2[0] + p2[1]) + (p2[2] + p2[3])) + ((p3[0] + p3[1]) + (p3[2] + p3[3])));
    const float rstd = frsq(rsum * (1.0f / 1024.0f) + EPS);
    *(GAS f32x4*)((float*)(a.ws + WS_EX) + (size_t)t * 32 + 16 * nt + 4 * lq) = acc * rstd;
}

template <int CTRL> __device__ __forceinline__ float dppf(float old, float v) { return __builtin_bit_cast(float, __builtin_amdgcn_update_dpp(__builtin_bit_cast(int, old), __builtin_bit_cast(int, v), CTRL, 0xF, 0xF, false)); }
template <int CTRL> __device__ __forceinline__ float dppz(float v) { return __builtin_bit_cast(float, __builtin_amdgcn_update_dpp(0, __builtin_bit_cast(int, v), CTRL, 0xF, 0xF, true)); }
#define LRU_S4(SH) \
    "v_fmac_f32_dpp %4, %4, %0 row_shr:" #SH " row_mask:0xf bank_mask:0xf\n v_fmac_f32_dpp %5, %5, %1 row_shr:" #SH " row_mask:0xf bank_mask:0xf\n" \
    "v_fmac_f32_dpp %6, %6, %2 row_shr:" #SH " row_mask:0xf bank_mask:0xf\n v_fmac_f32_dpp %7, %7, %3 row_shr:" #SH " row_mask:0xf bank_mask:0xf\n" \
    "v_mul_f32_dpp %0, %0, %0 row_shr:" #SH " row_mask:0xf bank_mask:0xf\n v_mul_f32_dpp %1, %1, %1 row_shr:" #SH " row_mask:0xf bank_mask:0xf\n" \
    "v_mul_f32_dpp %2, %2, %2 row_shr:" #SH " row_mask:0xf bank_mask:0xf\n v_mul_f32_dpp %3, %3, %3 row_shr:" #SH " row_mask:0xf bank_mask:0xf\n"
__device__ __forceinline__ void lru_scan4(float (&A)[4], float (&B)[4]) {
    asm("s_nop 1\n" LRU_S4(1) LRU_S4(2) LRU_S4(4) LRU_S4(8) "s_nop 1\n"
        : "+v"(A[0]), "+v"(A[1]), "+v"(A[2]), "+v"(A[3]), "+v"(B[0]), "+v"(B[1]), "+v"(B[2]), "+v"(B[3]));
}
#define LRU_SCAN_STEP(CTRL) do { const float Ap = dppf<CTRL>(1.0f, A[mt]), Bp = dppf<CTRL>(0.0f, B[mt]); B[mt] = A[mt] * Bp + B[mt]; A[mt] = A[mt] * Ap; } while (0)
__device__ __forceinline__ void lru_chunk(const Args& a, int l, int c, bool fin, LAS unsigned char* lds, bool dry = false, bool conv_only = false) {
    const int tid = opaque_tid(), lane = tid & 63, h = __builtin_amdgcn_readfirstlane(tid >> 6), l15 = lane & 15, lq = lane >> 4;
    const int t0 = c * 64; const bool hp = (c % CPB) != 0;
    bf16* PR = (bf16*)(a.ws + WS_PROJ);
    bf16x8 yf[4][2];
#pragma unroll
    for (int ks = 0; ks < 2; ++ks) {
        const int i0 = h * 64 + 32 * ks + 8 * lq; float cw[4][8], cb[8];
#pragma unroll
        for (int v = 0; v < 4; ++v) { const f32x4 w0 = *(const GAS f32x4*)(a.in[I_LCW] + (size_t)(l * 4 + v) * 512 + i0), w1 = *(const GAS f32x4*)(a.in[I_LCW] + (size_t)(l * 4 + v) * 512 + i0 + 4);
            cw[v][0] = w0[0]; cw[v][1] = w0[1]; cw[v][2] = w0[2]; cw[v][3] = w0[3]; cw[v][4] = w1[0]; cw[v][5] = w1[1]; cw[v][6] = w1[2]; cw[v][7] = w1[3]; }
        { const f32x4 b0 = *(const GAS f32x4*)(a.in[I_LCB] + l * 512 + i0), b1 = *(const GAS f32x4*)(a.in[I_LCB] + l * 512 + i0 + 4);
          cb[0] = b0[0]; cb[1] = b0[1]; cb[2] = b0[2]; cb[3] = b0[3]; cb[4] = b1[0]; cb[5] = b1[1]; cb[6] = b1[2]; cb[7] = b1[3]; }
#pragma unroll
        for (int mt = 0; mt < 4; ++mt) { const int t = 16 * mt + l15; float u[8];
#pragma unroll
            for (int q = 0; q < 8; ++q) u[q] = cb[q];
#pragma unroll
            for (int v = 0; v < 4; ++v) { const int tt = t - 3 + v; const int row = (t0 + tt) < 0 ? 0 : (t0 + tt);
                v4u raw = *(const GAS v4u*)(PR + (size_t)row * PJ + A_X + i0);
                if (!(tt >= 0 || hp)) raw = (v4u){0u, 0u, 0u, 0u};
                u[0] += cw[v][0] * bflo(raw.x); u[1] += cw[v][1] * bfhi(raw.x); u[2] += cw[v][2] * bflo(raw.y); u[3] += cw[v][3] * bfhi(raw.y);
                u[4] += cw[v][4] * bflo(raw.z); u[5] += cw[v][5] * bfhi(raw.z); u[6] += cw[v][6] * bflo(raw.w); u[7] += cw[v][7] * bfhi(raw.w); }
            v4u pk; pk.x = pk2(u[0], u[1]); pk.y = pk2(u[2], u[3]); pk.z = pk2(u[4], u[5]); pk.w = pk2(u[6], u[7]); yf[mt][ks] = __builtin_bit_cast(bf16x8, pk); }
    }
    if (conv_only) {
#pragma unroll
        for (int mt = 0; mt < 4; ++mt) { asm volatile("" :: "v"(yf[mt][0]), "v"(yf[mt][1])); }
        return; }
    const bf16* WRt = (const bf16*)(a.ws + WS_LRW) + (size_t)((l * 2 + 0) * 8 + h) * 4096; const bf16* WIt = (const bf16*)(a.ws + WS_LRW) + (size_t)((l * 2 + 1) * 8 + h) * 4096;
#define LRU_LOADS(J, XR, XI, BR, BI, LL) do { const int ch0_ = h * 64 + 16 * (J) + 4 * lq; \
        _Pragma("unroll") for (int ks = 0; ks < 2; ++ks) { XR[ks] = *(const GAS bf16x8*)(WRt + (size_t)(16 * (J) + l15) * 64 + 32 * ks + 8 * lq); XI[ks] = *(const GAS bf16x8*)(WIt + (size_t)(16 * (J) + l15) * 64 + 32 * ks + 8 * lq); } \
        BR = *(const GAS f32x4*)(a.in[I_LBR] + l * 512 + ch0_); BI = *(const GAS f32x4*)(a.in[I_LBI] + l * 512 + ch0_); LL = *(const GAS f32x4*)(a.in[I_LL] + l * 512 + ch0_); \
        } while (0)
    bf16x8 cxr[2], cxi[2], nxr[2], nxi[2]; f32x4 br4, bi4, ll4, nbr, nbi, nll;
    LRU_LOADS(0, cxr, cxi, br4, bi4, ll4);
#pragma unroll 1
    for (int jt = 0; jt < 4; ++jt) {
        const int jn = jt < 3 ? jt + 1 : 3;
        LRU_LOADS(jn, nxr, nxi, nbr, nbi, nll);
        const int ch0 = h * 64 + 16 * jt + 4 * lq;
        f32x4 hin4 = (f32x4){0.f, 0.f, 0.f, 0.f}; v2u czv[4];
#pragma unroll
        for (int mt = 0; mt < 4; ++mt) czv[mt] = (v2u){0u, 0u};
        if (fin) { hin4 = *(const GAS f32x4*)((const float*)(a.ws + WS_LRUH) + (size_t)c * 512 + ch0);
#pragma unroll
            for (int mt = 0; mt < 4; ++mt) czv[mt] = *(const GAS v2u*)(PR + (size_t)(t0 + 16 * mt + l15) * PJ + A_Z + ch0); }
        PIN_MEM();
        f32x4 ar[4], ai[4], au[4];
#pragma unroll
        for (int mt = 0; mt < 4; ++mt) { ar[mt] = (f32x4){0.f, 0.f, 0.f, 0.f}; ai[mt] = ar[mt]; au[mt] = ar[mt]; }
#pragma unroll
        for (int ks = 0; ks < 2; ++ks) {
            bf16x8 xu = (bf16x8){0, 0, 0, 0, 0, 0, 0, 0};
#pragma unroll
            for (int e = 0; e < 8; ++e) xu[e] = (32 * ks + 8 * lq + e == 16 * jt + l15) ? (short)0x3F80 : (short)0;
#pragma unroll
            for (int mt = 0; mt < 4; ++mt) { ar[mt] = mfma32(cxr[ks], yf[mt][ks], ar[mt]); ai[mt] = mfma32(cxi[ks], yf[mt][ks], ai[mt]); au[mt] = mfma32(xu, yf[mt][ks], au[mt]); }
        }
        float hv[4][4]; unsigned cpk[4][4];
#pragma unroll
        for (int r = 0; r < 4; ++r) {
            const float sp = softplus(-ll4[r]); float A[4], B[4];
#pragma unroll
            for (int mt = 0; mt < 4; ++mt) { const float rg = sigm(ar[mt][r] + br4[r]), ig = sigm(ai[mt][r] + bi4[r]); const float la = -8.0f * rg * sp;
                A[mt] = fexp(la); B[mt] = fsqrt((1.0f - A[mt]) * (1.0f + A[mt])) * ig * au[mt][r]; }
            lru_scan4(A, B);
            float Ac = 1.0f, Bc = 0.0f;
#pragma unroll
            for (int mt = 0; mt < 4; ++mt) { B[mt] = A[mt] * Bc + B[mt]; A[mt] = A[mt] * Ac; Ac = dppz<0x15F>(A[mt]); Bc = dppz<0x15F>(B[mt]); }
            if (fin) {
#pragma unroll
                for (int mt = 0; mt < 4; ++mt) hv[mt][r] = B[mt] + A[mt] * hin4[r];
            } else {
#pragma unroll
                for (int mt = 0; mt < 4; ++mt) cpk[mt][r] = pk2(A[mt], B[mt]);
                if (l15 == 15) { float* E = (float*)(a.ws + WS_LRUE) + ((size_t)c * 512 + ch0 + r) * 2; E[0] = A[3]; E[1] = B[3]; }
            }
        }
        if (!fin) {
#pragma unroll
            for (int mt = 0; mt < 4; ++mt) { v4u o; o.x = cpk[mt][0]; o.y = cpk[mt][1]; o.z = cpk[mt][2]; o.w = cpk[mt][3];
                *(GAS v4u*)((unsigned*)a.out + (size_t)8388608 + (size_t)(t0 + 16 * mt + l15) * 512 + ch0) = o; }
        }
        if (fin) {
#pragma unroll
            for (int mt = 0; mt < 4; ++mt) { GAS v2u* zp = (GAS v2u*)(PR + (size_t)(t0 + 16 * mt + l15) * PJ + A_Z + ch0); const v2u zv = czv[mt];
                v2u o; o.x = pk2(hv[mt][0] * silu(bflo(zv.x)), hv[mt][1] * silu(bfhi(zv.x))); o.y = pk2(hv[mt][2] * silu(bflo(zv.y)), hv[mt][3] * silu(bfhi(zv.y))); if (dry) asm volatile("" :: "v"(o.x), "v"(o.y)); else *zp = o; }
        }
#pragma unroll
        for (int ks = 0; ks < 2; ++ks) { cxr[ks] = nxr[ks]; cxi[ks] = nxi[ks]; }
        br4 = nbr; bi4 = nbi; ll4 = nll;
    }
#undef LRU_LOADS
}

__device__ __forceinline__ void lru_out(const Args& a, int l, int c, bool dry = false) {
    const int tid = opaque_tid(), cg = tid & 63, tq = tid >> 6; const int t0 = c * 64;
    bf16* PR = (bf16*)(a.ws + WS_PROJ); const unsigned* LC = (const unsigned*)a.out + (size_t)8388608;
    const f32x4 h0 = *(const GAS f32x4*)((const float*)(a.ws + WS_LRUH) + (size_t)c * 512 + 8 * cg), h1 = *(const GAS f32x4*)((const float*)(a.ws + WS_LRUH) + (size_t)c * 512 + 8 * cg + 4);
    v4u p0[8], p1[8], zz[8];
#pragma unroll
    for (int i = 0; i < 8; ++i) { const size_t t = (size_t)(t0 + 8 * tq + i);
        p0[i] = *(const GAS v4u*)(LC + t * 512 + 8 * cg); p1[i] = *(const GAS v4u*)(LC + t * 512 + 8 * cg + 4); zz[i] = *(const GAS v4u*)(PR + t * PJ + A_Z + 8 * cg); }
    PIN_MEM();
#pragma unroll
    for (int i = 0; i < 8; ++i) { const size_t t = (size_t)(t0 + 8 * tq + i);
        const float y0 = (bfhi(p0[i].x) + bflo(p0[i].x) * h0[0]) * silu(bflo(zz[i].x)), y1 = (bfhi(p0[i].y) + bflo(p0[i].y) * h0[1]) * silu(bfhi(zz[i].x));
        const float y2 = (bfhi(p0[i].z) + bflo(p0[i].z) * h0[2]) * silu(bflo(zz[i].y)), y3 = (bfhi(p0[i].w) + bflo(p0[i].w) * h0[3]) * silu(bfhi(zz[i].y));
        const float y4 = (bfhi(p1[i].x) + bflo(p1[i].x) * h1[0]) * silu(bflo(zz[i].z)), y5 = (bfhi(p1[i].y) + bflo(p1[i].y) * h1[1]) * silu(bfhi(zz[i].z));
        const float y6 = (bfhi(p1[i].z) + bflo(p1[i].z) * h1[2]) * silu(bflo(zz[i].w)), y7 = (bfhi(p1[i].w) + bflo(p1[i].w) * h1[3]) * silu(bfhi(zz[i].w));
        v4u o; o.x = pk2(y0, y1); o.y = pk2(y2, y3); o.z = pk2(y4, y5); o.w = pk2(y6, y7);
        if (dry) asm volatile("" :: "v"(o.x), "v"(o.y), "v"(o.z), "v"(o.w)); else *(GAS v4u*)(PR + t * PJ + A_Z + 8 * cg) = o; }
}

constexpr int UBP = 520;
__device__ __forceinline__ void s5_local(const Args& a, int l, int c) {
    const int tid = opaque_tid(), lane = tid & 63, w = __builtin_amdgcn_readfirstlane(tid >> 6), l15 = lane & 15, lq = lane >> 4;
    const int t0 = c * 64;
    const bf16* PR = (const bf16*)(a.ws + WS_PROJ);
    const unsigned char* tb = a.ws + WS_S5T + (size_t)l * S5T_LAYER;
    const bf16* BC = (const bf16*)(tb + S5T_BC); const f32x2* PW = (const f32x2*)(tb + S5T_PW);
    f32x2* ST = (f32x2*)(a.ws + WS_S5ST) + (size_t)c * 2048;
#pragma unroll 2
    for (int k = 0; k < 4; ++k) {
        const int g = 4 * w + k; bf16x4 yf[4], xr[4], xi[4]; f32x2 wb[4][4], st[4][4];
#pragma unroll
        for (int nt = 0; nt < 4; ++nt) yf[nt] = *(const GAS bf16x4*)(PR + (size_t)(t0 + 16 * nt + l15) * PJ + B_U + g * 16 + 4 * lq);
#pragma unroll
        for (int mt = 0; mt < 4; ++mt) { xr[mt] = *(const GAS bf16x4*)(BC + ((size_t)g * 128 + 16 * mt + l15) * 16 + 4 * lq); xi[mt] = *(const GAS bf16x4*)(BC + ((size_t)g * 128 + 64 + 16 * mt + l15) * 16 + 4 * lq);
#pragma unroll
            for (int r = 0; r < 4; ++r) { const int n = 16 * mt + 4 * lq + r; wb[mt][r] = PW[(g * 64 + n) * 17 + (15 - l15)]; st[mt][r] = PW[(g * 64 + n) * 17 + 16]; } }
        PIN_MEM();
#pragma unroll
        for (int mt = 0; mt < 4; ++mt) {
            f32x4 ar[4], ai[4];
#pragma unroll
            for (int nt = 0; nt < 4; ++nt) { ar[nt] = mfma16(xr[mt], yf[nt], (f32x4){0.f, 0.f, 0.f, 0.f}); ai[nt] = mfma16(xi[mt], yf[nt], (f32x4){0.f, 0.f, 0.f, 0.f}); }
#pragma unroll
            for (int r = 0; r < 4; ++r) {
                const int n = 16 * mt + 4 * lq + r; const f32x2 s16 = st[mt][r];
                float er = 0.f, ei = 0.f, wr = wb[mt][r].x, wi = wb[mt][r].y;
#pragma unroll
                for (int nt = 3; nt >= 0; --nt) { const float br = ar[nt][r], bi = ai[nt][r]; er += wr * br - wi * bi; ei += wr * bi + wi * br;
                    const float nwr = wr * s16.x - wi * s16.y, nwi = wr * s16.y + wi * s16.x; wr = nwr; wi = nwi; }
                er += dppz<0x111>(er); ei += dppz<0x111>(ei); er += dppz<0x112>(er); ei += dppz<0x112>(ei);
                er += dppz<0x114>(er); ei += dppz<0x114>(ei); er += dppz<0x118>(er); ei += dppz<0x118>(ei);
                if (l15 == 15) { const f32x2 v = {er, ei}; ST[g * 64 + n] = v; }
            }
        }
    }
}
__device__ __forceinline__ void s5_out(const Args& a, int l, int c, LAS unsigned char* lds, bool dry = false) {
    const int tid = opaque_tid(), lane = tid & 63, w = __builtin_amdgcn_readfirstlane(tid >> 6), l15 = lane & 15, lq = lane >> 4;
    const int t0 = c * 64;
    LAS bf16* ub = (LAS bf16*)lds;
    bf16* PR = (bf16*)(a.ws + WS_PROJ);
    { v4u ut[8];
#pragma unroll
      for (int i = 0; i < 8; ++i) { const int idx = tid + NTHR * i, row = idx >> 6, c8 = idx & 63; ut[i] = *(const GAS v4u*)(PR + (size_t)(t0 + row) * PJ + B_U + c8 * 8); }
      PIN_MEM();
      for (int idx = tid; idx < 16 * 65; idx += NTHR) { const int row = idx / 65, c8 = idx % 65; *(LAS v4u*)(ub + row * UBP + c8 * 8) = (v4u){0u, 0u, 0u, 0u}; }
#pragma unroll
      for (int i = 0; i < 8; ++i) { const int idx = tid + NTHR * i, row = idx >> 6, c8 = idx & 63; *(LAS v4u*)(ub + (16 + row) * UBP + c8 * 8) = ut[i]; } }
    __syncthreads();
    const unsigned char* tb = a.ws + WS_S5T + (size_t)l * S5T_LAYER;
    const bf16* KT = (const bf16*)(tb + S5T_KT); const bf16* CC = (const bf16*)(tb + S5T_CC); const f32x2* PW = (const f32x2*)(tb + S5T_PW);
    const f32x2* ST = (const f32x2*)(a.ws + WS_S5ST) + (size_t)c * 2048;
#define S5_KLOAD(dst, kb) do { _Pragma("unroll") for (int k8 = 0; k8 < 8; ++k8) dst[k8] = *(const GAS bf16x8*)(kp + (size_t)(2 * ((kb) * 8 + k8)) * 256); } while (0)
#define S5_KMMA(src, kb) do { _Pragma("unroll") for (int k8 = 0; k8 < 8; ++k8) { _Pragma("unroll") for (int it = (kb); it < 4; ++it) { \
        const bf16x8 yf = *(const LAS bf16x8*)(up + (16 * it - 2 * ((kb) * 8 + k8)) * UBP); acc[it] = mfma32(src[k8], yf, acc[it]); } } } while (0)
#pragma unroll 1
    for (int k = 0; k < 4; ++k) {
        const int g = 4 * w + k; f32x4 acc[4];
#pragma unroll
        for (int it = 0; it < 4; ++it) acc[it] = (f32x4){0.f, 0.f, 0.f, 0.f};
        const bf16* kp = KT + ((size_t)(g * 64 + (lq >> 1)) * 16 + l15) * 16 + 8 * (lq & 1);
        const LAS bf16* up = ub + (16 + l15 - (lq >> 1)) * UBP + g * 16 + 8 * (lq & 1);
        bf16x8 ka[8], kc[8];
        S5_KLOAD(ka, 0); S5_KLOAD(kc, 1); PIN_MEM();
        S5_KMMA(ka, 0);
        S5_KLOAD(ka, 2); PIN_MEM();
        S5_KMMA(kc, 1);
        bf16x8 xfc[4]; f32x2 pb[4][4], ps[4][4], sv[4][4];
        S5_KLOAD(kc, 3);
#pragma unroll
        for (int ks2 = 0; ks2 < 4; ++ks2) { xfc[ks2] = *(const GAS bf16x8*)(CC + ((size_t)g * 16 + l15) * 128 + 32 * ks2 + 8 * lq);
#pragma unroll
            for (int m = 0; m < 4; ++m) { const int n = 16 * ks2 + 4 * lq + m; pb[ks2][m] = PW[(g * 64 + n) * 17 + l15 + 1]; ps[ks2][m] = PW[(g * 64 + n) * 17 + 16]; sv[ks2][m] = ST[g * 64 + n]; } }
        const f32x4 dsk = *(const GAS f32x4*)(a.in[I_SD] + l * 512 + g * 16 + 4 * lq);
        PIN_MEM();
        S5_KMMA(ka, 2);
        S5_KMMA(kc, 3);
#pragma unroll
        for (int ks2 = 0; ks2 < 4; ++ks2) {
            float pr[4], pi[4];
#pragma unroll
            for (int m = 0; m < 4; ++m) { pr[m] = pb[ks2][m].x; pi[m] = pb[ks2][m].y; }
#pragma unroll
            for (int it = 0; it < 4; ++it) {
                v4u zz; unsigned zw[4];
#pragma unroll
                for (int m = 0; m < 4; ++m) { const float sr = sv[ks2][m].x, si = sv[ks2][m].y, qr = ps[ks2][m].x, qi = ps[ks2][m].y;
                    const float zr = pr[m] * sr - pi[m] * si, zi = pr[m] * si + pi[m] * sr; zw[m] = pk2(zr, zi);
                    const float nr = pr[m] * qr - pi[m] * qi, ni = pr[m] * qi + pi[m] * qr; pr[m] = nr; pi[m] = ni; }
                zz.x = zw[0]; zz.y = zw[1]; zz.z = zw[2]; zz.w = zw[3];
                acc[it] = mfma32(xfc[ks2], __builtin_bit_cast(bf16x8, zz), acc[it]);
            }
        }
#pragma unroll
        for (int it = 0; it < 4; ++it) { LAS v2u* p = (LAS v2u*)(ub + (16 + 16 * it + l15) * UBP + g * 16 + 4 * lq); const v2u uv = *p;
            const float y0 = gelu_tanh(acc[it][0] + dsk[0] * bflo(uv.x)), y1 = gelu_tanh(acc[it][1] + dsk[1] * bfhi(uv.x)), y2 = gelu_tanh(acc[it][2] + dsk[2] * bflo(uv.y)), y3 = gelu_tanh(acc[it][3] + dsk[3] * bfhi(uv.y));
            v2u o; o.x = pk2(y0, y1); o.y = pk2(y2, y3); *p = o; }
    }
#undef S5_KLOAD
#undef S5_KMMA
    {
        f32x4 acc[4][4]; v2u zv[4][4]; f32x4 gb[4];
        const bf16* wp = (const bf16*)(a.ws + WS_GLUT) + (size_t)l * 512 * 512 + (size_t)(64 * w + l15) * 512 + 8 * lq;
        bf16x8 xa[4], xb[4];
#pragma unroll
        for (int jt = 0; jt < 4; ++jt) { xa[jt] = *(const GAS bf16x8*)(wp + (size_t)(16 * jt) * 512); gb[jt] = *(const GAS f32x4*)(a.in[I_SGB] + l * 512 + 64 * w + 16 * jt + 4 * lq);
#pragma unroll
            for (int tt = 0; tt < 4; ++tt) { zv[jt][tt] = *(const GAS v2u*)(PR + (size_t)(t0 + 16 * tt + l15) * PJ + B_Z + 64 * w + 16 * jt + 4 * lq); acc[jt][tt] = (f32x4){0.f, 0.f, 0.f, 0.f}; } }
        PIN_MEM();
        __syncthreads();
        const LAS bf16* yp = ub + (16 + l15) * UBP + 8 * lq;
#define S5_GMMA(xf, ks) do { bf16x8 yf[4]; _Pragma("unroll") for (int tt = 0; tt < 4; ++tt) yf[tt] = *(const LAS bf16x8*)(yp + (16 * tt) * UBP + 32 * (ks)); \
        _Pragma("unroll") for (int jt = 0; jt < 4; ++jt) _Pragma("unroll") for (int tt = 0; tt < 4; ++tt) acc[jt][tt] = mfma32(xf[jt], yf[tt], acc[jt][tt]); } while (0)
#pragma unroll 1
        for (int k2 = 0; k2 < 8; ++k2) {
#pragma unroll
            for (int jt = 0; jt < 4; ++jt) xb[jt] = *(const GAS bf16x8*)(wp + (size_t)(16 * jt) * 512 + 32 * (2 * k2 + 1));
            PIN_MEM();
            S5_GMMA(xa, 2 * k2);
            const int kn = k2 < 7 ? 2 * k2 + 2 : 15;
#pragma unroll
            for (int jt = 0; jt < 4; ++jt) xa[jt] = *(const GAS bf16x8*)(wp + (size_t)(16 * jt) * 512 + 32 * kn);
            PIN_MEM();
            S5_GMMA(xb, 2 * k2 + 1);
        }
#undef S5_GMMA
#pragma unroll
        for (int jt = 0; jt < 4; ++jt) { const int j0 = 64 * w + 16 * jt + 4 * lq;
#pragma unroll
            for (int tt = 0; tt < 4; ++tt) { const int t = 16 * tt + l15; const v2u yv = *(const LAS v2u*)(ub + (16 + t) * UBP + j0);
                GAS v2u* zp = (GAS v2u*)(PR + (size_t)(t0 + t) * PJ + B_Z + j0); const v2u zz = zv[jt][tt];
                const float o0 = bflo(yv.x) * sigm(acc[jt][tt][0] + gb[jt][0]) * silu(bflo(zz.x)), o1 = bfhi(yv.x) * sigm(acc[jt][tt][1] + gb[jt][1]) * silu(bfhi(zz.x));
                const float o2 = bflo(yv.y) * sigm(acc[jt][tt][2] + gb[jt][2]) * silu(bflo(zz.y)), o3 = bfhi(yv.y) * sigm(acc[jt][tt][3] + gb[jt][3]) * silu(bfhi(zz.y));
                v2u o; o.x = pk2(o0, o1); o.y = pk2(o2, o3); if (dry) asm volatile("" :: "v"(o.x), "v"(o.y)); else *zp = o; } }
    }
    __syncthreads();
}

__device__ __forceinline__ void s5_chunk(const Args& a, int l, int c, bool fin, LAS unsigned char* lds, bool dry = false) { if (fin) s5_out(a, l, c, lds, dry); else s5_local(a, l, c); }

constexpr int QP = 264, VPF = 520, SPP = 72;
constexpr int GLA_QD = 0, GLA_KI = 33792, GLA_VV = 67584, GLA_SS = 134144, GLA_GT = 134144, GLA_GLW = 136192;
__device__ __forceinline__ void gla_chunk(const Args& a, int l, int c, bool fin, LAS unsigned char* lds, bool dry = false) {
    const int tid = opaque_tid(), lane = tid & 63, w = __builtin_amdgcn_readfirstlane(tid >> 6), l15 = lane & 15, lq = lane >> 4; const int t0 = c * 64;
    LAS bf16* QD = (LAS bf16*)(lds + GLA_QD); LAS bf16* KI = (LAS bf16*)(lds + GLA_KI); LAS bf16* VV = (LAS bf16*)(lds + GLA_VV); LAS bf16* SS = (LAS bf16*)(lds + GLA_SS);
    LAS float* GT = (LAS float*)(lds + GLA_GT); LAS float* GLW = (LAS float*)(lds + GLA_GLW);
    bf16* PR = (bf16*)(a.ws + WS_PROJ); const float* EX = (const float*)(a.ws + WS_EX);
    bf16* KV = (bf16*)(a.ws + WS_GLA) + (size_t)c * 32768;
    const int d = tid & 255, half = tid >> 8; float g[32]; unsigned short kraw[32], qraw[32];
    { float wg[16]; v4u vt[8];
      const f32x2 glr = *(const GAS f32x2*)(EX + (size_t)(t0 + (tid >> 3)) * 32 + 2 * (tid & 7));
#pragma unroll
      for (int r = 0; r < 16; ++r) wg[r] = a.in[I_GWG][(size_t)(l * 16 + r) * 256 + d];
      const float bg = a.in[I_GBG][l * 256 + d];
#pragma unroll
      for (int i = 0; i < 8; ++i) { const int idx = tid + NTHR * i, row = idx >> 6, c8 = idx & 63; vt[i] = *(const GAS v4u*)(PR + (size_t)(t0 + row) * PJ + C_V + c8 * 8); }
#pragma unroll
      for (int tt = 0; tt < 32; ++tt) { kraw[tt] = PR[(size_t)(t0 + 32 * half + tt) * PJ + C_K + d]; qraw[tt] = PR[(size_t)(t0 + 32 * half + tt) * PJ + C_Q + d]; }
      PIN_MEM();
      *(LAS f32x2*)(GLW + (tid >> 3) * 16 + 2 * (tid & 7)) = glr;
#pragma unroll
      for (int i = 0; i < 8; ++i) { const int idx = tid + NTHR * i, row = idx >> 6, c8 = idx & 63; *(LAS v4u*)(VV + row * VPF + c8 * 8) = vt[i]; }
      __syncthreads();
      float run = 0.f;
#pragma unroll
      for (int tt = 0; tt < 32; ++tt) { const LAS f32x4* gl = (const LAS f32x4*)(GLW + (32 * half + tt) * 16); const f32x4 g0 = gl[0], g1 = gl[1], g2 = gl[2], g3 = gl[3];
          float lg = bg + ((g0[0] * wg[0] + g0[1] * wg[1]) + (g0[2] * wg[2] + g0[3] * wg[3])) + ((g1[0] * wg[4] + g1[1] * wg[5]) + (g1[2] * wg[6] + g1[3] * wg[7]))
                        + ((g2[0] * wg[8] + g2[1] * wg[9]) + (g2[2] * wg[10] + g2[3] * wg[11])) + ((g3[0] * wg[12] + g3[1] * wg[13]) + (g3[2] * wg[14] + g3[3] * wg[15]));
          run += -softplus(-lg) * (1.0f / 16.0f); g[tt] = run; }
      GT[half * 256 + d] = run; }
    __syncthreads();
    { const float tot0 = GT[d], tot1 = GT[256 + d], off = half ? tot0 : 0.f, glast = tot0 + tot1;
      const float kofs = fin ? 0.f : glast;
#pragma unroll
      for (int tt = 0; tt < 32; ++tt) { const int t = 32 * half + tt; const float gc = g[tt] + off; const float kx = bf2f(kraw[tt]), qx = bf2f(qraw[tt]);
          QD[t * QP + d] = (bf16)f2bf(qx * 0.125f * fexp(gc)); KI[t * QP + d] = (bf16)f2bf(kx * fexp(kofs - gc)); }
      if (!fin && half == 0) ((float*)(a.ws + WS_GDEC))[(size_t)c * 256 + d] = fexp(glast); }
    __syncthreads();
    if (!fin) {
        const int h = w >> 1, eh = w & 1; f32x4 acc[4][4];
#pragma unroll
        for (int dt = 0; dt < 4; ++dt)
#pragma unroll
            for (int et = 0; et < 4; ++et) acc[dt][et] = (f32x4){0.f, 0.f, 0.f, 0.f};
#pragma unroll
        for (int ks = 0; ks < 2; ++ks) { bf16x8 xf[4], yf[4];
#pragma unroll
            for (int dt = 0; dt < 4; ++dt) xf[dt] = tr_frag(KI + (32 * ks + 8 * lq + (l15 >> 2)) * QP + h * 64 + 16 * dt + 4 * (l15 & 3), QP);
#pragma unroll
            for (int et = 0; et < 4; ++et) yf[et] = tr_frag(VV + (32 * ks + 8 * lq + (l15 >> 2)) * VPF + h * 128 + 64 * eh + 16 * et + 4 * (l15 & 3), VPF);
#pragma unroll
            for (int dt = 0; dt < 4; ++dt)
#pragma unroll
                for (int et = 0; et < 4; ++et) acc[dt][et] = mfma32(xf[dt], yf[et], acc[dt][et]); }
#pragma unroll
        for (int dt = 0; dt < 4; ++dt)
#pragma unroll
            for (int et = 0; et < 4; ++et) { v2u o; o.x = pk2(acc[dt][et][0], acc[dt][et][1]); o.y = pk2(acc[dt][et][2], acc[dt][et][3]);
                *(GAS v2u*)(KV + ((size_t)h * 128 + 64 * eh + 16 * et + l15) * 64 + 16 * dt + 4 * lq) = o; }
    } else {
#pragma unroll 1
        for (int rd = 0; rd < 2; ++rd) {
            const int hl = w >> 2, it = w & 3, h = 2 * rd + hl, i = 16 * it + l15; LAS bf16* SSw = SS + w * 16 * SPP;
            bf16x8 pf[2][8]; v2u zv[8]; f32x4 nw[8];
#pragma unroll
            for (int ks = 0; ks < 2; ++ks)
#pragma unroll
                for (int et = 0; et < 8; ++et) pf[ks][et] = *(const GAS bf16x8*)(KV + ((size_t)h * 128 + 16 * et + l15) * 64 + 32 * ks + 8 * lq);
#pragma unroll
            for (int et = 0; et < 8; ++et) { zv[et] = *(const GAS v2u*)(PR + (size_t)(t0 + i) * PJ + C_Z + h * 128 + 16 * et + 4 * lq); nw[et] = *(const GAS f32x4*)(a.in[I_GNW] + l * 128 + 16 * et + 4 * lq); }
            PIN_MEM();
#pragma unroll
            for (int jt = 0; jt < 4; ++jt) { v2u o = (v2u){0u, 0u};
                if (jt <= it) { f32x4 s = (f32x4){0.f, 0.f, 0.f, 0.f};
#pragma unroll
                    for (int ks = 0; ks < 2; ++ks) { const bf16x8 xf = *(const LAS bf16x8*)(KI + (16 * jt + l15) * QP + h * 64 + 32 * ks + 8 * lq), yf = *(const LAS bf16x8*)(QD + (16 * it + l15) * QP + h * 64 + 32 * ks + 8 * lq);
                        s = mfma32(xf, yf, s); }
                    const int j0 = 16 * jt + 4 * lq;
                    o.x = pk2(j0 <= i ? s[0] : 0.f, j0 + 1 <= i ? s[1] : 0.f); o.y = pk2(j0 + 2 <= i ? s[2] : 0.f, j0 + 3 <= i ? s[3] : 0.f); }
                *(LAS v2u*)(SSw + l15 * SPP + 16 * jt + 4 * lq) = o; }
            f32x4 oa[8];
#pragma unroll
            for (int et = 0; et < 8; ++et) oa[et] = (f32x4){0.f, 0.f, 0.f, 0.f};
#pragma unroll
            for (int ks = 0; ks < 2; ++ks) { if (32 * ks <= 16 * it + 15) { const bf16x8 yf = *(const LAS bf16x8*)(SSw + l15 * SPP + 32 * ks + 8 * lq);
#pragma unroll
                for (int et = 0; et < 8; ++et) { const bf16x8 xf = tr_frag(VV + (32 * ks + 8 * lq + (l15 >> 2)) * VPF + h * 128 + 16 * et + 4 * (l15 & 3), VPF); oa[et] = mfma32(xf, yf, oa[et]); } } }
#pragma unroll
            for (int ks = 0; ks < 2; ++ks) { const bf16x8 yf = *(const LAS bf16x8*)(QD + (16 * it + l15) * QP + h * 64 + 32 * ks + 8 * lq);
#pragma unroll
                for (int et = 0; et < 8; ++et) oa[et] = mfma32(pf[ks][et], yf, oa[et]); }
            float ss = 0.f;
#pragma unroll
            for (int et = 0; et < 8; ++et) ss += (oa[et][0] * oa[et][0] + oa[et][1] * oa[et][1]) + (oa[et][2] * oa[et][2] + oa[et][3] * oa[et][3]);
            ss += __shfl_xor(ss, 16); ss += __shfl_xor(ss, 32);
            const float rstd = frsq(ss * (1.0f / 128.0f) + EPS);
#pragma unroll
            for (int et = 0; et < 8; ++et) { GAS v2u* zp = (GAS v2u*)(PR + (size_t)(t0 + i) * PJ + C_Z + h * 128 + 16 * et + 4 * lq);
                v2u o; o.x = pk2(oa[et][0] * rstd * nw[et][0] * silu(bflo(zv[et].x)), oa[et][1] * rstd * nw[et][1] * silu(bfhi(zv[et].x)));
                o.y = pk2(oa[et][2] * rstd * nw[et][2] * silu(bflo(zv[et].y)), oa[et][3] * rstd * nw[et][3] * silu(bfhi(zv[et].y)));
                if (dry) asm volatile("" :: "v"(o.x), "v"(o.y)); else *zp = o; }
        }
    }
    __syncthreads();
}

constexpr int XSP = 520, BMP = 264, MP = 72;
constexpr int SSD_XS = 0, SSD_CM = 66560, SSD_BM = 100352, SSD_M = 100352, SSD_DT = 137216, SSD_AC = 139264, SSD_SQ = 141312;
__device__ __forceinline__ void ssd_chunk(const Args& a, int l, int c, bool fin, LAS unsigned char* lds, bool dry = false) {
    const int tid = opaque_tid(), lane = tid & 63, w = __builtin_amdgcn_readfirstlane(tid >> 6), l15 = lane & 15, lq = lane >> 4; const int t0 = c * 64;
    const bool hp = (c % CPB) != 0;
    LAS bf16* XS = (LAS bf16*)(lds + SSD_XS); LAS bf16* CM = (LAS bf16*)(lds + SSD_CM); LAS bf16* BM = (LAS bf16*)(lds + SSD_BM); LAS bf16* MM = (LAS bf16*)(lds + SSD_M);
    LAS float* dtl = (LAS float*)(lds + SSD_DT); LAS float* acl = (LAS float*)(lds + SSD_AC); LAS float* ssq = (LAS float*)(lds + SSD_SQ);
    bf16* PR = (bf16*)(a.ws + WS_PROJ); const float* EX = (const float*)(a.ws + WS_EX);
    bf16* STT = (bf16*)(a.ws + WS_SSD) + (size_t)c * 65536;
    { const int h = w; const float bias = a.in[I_DDTB][l * 8 + h], av = -expf(a.in[I_DALOG][l * 8 + h]);
      const float dt = softplus(EX[(size_t)(t0 + lane) * 32 + 16 + h] + bias); float cum = dt * av;
#pragma unroll
      for (int off = 1; off < 64; off <<= 1) { const float pv = __shfl_up(cum, off); if (lane >= off) cum += pv; }
      dtl[lane * 8 + h] = dt; acl[lane * 8 + h] = cum; }
    __syncthreads();
    { const int cg = tid & 127, seg = tid >> 7; int mycol, wch, pitch; LAS bf16* dst;
      if (cg < 64) { mycol = D_XS + 8 * cg; wch = 8 * cg; dst = XS + 8 * cg; pitch = XSP; }
      else if (cg < 96) { mycol = D_BM + 8 * (cg - 64); wch = 512 + 8 * (cg - 64); dst = BM + 8 * (cg - 64); pitch = BMP; }
      else { mycol = D_CM + 8 * (cg - 96); wch = 768 + 8 * (cg - 96); dst = CM + 8 * (cg - 96); pitch = BMP; }
      if (fin || cg < 96) {
          float wgt[4][8], cb[8];
          const float* cw = a.in[I_DCW] + (size_t)l * 4 * 1024 + wch;
#pragma unroll
          for (int v = 0; v < 4; ++v) { const f32x4 w0 = *(const GAS f32x4*)(cw + v * 1024), w1 = *(const GAS f32x4*)(cw + v * 1024 + 4);
              wgt[v][0] = w0[0]; wgt[v][1] = w0[1]; wgt[v][2] = w0[2]; wgt[v][3] = w0[3]; wgt[v][4] = w1[0]; wgt[v][5] = w1[1]; wgt[v][6] = w1[2]; wgt[v][7] = w1[3]; }
          { const f32x4 b0 = *(const GAS f32x4*)(a.in[I_DCB] + l * 1024 + wch), b1 = *(const GAS f32x4*)(a.in[I_DCB] + l * 1024 + wch + 4);
            cb[0] = b0[0]; cb[1] = b0[1]; cb[2] = b0[2]; cb[3] = b0[3]; cb[4] = b1[0]; cb[5] = b1[1]; cb[6] = b1[2]; cb[7] = b1[3]; }
          const int hh = cg >> 3; const float aL = acl[63 * 8 + (hh & 7)];
          v4u raws[19];
#pragma unroll
          for (int r = 0; r < 19; ++r) { const int t = 16 * seg - 3 + r; const int row = (t0 + t) < 0 ? 0 : (t0 + t); raws[r] = *(const GAS v4u*)(PR + (size_t)row * PJ + mycol); }
          PIN_MEM();
          float x3[8], x2[8], x1[8];
#pragma unroll
          for (int q = 0; q < 8; ++q) { x3[q] = 0.f; x2[q] = 0.f; x1[q] = 0.f; }
#pragma unroll
          for (int r = 0; r < 19; ++r) {
              const int t = 16 * seg - 3 + r; v4u raw = raws[r];
              if (!(t >= 0 || hp)) raw = (v4u){0u, 0u, 0u, 0u};
              float x0[8]; x0[0] = bflo(raw.x); x0[1] = bfhi(raw.x); x0[2] = bflo(raw.y); x0[3] = bfhi(raw.y); x0[4] = bflo(raw.z); x0[5] = bfhi(raw.z); x0[6] = bflo(raw.w); x0[7] = bfhi(raw.w);
              if (r >= 3) {
                  float sc = 1.0f; if (!fin && cg < 64) sc = fexp(aL - acl[t * 8 + hh]) * dtl[t * 8 + hh];
                  float o[8];
#pragma unroll
                  for (int q = 0; q < 8; ++q) o[q] = silu(cb[q] + wgt[0][q] * x3[q] + wgt[1][q] * x2[q] + wgt[2][q] * x1[q] + wgt[3][q] * x0[q]) * sc;
                  v4u pk; pk.x = pk2(o[0], o[1]); pk.y = pk2(o[2], o[3]); pk.z = pk2(o[4], o[5]); pk.w = pk2(o[6], o[7]);
                  *(LAS v4u*)(dst + t * pitch) = pk;
              }
#pragma unroll
              for (int q = 0; q < 8; ++q) { x3[q] = x2[q]; x2[q] = x1[q]; x1[q] = x0[q]; }
          }
      } }
    __syncthreads();
    if (!fin) {
        const int h = w, g = h >> 2;
#pragma unroll 1
        for (int sh = 0; sh < 2; ++sh) {
            f32x4 acc[4][4];
#pragma unroll
            for (int st = 0; st < 4; ++st)
#pragma unroll
                for (int pt = 0; pt < 4; ++pt) acc[st][pt] = (f32x4){0.f, 0.f, 0.f, 0.f};
#pragma unroll
            for (int ks = 0; ks < 2; ++ks) {
                bf16x8 xf[4], yf[4];
#pragma unroll
                for (int st = 0; st < 4; ++st) xf[st] = tr_frag(BM + (32 * ks + 8 * lq + (l15 >> 2)) * BMP + g * 128 + 64 * sh + 16 * st + 4 * (l15 & 3), BMP);
#pragma unroll
                for (int pt = 0; pt < 4; ++pt) yf[pt] = tr_frag(XS + (32 * ks + 8 * lq + (l15 >> 2)) * XSP + h * 64 + 16 * pt + 4 * (l15 & 3), XSP);
#pragma unroll
                for (int st = 0; st < 4; ++st)
#pragma unroll
                    for (int pt = 0; pt < 4; ++pt) acc[st][pt] = mfma32(xf[st], yf[pt], acc[st][pt]);
            }
#pragma unroll
            for (int st = 0; st < 4; ++st)
#pragma unroll
                for (int pt = 0; pt < 4; ++pt) { v2u o; o.x = pk2(acc[st][pt][0], acc[st][pt][1]); o.y = pk2(acc[st][pt][2], acc[st][pt][3]);
                    *(GAS v2u*)(STT + ((size_t)h * 64 + 16 * pt + l15) * 128 + 64 * sh + 16 * st + 4 * lq) = o; }
        }
        if (lane == 0) ((float*)(a.ws + WS_SDEC))[(size_t)c * 8 + h] = fexp(acl[63 * 8 + h]);
    } else {
        const int gC = w >> 2, itC = w & 3; f32x4 cbt[4];
#pragma unroll
        for (int jt = 0; jt < 4; ++jt) cbt[jt] = (f32x4){0.f, 0.f, 0.f, 0.f};
#pragma unroll
        for (int ks = 0; ks < 4; ++ks) {
            const bf16x8 yf = *(const LAS bf16x8*)(CM + (16 * itC + l15) * BMP + gC * 128 + 32 * ks + 8 * lq);
#pragma unroll
            for (int jt = 0; jt < 4; ++jt) { const bf16x8 xf = *(const LAS bf16x8*)(BM + (16 * jt + l15) * BMP + gC * 128 + 32 * ks + 8 * lq); cbt[jt] = mfma32(xf, yf, cbt[jt]); }
        }
        __syncthreads();
        f32x4 yv[2][4][2];
#pragma unroll 1
        for (int rd = 0; rd < 2; ++rd) {
            bf16x8 pfr[4][4]; v2u zvr[2][4];
            { const int ms_ = w >> 1, half_ = w & 1, g_ = ms_ >> 1, h_ = g_ * 4 + 2 * rd + (ms_ & 1);
#pragma unroll
              for (int ks = 0; ks < 4; ++ks)
#pragma unroll
                  for (int pt = 0; pt < 4; ++pt) pfr[ks][pt] = *(const GAS bf16x8*)(STT + ((size_t)h_ * 64 + 16 * pt + l15) * 128 + 32 * ks + 8 * lq);
#pragma unroll
              for (int i2 = 0; i2 < 2; ++i2)
#pragma unroll
                  for (int pt = 0; pt < 4; ++pt) zvr[i2][pt] = *(const GAS v2u*)(PR + (size_t)(t0 + 16 * (2 * half_ + i2) + l15) * PJ + D_Z + h_ * 64 + 16 * pt + 4 * lq);
              PIN_MEM(); }
            { const int i = 16 * itC + l15;
#pragma unroll
              for (int hh = 0; hh < 2; ++hh) { const int h = gC * 4 + 2 * rd + hh; const float ai = acl[i * 8 + h];
#pragma unroll
                  for (int jt = 0; jt < 4; ++jt) { float mv[4];
#pragma unroll
                      for (int r = 0; r < 4; ++r) { const int j = 16 * jt + 4 * lq + r; mv[r] = (j <= i) ? cbt[jt][r] * fexp(ai - acl[j * 8 + h]) * dtl[j * 8 + h] : 0.f; }
                      v2u o; o.x = pk2(mv[0], mv[1]); o.y = pk2(mv[2], mv[3]); *(LAS v2u*)(MM + ((gC * 2 + hh) * 64 + i) * MP + 16 * jt + 4 * lq) = o; } } }
            __syncthreads();
            { const int ms = w >> 1, half = w & 1, g = ms >> 1, h = g * 4 + 2 * rd + (ms & 1);
              f32x4 a1[4][2], a2[4][2];
#pragma unroll
              for (int pt = 0; pt < 4; ++pt)
#pragma unroll
                  for (int i2 = 0; i2 < 2; ++i2) { a1[pt][i2] = (f32x4){0.f, 0.f, 0.f, 0.f}; a2[pt][i2] = (f32x4){0.f, 0.f, 0.f, 0.f}; }
#pragma unroll
              for (int ks = 0; ks < 2; ++ks) { if (ks <= half) {
                  bf16x8 xf[4];
#pragma unroll
                  for (int pt = 0; pt < 4; ++pt) xf[pt] = tr_frag(XS + (32 * ks + 8 * lq + (l15 >> 2)) * XSP + h * 64 + 16 * pt + 4 * (l15 & 3), XSP);
#pragma unroll
                  for (int i2 = 0; i2 < 2; ++i2) { const bf16x8 yf = *(const LAS bf16x8*)(MM + (ms * 64 + 16 * (2 * half + i2) + l15) * MP + 32 * ks + 8 * lq);
#pragma unroll
                      for (int pt = 0; pt < 4; ++pt) a1[pt][i2] = mfma32(xf[pt], yf, a1[pt][i2]); } } }
#pragma unroll
              for (int ks = 0; ks < 4; ++ks) {
#pragma unroll
                  for (int i2 = 0; i2 < 2; ++i2) { const bf16x8 yf = *(const LAS bf16x8*)(CM + (16 * (2 * half + i2) + l15) * BMP + g * 128 + 32 * ks + 8 * lq);
#pragma unroll
                      for (int pt = 0; pt < 4; ++pt) a2[pt][i2] = mfma32(pfr[ks][pt], yf, a2[pt][i2]); } }
              const float Dh = a.in[I_DD][l * 8 + h];
#pragma unroll
              for (int i2 = 0; i2 < 2; ++i2) { const int i = 16 * (2 * half + i2) + l15; const float ea = fexp(acl[i * 8 + h]); float s2 = 0.f;
#pragma unroll
                  for (int pt = 0; pt < 4; ++pt) { const int ch = h * 64 + 16 * pt + 4 * lq;
                      const v2u xv = *(const LAS v2u*)(XS + i * XSP + ch); const v2u zv = zvr[i2][pt];
                      f32x4 y; y[0] = (a1[pt][i2][0] + ea * a2[pt][i2][0] + Dh * bflo(xv.x)) * silu(bflo(zv.x)); y[1] = (a1[pt][i2][1] + ea * a2[pt][i2][1] + Dh * bfhi(xv.x)) * silu(bfhi(zv.x));
                      y[2] = (a1[pt][i2][2] + ea * a2[pt][i2][2] + Dh * bflo(xv.y)) * silu(bflo(zv.y)); y[3] = (a1[pt][i2][3] + ea * a2[pt][i2][3] + Dh * bfhi(xv.y)) * silu(bfhi(zv.y));
                      if (rd == 0) yv[0][pt][i2] = y; else yv[1][pt][i2] = y;
                      s2 += (y[0] * y[0] + y[1] * y[1]) + (y[2] * y[2] + y[3] * y[3]); }
                  s2 += __shfl_xor(s2, 16); s2 += __shfl_xor(s2, 32);
                  if (lq == 0) ssq[i * 8 + h] = s2; } }
            __syncthreads();
        }
        { const int ms = w >> 1, half = w & 1, g = ms >> 1;
#pragma unroll
          for (int rd = 0; rd < 2; ++rd) { const int h = g * 4 + 2 * rd + (ms & 1);
#pragma unroll
              for (int i2 = 0; i2 < 2; ++i2) { const int i = 16 * (2 * half + i2) + l15; const LAS float* sq = ssq + i * 8;
                  const float rstd = frsq((((sq[0] + sq[1]) + (sq[2] + sq[3])) + ((sq[4] + sq[5]) + (sq[6] + sq[7]))) * (1.0f / 512.0f) + EPS);
#pragma unroll
                  for (int pt = 0; pt < 4; ++pt) { const int ch = h * 64 + 16 * pt + 4 * lq; const f32x4 nw = *(const GAS f32x4*)(a.in[I_DNW] + l * 512 + ch); const f32x4 y = yv[rd][pt][i2];
                      v2u o; o.x = pk2(y[0] * rstd * nw[0], y[1] * rstd * nw[1]); o.y = pk2(y[2] * rstd * nw[2], y[3] * rstd * nw[3]);
                      if (dry) asm volatile("" :: "v"(o.x), "v"(o.y)); else *(GAS v2u*)(PR + (size_t)(t0 + i) * PJ + D_Z + ch) = o; } } } }
    }
    __syncthreads();
}

__device__ __forceinline__ void scan_phase(const Args& a, int l, int vcu, int G, LAS unsigned char* lds) {
    const int tid = opaque_tid();
    LAS float* dl = (LAS float*)lds;
    for (int j = vcu; j < 202; j += G) {
        if (j < 192) {
            const bool isS = j < 128; const int jj = isS ? j : j - 128;
            const int b = isS ? (jj >> 6) : (jj >> 5), r0 = (isS ? (jj & 63) : (jj & 31)) * 1024, h = r0 >> 13, r = r0 + 2 * tid;
            if (isS) { if (tid < CPB) dl[tid] = ((const float*)(a.ws + WS_SDEC))[(size_t)(b * CPB + tid) * 8 + h]; }
            else { for (int i = tid; i < CPB * 64; i += NTHR) dl[i] = ((const float*)(a.ws + WS_GDEC))[(size_t)(b * CPB + (i >> 6)) * 256 + h * 64 + (i & 63)]; }
            const int cstride = isS ? 131072 : 65536;
            const __amdgpu_buffer_rsrc_t rs = __builtin_amdgcn_make_buffer_rsrc((void*)(a.ws + (isS ? WS_SSD : WS_GLA) + (size_t)b * CPB * cstride), (short)0, CPB * cstride, 0x00020000);
            __syncthreads();
            float s0 = 0.f, s1 = 0.f; const int d = r & 63;
#pragma unroll 1
            for (int n0 = 0; n0 < CPB; n0 += 64) { unsigned kv[64];
#pragma unroll
                for (int q = 0; q < 64; ++q) kv[q] = __builtin_amdgcn_raw_buffer_load_b32(rs, r * 2, (n0 + q) * cstride, 0);
                asm volatile("s_waitcnt vmcnt(0)" ::: "memory");
#pragma unroll
                for (int q = 0; q < 64; ++q) { float d0, d1; if (isS) { d0 = dl[n0 + q]; d1 = d0; } else { const f32x2 dd = *(const LAS f32x2*)(dl + (n0 + q) * 64 + d); d0 = dd.x; d1 = dd.y; }
                    __builtin_amdgcn_raw_buffer_store_b32(pk2(s0, s1), rs, r * 2, (n0 + q) * cstride, 0); s0 = d0 * s0 + bflo(kv[q]); s1 = d1 * s1 + bfhi(kv[q]);
                    if ((q & 15) == 15) PIN_MEM(); } }
            __syncthreads();
        } else if (j < 200) {
            const int e2 = (j - 192) * NTHR + tid, b = e2 >> 11, gn = e2 & 2047;
            const float* A64 = (const float*)(a.ws + WS_S5T + (size_t)l * S5T_LAYER + S5T_A64); const float ar = A64[gn * 2], ai = A64[gn * 2 + 1];
            f32x2* p = (f32x2*)(a.ws + WS_S5ST) + (size_t)b * CPB * 2048 + gn; float sr = 0.f, si = 0.f;
#pragma unroll 1
            for (int n0 = 0; n0 < CPB; n0 += 32) { f32x2 ev[32];
#pragma unroll
                for (int q = 0; q < 32; ++q) ev[q] = p[(size_t)(n0 + q) * 2048];
                asm volatile("s_waitcnt vmcnt(0)" ::: "memory");
#pragma unroll
                for (int q = 0; q < 32; ++q) { const f32x2 o = {sr, si}; p[(size_t)(n0 + q) * 2048] = o; const float nr = ar * sr - ai * si + ev[q].x, ni = ar * si + ai * sr + ev[q].y; sr = nr; si = ni; } }
        } else {
            const int e2 = (j - 200) * NTHR + tid, b = e2 >> 9, ch = e2 & 511;
            const f32x2* E = (const f32x2*)(a.ws + WS_LRUE) + (size_t)b * CPB * 512 + ch; float* H = (float*)(a.ws + WS_LRUH) + (size_t)b * CPB * 512 + ch; float hs = 0.f;
#pragma unroll 1
            for (int n0 = 0; n0 < CPB; n0 += 32) { f32x2 ev[32];
#pragma unroll
                for (int q = 0; q < 32; ++q) ev[q] = E[(size_t)(n0 + q) * 512];
#pragma unroll
                for (int q = 0; q < 32; ++q) { H[(size_t)(n0 + q) * 512] = hs; hs = ev[q].x * hs + ev[q].y; } }
        }
    }
}

__device__ __forceinline__ void final_norm(const Args& a, int vcu, int G) {
    const int tid = opaque_tid(), lane = tid & 63, wave = tid >> 6; const int gw = vcu * NWAVES + wave, NGW = G * NWAVES;
    const float* rowss = (const float*)(a.ws + WS_PART) + (size_t)DEPTH * T * 16;
    for (int m = gw; m < T; m += NGW) {
        float rsum = 0.f;
#pragma unroll
        for (int q = 0; q < 16; ++q) rsum += rowss[(size_t)m * 16 + q];
        const float rstd = 1.0f / sqrtf(rsum * (1.0f / 1024.0f) + EPS);
        const GAS v2u* xr = (const GAS v2u*)((const bf16*)(a.ws + WS_XBF) + (size_t)m * DM) + lane; GAS f32x4* orow = (GAS f32x4*)(a.out + (size_t)m * DM) + lane; const GAS f32x4* wr = (const GAS f32x4*)(a.in[I_NFW]) + lane;
        v2u xv[4];
#pragma unroll
        for (int j = 0; j < 4; ++j) xv[j] = xr[64 * j];
#pragma unroll
        for (int j = 0; j < 4; ++j) { const f32x4 w = wr[64 * j]; f32x4 v = (f32x4){bflo(xv[j].x), bfhi(xv[j].x), bflo(xv[j].y), bfhi(xv[j].y)}; v = v * rstd * w; orow[64 * j] = v; }
    }
}

#define XB_TMO      128
#define XB_XCNT(j)  (256  + 64 * (j))
#define XB_XSUB(j)  (1280 + 64 * (j))
#define XB_XGEN(j)  (2304 + 64 * (j))
#define XB_TOP      3328
#define XB_TOPGEN   3392
#define XCD_BAR_WORDS 3456
#define XB_SPIN_CAP (1u << 22)
__device__ __forceinline__ unsigned xb_ld(unsigned* p)              { return __hip_atomic_load(p, __ATOMIC_RELAXED, __HIP_MEMORY_SCOPE_AGENT); }
__device__ __forceinline__ unsigned xb_add(unsigned* p, unsigned v) { return __hip_atomic_fetch_add(p, v, __ATOMIC_RELAXED, __HIP_MEMORY_SCOPE_AGENT); }
__device__ __forceinline__ unsigned xb_xcc_id() { return (unsigned)__builtin_amdgcn_s_getreg((3 << 11) | 20) & 0xFu; }
#define XB_SPIN(cond, bar) do { unsigned _sp = 0; while (cond) { __builtin_amdgcn_s_sleep(1); \
    if ((++_sp & 255u) == 0u) { if (xb_ld(&(bar)[XB_TMO])) break; if (_sp > XB_SPIN_CAP) { atomicAdd(&(bar)[XB_TMO], 1u); break; } } } } while (0)
struct XcdBarrier { unsigned* bar; unsigned x; volatile LAS unsigned* st; };
__device__ __forceinline__ XcdBarrier xcd_barrier_post(unsigned* bar, volatile LAS unsigned* st) {
    XcdBarrier b; b.bar = bar; b.x = xb_xcc_id(); b.st = st;
    if (threadIdx.x == 0) (void)xb_add(&bar[XB_XCNT(b.x)], 1u);
    return b;
}
__device__ __forceinline__ void xcd_barrier_complete(unsigned* bar, unsigned x, unsigned& nloc, unsigned& nx) {
    const unsigned G = gridDim.x * gridDim.y * gridDim.z;
    unsigned sum, cnt, mine, sp = 0u;
    for (;;) {
        sum = 0u; cnt = 0u; mine = 0u;
#pragma unroll
        for (unsigned j = 0; j < 16; ++j) { const unsigned c = xb_ld(&bar[XB_XCNT(j)]); sum += c; cnt += (c > 0u) ? 1u : 0u; mine = (j == x) ? c : mine; }
        if (sum == G) break;
        __builtin_amdgcn_s_sleep(1);
        if ((++sp & 255u) == 0u) { if (xb_ld(&bar[XB_TMO])) break; if (sp > XB_SPIN_CAP) { atomicAdd(&bar[XB_TMO], 1u); break; } }
    }
    nloc = mine > 0u ? mine : 1u; nx = cnt > 0u ? cnt : 1u;
}
__device__ __forceinline__ void xcd_barrier(const XcdBarrier& b) {
    asm volatile("s_waitcnt vmcnt(0)" ::: "memory");
    __syncthreads();
    if (threadIdx.x == 0) {
        unsigned* bar = b.bar;
        __builtin_amdgcn_s_waitcnt(0);
        unsigned nloc = b.st[0], nx = b.st[1];
        if (nloc == 0u) { xcd_barrier_complete(bar, b.x, nloc, nx); b.st[0] = nloc; b.st[1] = nx; }
        const unsigned old = xb_add(&bar[XB_XSUB(b.x)], 1u);
        const unsigned gen = old / nloc;
        if (old + 1u == (gen + 1u) * nloc) {
            __builtin_amdgcn_fence(__ATOMIC_RELEASE, "agent");
            asm volatile("s_waitcnt vmcnt(0)" ::: "memory");
            const unsigned og = xb_add(&bar[XB_TOP], 1u);
            const unsigned tg = og / nx;
            if (og + 1u == (tg + 1u) * nx) xb_add(&bar[XB_TOPGEN], 1u);
            else XB_SPIN(xb_ld(&bar[XB_TOPGEN]) == tg, bar);
            __builtin_amdgcn_fence(__ATOMIC_ACQUIRE, "agent");
            xb_add(&bar[XB_XGEN(b.x)], 1u);
            asm volatile("s_waitcnt vmcnt(0)" ::: "memory");
        } else {
            XB_SPIN(xb_ld(&bar[XB_XGEN(b.x)]) == gen, bar);
            __builtin_amdgcn_fence(__ATOMIC_ACQUIRE, "agent");
            asm volatile("s_waitcnt vmcnt(0)" ::: "memory");
        }
    }
    __syncthreads();
}

constexpr int N_PHASES = 2 + 5 * DEPTH;
__global__ void __launch_bounds__(NTHR, 2) mega_fwd(Args args) {
    extern __shared__ __attribute__((aligned(16))) unsigned char lds_raw[];
    LAS unsigned char* lds = (LAS unsigned char*)lds_raw;
    const int G = gridDim.x, bx = blockIdx.x; const int vcu = (G % 8 == 0) ? (bx % 8) * (G / 8) + bx / 8 : bx;
    const int lo = args.ph_lo, hi = args.ph_hi;
    float* rowss = (float*)(args.ws + WS_PART);
    volatile LAS unsigned* bst = (volatile LAS unsigned*)(lds + LDS_BYTES - 64);
    if (threadIdx.x < 2) bst[threadIdx.x] = 0u;
    __syncthreads();
    XcdBarrier xbar = xcd_barrier_post((unsigned*)(args.ws + WS_CTL), bst);
    constexpr int N_EXTRA = PROBE_DUP == 0 ? 0 : (PROBE_DUP == 3 ? 4 : 1);
    for (int sq = lo; sq < hi + N_EXTRA; ++sq) {
        int ph = sq;
        if (PROBE_DUP == 1) ph = sq <= 1 ? sq : sq - 1;
        if (PROBE_DUP == 2) ph = sq <= 2 ? sq : sq - 1;
        if (PROBE_DUP == 3) ph = sq <= 4 ? sq : sq - 4;
        if (PROBE_DUP == 4) ph = sq <= 5 ? sq : sq - 1;
        if (PROBE_DUP == 5) ph = sq <= 0 ? sq : sq - 1;
        if (PROBE_DUP == 6) ph = sq <= N_PHASES - 1 ? sq : sq - 1;
        if (ph == 0) { if (DBG_MASK & 1) p0_prologue(args, lds, vcu, G); }
        else if (ph == N_PHASES - 1) { if (DBG_MASK & 256) final_norm(args, vcu, G); }
        else {
            const int l = (ph - 1) / 5, sub = (ph - 1) % 5;
            if (sub == 0) { if (DBG_MASK & 2) {
                pg8::Gemm g{(const bf16*)args.out, (const bf16*)(args.ws + WS_WIN) + (size_t)l * NPAD * DM, T, PJ, DM, DM, 512};
                pg8::StaticOrder S; S.init(T, PJ, G, bx);
                pg8::EpiProj E{(bf16*)(args.ws + WS_PROJ), (float*)(args.ws + WS_EX), rowss + (size_t)l * T * 16, PJ};
                pg8::gemm_phase<pg8::EpiProj, pg8::StaticOrder, true, true>(lds, g, S, E);
                for (int c = vcu; c < NCHUNK; c += G) ex_chunk(args, l, c); }
            } else if (sub == 1 || sub == 3) {
                const bool fin = (sub == 3);
                for (int c = vcu; c < NCHUNK; c += G) {
                    if (PROBE_MIX == 1 && !fin) lru_chunk(args, l, c, false, lds); if (PROBE_MIX == 9 && !fin) lru_chunk(args, l, c, false, lds, false, true); if (PROBE_MIX == 5 && fin) lru_chunk(args, l, c, true, lds, true);
                    if (fin) lru_out(args, l, c); else lru_chunk(args, l, c, false, lds);
                    if (PROBE_MIX == 2 && !fin) s5_chunk(args, l, c, false, lds); if (PROBE_MIX == 6 && fin) s5_chunk(args, l, c, true, lds, true);
                    s5_chunk(args, l, c, fin, lds);
                    if (PROBE_MIX == 3 && !fin) gla_chunk(args, l, c, false, lds); if (PROBE_MIX == 7 && fin) gla_chunk(args, l, c, true, lds, true);
                    gla_chunk(args, l, c, fin, lds);
                    if (PROBE_MIX == 4 && !fin) ssd_chunk(args, l, c, false, lds); if (PROBE_MIX == 8 && fin) ssd_chunk(args, l, c, true, lds, true);
                    ssd_chunk(args, l, c, fin, lds); }
            } else if (sub == 2) { if (DBG_MASK & 64) scan_phase(args, l, vcu, G, lds); }
            else if (DBG_MASK & 128) {
                pg8::Gemm g{(const bf16*)(args.ws + WS_PROJ), (const bf16*)(args.ws + WS_WOUT) + (size_t)l * DM * 2048, T, DM, 2048, PJ, 1280};
                pg8::StaticOrder S; S.init(T, DM, G, bx);
                pg8::EpiOut E{l == 0 ? args.in[I_X] : nullptr, (const bf16*)args.out, l == DEPTH - 1 ? (bf16*)(args.ws + WS_XBF) : (bf16*)args.out, rowss + (size_t)(l + 1) * T * 16};
                pg8::gemm_phase<pg8::EpiOut, pg8::StaticOrder, true, true>(lds, g, S, E);
            }
        }
        if (sq + 1 < hi + N_EXTRA) { xcd_barrier(xbar); }
    }
}

extern "C" void kernel_launch(void* const* d_in, const int* in_sizes, int n_in, void* d_out, int out_size, void* d_ws, size_t ws_size, hipStream_t stream) {
    static int grid = 0;
    if (grid == 0) {
        if (n_in != 31 || out_size != T * DM || ws_size < WS_END) { fprintf(stderr, "kernel_launch: unexpected shapes (n_in %d out %d ws %zu need %zu)\n", n_in, out_size, ws_size, (size_t)WS_END); grid = -1; return; }
        int dev = 0, cus = 0, per_cu = 0;
        if (hipGetDevice(&dev) != hipSuccess || hipDeviceGetAttribute(&cus, hipDeviceAttributeMultiprocessorCount, dev) != hipSuccess) { grid = -1; return; }
        if (hipFuncSetAttribute((const void*)mega_fwd, hipFuncAttributeMaxDynamicSharedMemorySize, LDS_BYTES) != hipSuccess) { fprintf(stderr, "kernel_launch: hipFuncSetAttribute failed\n"); grid = -1; return; }
        if (hipOccupancyMaxActiveBlocksPerMultiprocessor(&per_cu, (const void*)mega_fwd, NTHR, LDS_BYTES) != hipSuccess || per_cu < 1) { fprintf(stderr, "kernel_launch: occupancy query says %d blocks/CU\n", per_cu); (void)hipGetLastError(); per_cu = 1; }
        grid = cus;
        fprintf(stderr, "kernel_launch: grid %d (per_cu %d)\n", grid, per_cu);
    }
    if (grid < 0) return;
    (void)hipMemsetAsync((char*)d_ws + WS_CTL, 0, CTL_ZERO_BYTES, stream);
    Args a{};
    for (int i = 0; i < 31; ++i) a.in[i] = (const float*)d_in[i];
    a.out = (float*)d_out; a.ws = (unsigned char*)d_ws;
#if MK_PER_PHASE
    for (int ph = 0; ph < N_PHASES; ++ph) { a.ph_lo = ph; a.ph_hi = ph + 1; hipLaunchKernelGGL(mega_fwd, dim3(grid), dim3(NTHR), LDS_BYTES, stream, a); }
#else
    a.ph_lo = 0; a.ph_hi = N_PHASES;
    void* kargs[] = {&a};
    hipError_t e = hipLaunchCooperativeKernel((const void*)mega_fwd, dim3(grid), dim3(NTHR), kargs, LDS_BYTES, stream);
    if (e != hipSuccess) fprintf(stderr, "kernel_launch: cooperative launch failed: %s\n", hipGetErrorString(e));
#endif
}
```

```cpp
#include <hip/hip_runtime.h>
#include <hip/hip_cooperative_groups.h>
#include <cstdio>
#include <cstdint>
namespace cg = cooperative_groups;

#ifndef DBG_MASK
#define DBG_MASK 0xFFF
#endif
#ifndef PROBE_DUP
#define PROBE_DUP 0
#endif
#ifndef PROBE_MIX
#define PROBE_MIX 0
#endif
#ifndef MK_PER_PHASE
#define MK_PER_PHASE 0
#endif

namespace pg8 {
#define PG8_LAS __attribute__((address_space(3)))
typedef unsigned short bf16_t;
typedef short bf16x8 __attribute__((ext_vector_type(8)));
typedef float f32x4 __attribute__((ext_vector_type(4)));
typedef unsigned u32x4 __attribute__((ext_vector_type(4)));
typedef unsigned u32x2 __attribute__((ext_vector_type(2)));
constexpr int BM = 256, BK = 64, HALF = 128, HTB = HALF * BK * 2, STAGE_BYTES = 8 * HTB, NXCD = 8, WGM = 8;

__host__ __device__ __forceinline__ int lds_byte(int r, int c) { const int st = (r >> 4) * 2 + (c >> 5), rr = r & 15, cc = c & 31, ob = rr * 64 + cc * 2; return st * 1024 + (ob ^ (((ob >> 9) & 1) << 5)); }
__host__ __device__ __forceinline__ void stage_rc(int b, int& R, int& C) { const int st = b / 1024, sb = b % 1024, swz = sb ^ (((sb >> 9) & 1) << 5); R = (st >> 1) * 16 + swz / 64; C = (st & 1) * 32 + (swz % 64) / 2; }
__host__ __device__ __forceinline__ int perm32(int rho) { const int n = rho >> 4, i = rho & 15; return 8 * (i >> 2) + 4 * n + (i & 3); }

struct Unit { int pm, pn; };
struct Gemm { const bf16_t* A; const bf16_t* Bt; int M, N, K, lda, segcols; };

struct StaticOrder {
    int nM, nN, nwg, G, c;
    __host__ __device__ void init(int M, int N, int G_, int c_) { nM = M / BM; nN = N / BM; nwg = nM * nN; G = G_; c = c_; }
    __host__ __device__ bool next(int i, Unit& u) const {
        const long L = (long)i * G + c; if (L >= nwg) return false;
        int wgid = (int)L; { const int q = nwg / NXCD, r = nwg % NXCD, xcd = wgid % NXCD, off = wgid / NXCD; wgid = (xcd < r ? xcd * (q + 1) : r * (q + 1) + (xcd - r) * q) + off; }
        const int nig = WGM * nN, gid = wgid / nig, fm = gid * WGM, gsz = (nM - fm) < WGM ? (nM - fm) : WGM;
        u.pm = fm + ((wgid % nig) % gsz); u.pn = (wgid % nig) / gsz; return true;
    }
};

__device__ __forceinline__ unsigned cvt_pk_bf16(float lo, float hi) { unsigned r; asm volatile("v_cvt_pk_bf16_f32 %0, %1, %2" : "=v"(r) : "v"(lo), "v"(hi)); return r; }

struct EpiProj {
    static constexpr bool PERM = true, PRELOAD = false;
    bf16_t* P; float* EX; const float* rowss; int pj;
    const PG8_LAS float* rs_lds; int rs_pm;
    __device__ __forceinline__ void operator()(const f32x4 (&acc)[2][2][4][2], const Unit& u, int wr, int wc, int fr, int fq) const {
        const int row0 = u.pm * BM + wr * 64 + fr;
#pragma unroll
        for (int ai = 0; ai < 2; ++ai)
#pragma unroll
            for (int m = 0; m < 4; ++m) {
                const int row = row0 + ai * HALF + m * 16;
                float rstd;
                if (u.pm == rs_pm) rstd = rs_lds[wr * 64 + fr + ai * HALF + m * 16];
                else {
                const f32x4* pp = (const f32x4*)(rowss + (size_t)row * 16); const f32x4 p0 = pp[0], p1 = pp[1], p2 = pp[2], p3 = pp[3];
                const float rsum = (((p0[0] + p0[1]) + (p0[2] + p0[3])) + ((p1[0] + p1[1]) + (p1[2] + p1[3]))) + (((p2[0] + p2[1]) + (p2[2] + p2[3])) + ((p3[0] + p3[1]) + (p3[2] + p3[3])));
                rstd = 1.0f / sqrtf(rsum * (1.0f / 1024.0f) + 1e-6f); }
                if (u.pn < 20) {
                    bf16_t* rowp = P + (size_t)row * pj + u.pn * BM + wc * 32 + 8 * fq;
#pragma unroll
                    for (int bj = 0; bj < 2; ++bj) { const f32x4 v0 = acc[ai][bj][m][0] * rstd, v1 = acc[ai][bj][m][1] * rstd;
                        u32x4 w; w.x = cvt_pk_bf16(v0[0], v0[1]); w.y = cvt_pk_bf16(v0[2], v0[3]); w.z = cvt_pk_bf16(v1[0], v1[1]); w.w = cvt_pk_bf16(v1[2], v1[3]);
                        *(u32x4*)(rowp + bj * HALF) = w; }
                } else if (wc == 0) {
                    float* ep = EX + (size_t)row * 32 + 8 * fq;
                    *(f32x4*)(ep) = acc[ai][0][m][0] * rstd; *(f32x4*)(ep + 4) = acc[ai][0][m][1] * rstd;
                }
            }
    }
};
struct EpiOut {
    static constexpr bool PERM = false, PRELOAD = true;
    const float* Xf; const bf16_t* XBin; bf16_t* XBout; float* rowss_next;
    __device__ __forceinline__ void preload(f32x4 (&acc)[2][2][4][2], u32x2 (&xr)[2][2][4][2], const Unit& u, int wr, int wc, int fr, int fq) const {
        const int row0 = u.pm * BM + wr * 64 + fr, col0 = u.pn * BM + wc * 32 + 4 * fq;
#pragma unroll
        for (int ai = 0; ai < 2; ++ai)
#pragma unroll
            for (int bj = 0; bj < 2; ++bj)
#pragma unroll
                for (int m = 0; m < 4; ++m)
#pragma unroll
                    for (int n = 0; n < 2; ++n) { const size_t off = (size_t)(row0 + ai * HALF + m * 16) * 1024 + col0 + bj * HALF + n * 16;
                        xr[ai][bj][m][n] = *(const u32x2*)(XBin + off); }
    }
    __device__ __forceinline__ void reinit(f32x4 (&acc)[2][2][4][2], const Unit& u, int wr, int wc, int fr, int fq) const {
        const int row0 = u.pm * BM + wr * 64 + fr, col0 = u.pn * BM + wc * 32 + 4 * fq;
#pragma unroll
        for (int ai = 0; ai < 2; ++ai)
#pragma unroll
            for (int bj = 0; bj < 2; ++bj)
#pragma unroll
                for (int m = 0; m < 4; ++m)
#pragma unroll
                    for (int n = 0; n < 2; ++n) { const u32x2 w = *(const u32x2*)(XBin + (size_t)(row0 + ai * HALF + m * 16) * 1024 + col0 + bj * HALF + n * 16);
                        acc[ai][bj][m][n] = (f32x4){__builtin_bit_cast(float, w.x << 16), __builtin_bit_cast(float, w.x & 0xffff0000u), __builtin_bit_cast(float, w.y << 16), __builtin_bit_cast(float, w.y & 0xffff0000u)}; }
    }
    __device__ __forceinline__ void expand(f32x4 (&acc)[2][2][4][2], const u32x2 (&xr)[2][2][4][2]) const {
#pragma unroll
        for (int ai = 0; ai < 2; ++ai)
#pragma unroll
            for (int bj = 0; bj < 2; ++bj)
#pragma unroll
                for (int m = 0; m < 4; ++m)
#pragma unroll
                    for (int n = 0; n < 2; ++n) { const u32x2 w = xr[ai][bj][m][n];
                        acc[ai][bj][m][n] = (f32x4){__builtin_bit_cast(float, w.x << 16), __builtin_bit_cast(float, w.x & 0xffff0000u), __builtin_bit_cast(float, w.y << 16), __builtin_bit_cast(float, w.y & 0xffff0000u)}; }
    }
    __device__ __forceinline__ void operator()(const f32x4 (&acc)[2][2][4][2], const Unit& u, int wr, int wc, int fr, int fq) const {
        const int row0 = u.pm * BM + wr * 64 + fr, col0 = u.pn * BM + wc * 32 + 4 * fq;
#pragma unroll
        for (int ai = 0; ai < 2; ++ai)
#pragma unroll
            for (int mm = 0; mm < 4; ++mm) {
                const int row = row0 + ai * HALF + mm * 16; float ss = 0.f;
#pragma unroll
                for (int bj = 0; bj < 2; ++bj)
#pragma unroll
                    for (int n = 0; n < 2; ++n) { const size_t off = (size_t)row * 1024 + col0 + bj * HALF + n * 16;
                        const f32x4 xn = acc[ai][bj][mm][n];
                        u32x2 w; w.x = cvt_pk_bf16(xn[0], xn[1]); w.y = cvt_pk_bf16(xn[2], xn[3]); *(u32x2*)(XBout + off) = w;
                        ss += (xn[0] * xn[0] + xn[1] * xn[1]) + (xn[2] * xn[2] + xn[3] * xn[3]); }
                ss += __shfl_xor(ss, 16); ss += __shfl_xor(ss, 32);
                if (fq == 0) rowss_next[(size_t)row * 16 + u.pn * 4 + wc] = ss;
            }
    }
};

__device__ __forceinline__ int opaque_tid() { int t = threadIdx.x; asm volatile("" : "+v"(t)); return t; }
template <class Epi, class Sched, bool ALIGN_EPI = false, bool SP2 = false>
__device__ __forceinline__ void gemm_phase(PG8_LAS unsigned char* lds, const Gemm g, const Sched& S, const Epi& E) {
    const int tid = opaque_tid(), wid = __builtin_amdgcn_readfirstlane(tid >> 6), lane = tid & 63, wr = wid >> 2, wc = wid & 3, fr = lane & 15, fq = lane >> 4;
    const int K = g.K, nt = K / BK, lda = g.lda;
    unsigned voffA[2], voffB[2];
#pragma unroll
    for (int i = 0; i < 2; ++i) { int R, C; stage_rc(tid * 16 + i * 8192, R, C); const int Rb = Epi::PERM ? ((R & ~31) + perm32(R & 31)) : R;
        voffA[i] = (unsigned)(R * lda + C) * 2u; voffB[i] = (unsigned)(Rb * K + C) * 2u; }
    const size_t kstep = (size_t)(BK * 2);
    const size_t segB = (size_t)g.segcols * 2;
    const size_t hstepA = (size_t)HALF * lda * 2, hstepB = (size_t)HALF * K * 2;
    const size_t tstepA = 2 * hstepA, tstepB = 2 * hstepB;
    const unsigned ldsw = (unsigned)wid * 1024u;
    const int aoff = lds_byte(wr * 64 + fr, fq * 8), boff = lds_byte(wc * 32 + fr, fq * 8);
#define PG8_KA(t) ((size_t)((t) >> 3) * segB + (size_t)((t) & 7) * kstep)
#define PG8_SA(b, h) (((b) * 2 + (h)) * HTB)
#define PG8_SB(b, h) ((4 + (b) * 2 + (h)) * HTB)
#define PG8_STAGE(bufoff, gbase, voff) do { _Pragma("unroll") for (int _i = 0; _i < 2; ++_i) \
        __builtin_amdgcn_global_load_lds((const unsigned*)((const char*)(gbase) + (voff)[_i]), (PG8_LAS unsigned*)(lds + (bufoff) + ldsw + _i * 8192), 16, 0, 0); } while (0)
#define PG8_LDA(dst, b, h) do { _Pragma("unroll") for (int m = 0; m < 4; ++m) _Pragma("unroll") for (int k = 0; k < 2; ++k) dst[m][k] = *(const PG8_LAS bf16x8*)(lds + PG8_SA(b, h) + aoff + m * 2048 + k * 1024); } while (0)
#define PG8_LDB(dst, b, h) do { _Pragma("unroll") for (int n = 0; n < 2; ++n) _Pragma("unroll") for (int k = 0; k < 2; ++k) dst[n][k] = *(const PG8_LAS bf16x8*)(lds + PG8_SB(b, h) + boff + n * 2048 + k * 1024); } while (0)
#define PG8_MMA(ai, bj, At, Bt) do { __builtin_amdgcn_s_setprio(1); _Pragma("unroll") for (int m = 0; m < 4; ++m) _Pragma("unroll") for (int n = 0; n < 2; ++n) _Pragma("unroll") for (int k = 0; k < 2; ++k) \
        acc[ai][bj][m][n] = __builtin_amdgcn_mfma_f32_16x16x32_bf16(Bt[n][k], At[m][k], acc[ai][bj][m][n], 0, 0, 0); __builtin_amdgcn_s_setprio(0); } while (0)
#define PG8_WAIT_V(n) asm volatile("s_waitcnt vmcnt(" #n ")" ::: "memory")
#define PG8_WAIT_L(n) asm volatile("s_waitcnt lgkmcnt(" #n ")" ::: "memory")
#define PG8_BAR __builtin_amdgcn_s_barrier()
#define PG8_SCHED __builtin_amdgcn_sched_barrier(0)
    Unit cur, nxt; int ui = 0;
    if (!S.next(0, cur)) return;
    f32x4 acc[2][2][4][2];
#pragma unroll
    for (int a = 0; a < 2; ++a)
#pragma unroll
        for (int b = 0; b < 2; ++b)
#pragma unroll
            for (int m = 0; m < 4; ++m)
#pragma unroll
                for (int n = 0; n < 2; ++n) acc[a][b][m][n] = (f32x4){0.f, 0.f, 0.f, 0.f};
    bf16x8 At[4][2], B0[2][2], B1[2][2];
    const char* cA = (const char*)g.A + (size_t)cur.pm * tstepA; const char* cB = (const char*)g.Bt + (size_t)cur.pn * tstepB;
    if constexpr (SP2) {
        u32x2 xr[2][2][4][2];
        if constexpr (Epi::PRELOAD) E.preload(acc, xr, cur, wr, wc, fr, fq);
        PG8_STAGE(PG8_SB(0, 0), cB, voffB); PG8_STAGE(PG8_SB(0, 1), cB + hstepB, voffB); PG8_STAGE(PG8_SA(0, 0), cA, voffA); PG8_STAGE(PG8_SA(0, 1), cA + hstepA, voffA);
        if (wr == 1) PG8_BAR;
        PG8_WAIT_V(2); PG8_BAR;
        if constexpr (Epi::PRELOAD) E.expand(acc, xr);
        PG8_STAGE(PG8_SB(1, 0), cB + kstep, voffB); PG8_STAGE(PG8_SA(1, 0), cA + kstep, voffA); PG8_STAGE(PG8_SB(1, 1), cB + hstepB + kstep, voffB);
        PG8_WAIT_V(6); PG8_BAR;
    } else {
        PG8_STAGE(PG8_SB(0, 0), cB, voffB); PG8_STAGE(PG8_SA(0, 0), cA, voffA); PG8_STAGE(PG8_SB(0, 1), cB + hstepB, voffB); PG8_STAGE(PG8_SA(0, 1), cA + hstepA, voffA);
        if (wr == 1) PG8_BAR;
        PG8_WAIT_V(4); PG8_BAR;
        PG8_STAGE(PG8_SB(1, 0), cB + kstep, voffB); PG8_STAGE(PG8_SA(1, 0), cA + kstep, voffA); PG8_STAGE(PG8_SB(1, 1), cB + hstepB + kstep, voffB);
        PG8_WAIT_V(6); PG8_BAR;
    }
    for (;;) {
        const bool has_next = S.next(ui + 1, nxt);
        const char* nA = has_next ? (const char*)g.A + (size_t)nxt.pm * tstepA : cA; const char* nB = has_next ? (const char*)g.Bt + (size_t)nxt.pn * tstepB : cB;
        for (int t = 0; t < nt; t += 2) {
            const bool last = (t == nt - 2);
            const char* a1 = cA + PG8_KA(t + 1);
            const char* a2 = last ? nA : cA + PG8_KA(t + 2); const char* b2 = last ? nB : cB + (size_t)(t + 2) * kstep;
            const char* a3 = a2 + kstep; const char* b3 = b2 + kstep;
            if constexpr (SP2) {
            PG8_LDB(B0, 0, 0); PG8_LDB(B1, 0, 1); PG8_SCHED; PG8_LDA(At, 0, 0); PG8_STAGE(PG8_SA(1, 1), a1 + hstepA, voffA);
            PG8_WAIT_V(8); PG8_WAIT_L(0); PG8_BAR; PG8_MMA(0, 0, At, B0); PG8_MMA(0, 1, At, B1); PG8_BAR; PG8_SCHED;
            PG8_LDA(At, 0, 1); PG8_STAGE(PG8_SB(0, 0), b2, voffB); PG8_STAGE(PG8_SB(0, 1), b2 + hstepB, voffB); PG8_STAGE(PG8_SA(0, 0), a2, voffA);
            PG8_WAIT_V(8); PG8_WAIT_L(0); PG8_BAR; PG8_MMA(1, 0, At, B0); PG8_MMA(1, 1, At, B1); PG8_BAR; PG8_SCHED;
            PG8_LDB(B0, 1, 0); PG8_LDB(B1, 1, 1); PG8_SCHED; PG8_LDA(At, 1, 0); PG8_STAGE(PG8_SA(0, 1), a2 + hstepA, voffA);
            PG8_WAIT_V(8); PG8_WAIT_L(0); PG8_BAR; PG8_MMA(0, 0, At, B0); PG8_MMA(0, 1, At, B1); PG8_BAR; PG8_SCHED;
            PG8_LDA(At, 1, 1); PG8_STAGE(PG8_SB(1, 0), b3, voffB); PG8_STAGE(PG8_SB(1, 1), b3 + hstepB, voffB); PG8_STAGE(PG8_SA(1, 0), a3, voffA);
            PG8_WAIT_V(8); PG8_WAIT_L(0); PG8_BAR; PG8_MMA(1, 0, At, B0); PG8_MMA(1, 1, At, B1); PG8_BAR; PG8_SCHED;
            } else {
            PG8_LDB(B0, 0, 0); PG8_SCHED; PG8_LDA(At, 0, 0); PG8_STAGE(PG8_SA(1, 1), a1 + hstepA, voffA);
            PG8_WAIT_L(8); PG8_BAR; PG8_WAIT_L(0); PG8_MMA(0, 0, At, B0); PG8_BAR; PG8_SCHED;
            PG8_LDB(B1, 0, 1); PG8_STAGE(PG8_SB(0, 0), b2, voffB);
            PG8_BAR; PG8_WAIT_L(0); PG8_MMA(0, 1, At, B1); PG8_BAR;
            PG8_LDA(At, 0, 1); PG8_STAGE(PG8_SA(0, 0), a2, voffA);
            PG8_BAR; PG8_WAIT_L(0); PG8_MMA(1, 0, At, B0); PG8_BAR; PG8_SCHED;
            PG8_STAGE(PG8_SB(0, 1), b2 + hstepB, voffB);
            PG8_WAIT_V(6); PG8_BAR; PG8_MMA(1, 1, At, B1); PG8_BAR;
            PG8_LDB(B0, 1, 0); PG8_SCHED; PG8_LDA(At, 1, 0); PG8_STAGE(PG8_SA(0, 1), a2 + hstepA, voffA);
            PG8_WAIT_L(8); PG8_BAR; PG8_WAIT_L(0); PG8_MMA(0, 0, At, B0); PG8_BAR; PG8_SCHED;
            PG8_LDB(B1, 1, 1); PG8_STAGE(PG8_SB(1, 0), b3, voffB);
            PG8_BAR; PG8_WAIT_L(0); PG8_MMA(0, 1, At, B1); PG8_BAR;
            PG8_LDA(At, 1, 1); PG8_STAGE(PG8_SA(1, 0), a3, voffA);
            PG8_BAR; PG8_WAIT_L(0); PG8_MMA(1, 0, At, B0); PG8_BAR; PG8_SCHED;
            PG8_STAGE(PG8_SB(1, 1), b3 + hstepB, voffB);
            PG8_WAIT_V(6); PG8_BAR; PG8_MMA(1, 1, At, B1); PG8_BAR;
            }
        }
        if constexpr (ALIGN_EPI) { if (wr == 0) PG8_BAR; }
        E(acc, cur, wr, wc, fr, fq);
        if (!has_next) break;
        if constexpr (Epi::PRELOAD) E.reinit(acc, nxt, wr, wc, fr, fq);
        else {
#pragma unroll
        for (int a = 0; a < 2; ++a)
#pragma unroll
            for (int b = 0; b < 2; ++b)
#pragma unroll
                for (int m = 0; m < 4; ++m)
#pragma unroll
                    for (int n = 0; n < 2; ++n) acc[a][b][m][n] = (f32x4){0.f, 0.f, 0.f, 0.f};
        }
        cur = nxt; cA = nA; cB = nB; ++ui;
        if constexpr (ALIGN_EPI) { if (wr == 1) PG8_BAR; }
    }
    PG8_WAIT_V(0);
    if constexpr (!ALIGN_EPI) { if (wr == 0) PG8_BAR; }
    PG8_BAR;
#undef PG8_KA
#undef PG8_SA
#undef PG8_SB
#undef PG8_STAGE
#undef PG8_LDA
#undef PG8_LDB
#undef PG8_MMA
#undef PG8_WAIT_V
#undef PG8_WAIT_L
#undef PG8_BAR
#undef PG8_SCHED
}
}

constexpr int NWAVES = 8, NTHR = 512;
constexpr int DM = 1024, BATCH = 2, SEQ = 8192, DEPTH = 4, T = BATCH * SEQ;
constexpr int DIN = 5144, PJ = 5120, NPAD = 5152, NCHUNK = T / 64, CPB = SEQ / 64;
constexpr float EPS = 1e-6f;
constexpr int A_Z = 0, A_X = 512, C_Q = 1024, B_Z = 1280, B_U = 1792, C_K = 2304, C_Z = 2560, C_V = 3072, D_CM = 3584, D_Z = 3840, D_XS = 4352, D_BM = 4864;
constexpr int O_AX = 0, O_AZ = 512, O_BU = 1024, O_BZ = 1536, O_CQ = 2048, O_CK = 2304, O_CV = 2560, O_CZ = 3072, O_CG = 3584, O_DZ = 3600, O_DXBC = 4112, O_DDT = 5136;
__host__ __device__ __forceinline__ int orig_col(int j) {
    if (j < 512) return O_AZ + j;
    if (j < 1024) return O_AX + (j - 512);
    if (j < 1280) return O_CQ + (j - 1024);
    if (j < 1792) return O_BZ + (j - 1280);
    if (j < 2304) return O_BU + (j - 1792);
    if (j < 2560) return O_CK + (j - 2304);
    if (j < 3072) return O_CZ + (j - 2560);
    if (j < 3584) return O_CV + (j - 3072);
    if (j < 3840) return O_DXBC + 768 + (j - 3584);
    if (j < 4352) return O_DZ + (j - 3840);
    if (j < 4864) return O_DXBC + (j - 4352);
    if (j < 5120) return O_DXBC + 512 + (j - 4864);
    if (j < 5136) return O_CG + (j - 5120);
    if (j < 5144) return O_DDT + (j - 5136);
    return -1;
}
constexpr size_t MiB = 1u << 20;
constexpr size_t WS_CTL = 0, CTL_ZERO_BYTES = 1 * MiB;
constexpr size_t CTL_ROWSS = 512 * 1024;
constexpr size_t WS_WIN = 1 * MiB;
constexpr size_t WS_WOUT = 43 * MiB;
constexpr size_t WS_S5T = 59 * MiB;
constexpr size_t WS_PROJ = 75 * MiB;
constexpr size_t WS_EX = 235 * MiB;
constexpr size_t WS_GLA = 237 * MiB;
constexpr size_t WS_SSD = 253 * MiB;
constexpr size_t WS_XBF = WS_SSD;
constexpr size_t WS_S5ST = 285 * MiB;
constexpr size_t WS_LRUE = 289 * MiB;
constexpr size_t WS_LRUH = 290 * MiB;
constexpr size_t WS_GDEC = 291 * MiB;
constexpr size_t WS_SDEC = 292 * MiB;
constexpr size_t WS_PART = 293 * MiB;
constexpr size_t WS_GLUT = 298 * MiB;
constexpr size_t WS_LRW = 300 * MiB;
constexpr size_t WS_END = 301 * MiB;
constexpr size_t S5T_AB = 0;
constexpr size_t S5T_A64 = 16384;
constexpr size_t S5T_BC = 65536;
constexpr size_t S5T_CC = 196608;
constexpr size_t S5T_PW = 327680;
constexpr size_t S5T_KT = 1048576;
constexpr size_t S5T_LAYER = 4 * MiB;

constexpr int LDS_BYTES = 155648;

#define GAS __attribute__((address_space(1)))
#define LAS __attribute__((address_space(3)))
typedef unsigned short bf16;
typedef unsigned v4u __attribute__((ext_vector_type(4)));
typedef float f32x4 __attribute__((ext_vector_type(4)));

__device__ __forceinline__ unsigned f2bf(float f) { unsigned u = __builtin_bit_cast(unsigned, f); return (u + 0x7fffu + ((u >> 16) & 1u)) >> 16; }
__device__ __forceinline__ unsigned pk2(float lo, float hi) { return f2bf(lo) | (f2bf(hi) << 16); }
__device__ __forceinline__ float bf2f(unsigned h) { return __builtin_bit_cast(float, (h & 0xffffu) << 16); }
__device__ __forceinline__ float bflo(unsigned w) { return __builtin_bit_cast(float, w << 16); }
__device__ __forceinline__ float bfhi(unsigned w) { return __builtin_bit_cast(float, w & 0xffff0000u); }
__device__ __forceinline__ float fexp(float x) { return __builtin_amdgcn_exp2f(x * 1.4426950408889634f); }
__device__ __forceinline__ float frcp(float x) { return __builtin_amdgcn_rcpf(x); }
__device__ __forceinline__ float sigm(float x) { return frcp(1.0f + fexp(-x)); }
__device__ __forceinline__ float silu(float x) { return x * frcp(1.0f + fexp(-x)); }
__device__ __forceinline__ float softplus(float x) { return fmaxf(x, 0.f) + __builtin_amdgcn_logf(1.0f + fexp(-fabsf(x))) * 0.6931471805599453f; }
__device__ __forceinline__ float gelu_tanh(float x) { const float u = 0.7978845608028654f * (x + 0.044715f * x * x * x); return x * frcp(1.0f + fexp(-2.0f * u)); }
__device__ __forceinline__ float neg_expm1(float x) { const float s = -x * (1.0f + x * (0.5f + x * (0.16666667f + x * 0.041666668f))); const float d = 1.0f - fexp(x); return fabsf(x) < 0.03f ? s : d; }
__device__ __forceinline__ float fsqrt(float x) { return __builtin_amdgcn_sqrtf(x); }
__device__ __forceinline__ float frsq(float x) { return __builtin_amdgcn_rsqf(x); }
__device__ __forceinline__ float wave_sum(float v) {
#pragma unroll
    for (int o = 1; o < 64; o <<= 1) v += __shfl_xor(v, o);
    return v;
}

__device__ __forceinline__ int opaque_tid() { int t = threadIdx.x; asm volatile("" : "+v"(t)); return t; }
typedef short bf16x8 __attribute__((ext_vector_type(8)));
typedef short bf16x4 __attribute__((ext_vector_type(4)));
typedef float f32x2 __attribute__((ext_vector_type(2)));
typedef unsigned v2u __attribute__((ext_vector_type(2)));
__device__ __forceinline__ f32x4 mfma32(bf16x8 x, bf16x8 y, f32x4 c) { return __builtin_amdgcn_mfma_f32_16x16x32_bf16(x, y, c, 0, 0, 0); }
__device__ __forceinline__ f32x4 mfma16(bf16x4 x, bf16x4 y, f32x4 c) { return __builtin_amdgcn_mfma_f32_16x16x16bf16_1k(x, y, c, 0, 0, 0); }
typedef short v4i16_t __attribute__((ext_vector_type(4)));
__device__ __forceinline__ bf16x8 tr_frag(const LAS bf16* p, int pitch) {
    const v4i16_t x = __builtin_amdgcn_ds_read_tr16_b64_v4i16((LAS v4i16_t*)p), y = __builtin_amdgcn_ds_read_tr16_b64_v4i16((LAS v4i16_t*)(p + 4 * pitch));
    return (bf16x8){x[0], x[1], x[2], x[3], y[0], y[1], y[2], y[3]};
}
#define PIN_MEM() asm volatile("" ::: "memory")
struct Args { const float* in[31]; float* out; unsigned char* ws; int ph_lo, ph_hi; };
enum { I_X = 0, I_NORMW, I_WIN, I_LCW, I_LCB, I_LWR, I_LBR, I_LWI, I_LBI, I_LL, I_SLR, I_SLI, I_SLDT, I_SBR, I_SBI, I_SCR, I_SCI, I_SD, I_SGW, I_SGB,
       I_GWG, I_GBG, I_GNW, I_DCW, I_DCB, I_DDTB, I_DALOG, I_DD, I_DNW, I_WOUT, I_NFW };

template <bool MAPPED>
__device__ __forceinline__ void p0_transpose_item(const float* W, int K, int ldw, int nblk, const float* kscale, bf16* WT, LAS float* scr, int item, int lane) {
    const int kb = item / nblk, nb = item % nblk, k0 = 64 * kb, n0 = 32 * nb;
    const int myc = n0 + (lane & 31); const int oc = MAPPED ? orig_col(myc) : myc;
    const int c = lane & 7; float ksc[8];
    { float vv[32]; const int occ = oc >= 0 ? oc : 0;
#pragma unroll
      for (int i = 0; i < 32; ++i) { const int kk = 2 * i + (lane >> 5); vv[i] = W[(size_t)(k0 + kk) * ldw + occ]; }
#pragma unroll
      for (int q = 0; q < 8; ++q) ksc[q] = kscale ? kscale[k0 + 8 * c + q] : 1.0f;
      PIN_MEM();
#pragma unroll
      for (int i = 0; i < 32; ++i) { const int kk = 2 * i + (lane >> 5); scr[kk * 33 + (lane & 31)] = oc >= 0 ? vv[i] : 0.f; } }
    asm volatile("s_waitcnt lgkmcnt(0)" ::: "memory");
#pragma unroll
    for (int j = 0; j < 4; ++j) { const int n = (lane >> 3) + 8 * j; const LAS float* s = scr + (8 * c) * 33 + n;
        v4u o; o.x = pk2(s[0 * 33] * ksc[0], s[1 * 33] * ksc[1]); o.y = pk2(s[2 * 33] * ksc[2], s[3 * 33] * ksc[3]); o.z = pk2(s[4 * 33] * ksc[4], s[5 * 33] * ksc[5]); o.w = pk2(s[6 * 33] * ksc[6], s[7 * 33] * ksc[7]);
        *(GAS v4u*)(WT + (size_t)(n0 + n) * K + k0 + 8 * c) = o; }
    asm volatile("s_waitcnt lgkmcnt(0)" ::: "memory");
}

__device__ __forceinline__ void p0_s5_tables(const Args& a, LAS unsigned char* lds, int item) {
    const int tid = opaque_tid(); const int l = item >> 6, g = (item >> 1) & 31, dh = item & 1;
    LAS f32x2* P = (LAS f32x2*)lds;
    LAS f32x2* BL = P + 32 * 64;
    LAS f32x2* CL = BL + 64 * 16;
    unsigned char* tb = a.ws + WS_S5T + (size_t)l * S5T_LAYER;
    const float dt = expf(a.in[I_SLDT][l * 32 + g]);
    const float* LR = a.in[I_SLR] + l * 2048 + g * 64; const float* LI = a.in[I_SLI] + l * 2048 + g * 64;
    for (int idx = tid; idx < 2048; idx += NTHR) { const int dd = idx >> 6, n = idx & 63, d = dh * 32 + dd;
        const float m = expf(LR[n] * dt * (float)d), ang = LI[n] * dt * (float)d; const f32x2 v = {m * cosf(ang), m * sinf(ang)}; P[dd * 64 + n] = v;
        if (dh == 0 && d <= 16) ((f32x2*)(tb + S5T_PW))[(g * 64 + n) * 17 + d] = v;
        if (dh == 0 && d == 1) ((f32x2*)(tb + S5T_AB))[g * 64 + n] = v; }
    for (int idx = tid; idx < 1024; idx += NTHR) { const int n = idx >> 4, q = idx & 15; const float lr = LR[n], li = LI[n];
        const float mag = expf(lr * dt), abr = mag * cosf(li * dt), abi = mag * sinf(li * dt), den = lr * lr + li * li, nr = abr - 1.0f;
        const float cr = (nr * lr + abi * li) / den, ci = (abi * lr - nr * li) / den;
        const float br = a.in[I_SBR][((size_t)(l * 32 + g) * 64 + n) * 16 + q], bi = a.in[I_SBI][((size_t)(l * 32 + g) * 64 + n) * 16 + q];
        const f32x2 v = {cr * br - ci * bi, cr * bi + ci * br}; BL[n * 16 + q] = v;
        if (dh == 0) { bf16* BC = (bf16*)(tb + S5T_BC); BC[(g * 128 + n) * 16 + q] = (bf16)f2bf(v.x); BC[(g * 128 + 64 + n) * 16 + q] = (bf16)f2bf(v.y); } }
    for (int idx = tid; idx < 1024; idx += NTHR) { const int p = idx >> 6, n = idx & 63;
        const f32x2 v = {a.in[I_SCR][((size_t)(l * 32 + g) * 16 + p) * 64 + n], a.in[I_SCI][((size_t)(l * 32 + g) * 16 + p) * 64 + n]}; CL[p * 64 + n] = v;
        if (dh == 0) { bf16* CC = (bf16*)(tb + S5T_CC); CC[(g * 16 + p) * 128 + 2 * n] = (bf16)f2bf(v.x); CC[(g * 16 + p) * 128 + 2 * n + 1] = (bf16)f2bf(-v.y); } }
    if (dh == 0 && tid < 64) { const float m64 = expf(64.0f * LR[tid] * dt), ang = 64.0f * LI[tid] * dt; const f32x2 v = {m64 * cosf(ang), m64 * sinf(ang)}; ((f32x2*)(tb + S5T_A64))[g * 64 + tid] = v; }
    __syncthreads();
    { const int pq = tid & 255, p = pq >> 4, q = pq & 15, dq = tid >> 8; float s[16];
#pragma unroll
      for (int i = 0; i < 16; ++i) s[i] = 0.f;
#pragma unroll 1
      for (int nh = 0; nh < 4; ++nh) { float cbr[16], cbi[16];
#pragma unroll
          for (int n = 0; n < 16; ++n) { const f32x2 cv = CL[p * 64 + nh * 16 + n], bv = BL[(nh * 16 + n) * 16 + q]; cbr[n] = cv.x * bv.x - cv.y * bv.y; cbi[n] = cv.x * bv.y + cv.y * bv.x; }
#pragma unroll
          for (int i = 0; i < 16; ++i) { const LAS f32x2* pp = P + (dq * 16 + i) * 64 + nh * 16; float t = 0.f;
#pragma unroll
              for (int n = 0; n < 16; ++n) { const f32x2 pw = pp[n]; t += cbr[n] * pw.x - cbi[n] * pw.y; }
              s[i] += t; } }
      bf16* KT = (bf16*)(tb + S5T_KT);
#pragma unroll
      for (int i = 0; i < 16; ++i) KT[((size_t)(g * 64 + dh * 32 + dq * 16 + i) * 16 + p) * 16 + q] = (bf16)f2bf(s[i]); }
    __syncthreads();
}

__device__ __forceinline__ void p0_prologue(const Args& a, LAS unsigned char* lds, int vcu, int G) {
    const int tid = opaque_tid(), lane = tid & 63, wave = __builtin_amdgcn_readfirstlane(tid >> 6);
    for (int item = vcu; item < DEPTH * 64; item += G) p0_s5_tables(a, lds, item);
    for (int idx = vcu * NTHR + tid; idx < DEPTH * 2 * 8 * 64 * 64; idx += G * NTHR) { const int i = idx & 63, j = (idx >> 6) & 63, h = (idx >> 12) & 7, gate = (idx >> 15) & 1, l = idx >> 16;
        ((bf16*)(a.ws + WS_LRW))[idx] = (bf16)f2bf(a.in[gate ? I_LWI : I_LWR][((size_t)(l * 8 + h) * 64 + i) * 64 + j]); }
    LAS float* scr = (LAS float*)(lds + wave * 16384);
    const int gw = vcu * NWAVES + wave, NGW = G * NWAVES;
    for (int it = gw; it < DEPTH * 128; it += NGW) { const int l = it >> 7;
        p0_transpose_item<false>(a.in[I_SGW] + (size_t)l * 512 * 512, 512, 512, 16, nullptr, (bf16*)(a.ws + WS_GLUT) + (size_t)l * 512 * 512, scr, it & 127, lane); }
    constexpr int I_IN = (DM / 64) * (NPAD / 32), I_OUT = (2048 / 64) * (DM / 32);
    for (int it = gw; it < DEPTH * (I_IN + I_OUT); it += NGW) {
        const int l = it / (I_IN + I_OUT); int r = it % (I_IN + I_OUT);
        if (r < I_IN) p0_transpose_item<true>(a.in[I_WIN] + (size_t)l * DM * DIN, DM, DIN, NPAD / 32, a.in[I_NORMW] + l * DM, (bf16*)(a.ws + WS_WIN) + (size_t)l * NPAD * DM, scr, r, lane);
        else p0_transpose_item<false>(a.in[I_WOUT] + (size_t)l * 2048 * DM, 2048, DM, DM / 32, nullptr, (bf16*)(a.ws + WS_WOUT) + (size_t)l * DM * 2048, scr, r - I_IN, lane);
    }
    float* rowss0 = (float*)(a.ws + WS_PART);
    for (int m0 = gw; m0 < T; m0 += 4 * NGW) {
        f32x4 v[4][4];
#pragma unroll
        for (int r = 0; r < 4; ++r)
#pragma unroll
            for (int j = 0; j < 4; ++j) v[r][j] = ((const GAS f32x4*)(a.in[I_X] + (size_t)(m0 + r * NGW) * DM) + lane)[64 * j];
        PIN_MEM();
#pragma unroll
        for (int r = 0; r < 4; ++r) { const int m = m0 + r * NGW; float s = 0.f;
            GAS unsigned long long* o8 = (GAS unsigned long long*)((bf16*)a.out + (size_t)m * DM) + lane;
#pragma unroll
            for (int j = 0; j < 4; ++j) { const f32x4 x = v[r][j]; s += (x.x * x.x + x.y * x.y) + (x.z * x.z + x.w * x.w);
                o8[64 * j] = (unsigned long long)pk2(x.x, x.y) | ((unsigned long long)pk2(x.z, x.w) << 32); }
            s = wave_sum(s); if (lane < 16) rowss0[(size_t)m * 16 + lane] = lane == 0 ? s : 0.f; }
    }
}

__device__ __forceinline__ void ex_chunk(const Args& a, int l, int c) {
    const int tid = opaque_tid(), lane = tid & 63, w = __builtin_amdgcn_readfirstlane(tid >> 6), l15 = lane & 15, lq = lane >> 4;
    const int nt = w & 1, tt = w >> 1, t = c * 64 + 16 * tt + l15;
    const bf16* wp = (const bf16*)(a.ws + WS_WIN) + ((size_t)l * NPAD + PJ + 16 * nt + l15) * DM + 8 * lq;
    const bf16* xp = (const bf16*)a.out + (size_t)t * DM + 8 * lq;
    const float* rs = (const float*)(a.ws + WS_PART) + (size_t)l * T * 16 + (size_t)t * 16;
    const f32x4 p0 = *(const GAS f32x4*)(rs), p1 = *(const GAS f32x4*)(rs + 4), p2 = *(const GAS f32x4*)(rs + 8), p3 = *(const GAS f32x4*)(rs + 12);
    f32x4 acc = (f32x4){0.f, 0.f, 0.f, 0.f};
#pragma unroll 1
    for (int kb = 0; kb < 4; ++kb) { bf16x8 xf[8], yf[8];
#pragma unroll
        for (int k8 = 0; k8 < 8; ++k8) { xf[k8] = *(const GAS bf16x8*)(wp + 32 * (kb * 8 + k8)); yf[k8] = *(const GAS bf16x8*)(xp + 32 * (kb * 8 + k8)); }
        PIN_MEM();
#pragma unroll
        for (int k8 = 0; k8 < 8; ++k8) acc = mfma32(xf[k8], yf[k8], acc); }
    const float rsum = (((p0[0] + p0[1]) + (p0[2] + p0[3])) + ((p1[0] + p1[1]) + (p1[2] + p1[3]))) + (((p2[0] + p2[1]) + (p2[2] + p2[3])) + ((p3[0] + p3[1]) + (p3[2] + p3[3])));
    const float rstd = frsq(rsum * (1.0f / 1024.0f) + EPS);
    *(GAS f32x4*)((float*)(a.ws + WS_EX) + (size_t)t * 32 + 16 * nt + 4 * lq) = acc * rstd;
}

template <int CTRL> __device__ __forceinline__ float dppf(float old, float v) { return __builtin_bit_cast(float, __builtin_amdgcn_update_dpp(__builtin_bit_cast(int, old), __builtin_bit_cast(int, v), CTRL, 0xF, 0xF, false)); }
template <int CTRL> __device__ __forceinline__ float dppz(float v) { return __builtin_bit_cast(float, __builtin_amdgcn_update_dpp(0, __builtin_bit_cast(int, v), CTRL, 0xF, 0xF, true)); }
#define LRU_S4(SH) \
    "v_fmac_f32_dpp %4, %4, %0 row_shr:" #SH " row_mask:0xf bank_mask:0xf\n v_fmac_f32_dpp %5, %5, %1 row_shr:" #SH " row_mask:0xf bank_mask:0xf\n" \
    "v_fmac_f32_dpp %6, %6, %2 row_shr:" #SH " row_mask:0xf bank_mask:0xf\n v_fmac_f32_dpp %7, %7, %3 row_shr:" #SH " row_mask:0xf bank_mask:0xf\n" \
    "v_mul_f32_dpp %0, %0, %0 row_shr:" #SH " row_mask:0xf bank_mask:0xf\n v_mul_f32_dpp %1, %1, %1 row_shr:" #SH " row_mask:0xf bank_mask:0xf\n" \
    "v_mul_f32_dpp %2, %2, %2 row_shr:" #SH " row_mask:0xf bank_mask:0xf\n v_mul_f32_dpp %3, %3, %3 row_shr:" #SH " row_mask:0xf bank_mask:0xf\n"
__device__ __forceinline__ void lru_scan4(float (&A)[4], float (&B)[4]) {
    asm("s_nop 1\n" LRU_S4(1) LRU_S4(2) LRU_S4(4) LRU_S4(8) "s_nop 1\n"
        : "+v"(A[0]), "+v"(A[1]), "+v"(A[2]), "+v"(A[3]), "+v"(B[0]), "+v"(B[1]), "+v"(B[2]), "+v"(B[3]));
}
#define LRU_SCAN_STEP(CTRL) do { const float Ap = dppf<CTRL>(1.0f, A[mt]), Bp = dppf<CTRL>(0.0f, B[mt]); B[mt] = A[mt] * Bp + B[mt]; A[mt] = A[mt] * Ap; } while (0)
__device__ __forceinline__ void lru_chunk(const Args& a, int l, int c, bool fin, LAS unsigned char* lds, bool dry = false, bool conv_only = false) {
    const int tid = opaque_tid(), lane = tid & 63, h = __builtin_amdgcn_readfirstlane(tid >> 6), l15 = lane & 15, lq = lane >> 4;
    const int t0 = c * 64; const bool hp = (c % CPB) != 0;
    bf16* PR = (bf16*)(a.ws + WS_PROJ);
    bf16x8 yf[4][2];
#pragma unroll
    for (int ks = 0; ks < 2; ++ks) {
        const int i0 = h * 64 + 32 * ks + 8 * lq; float cw[4][8], cb[8];
#pragma unroll
        for (int v = 0; v < 4; ++v) { const f32x4 w0 = *(const GAS f32x4*)(a.in[I_LCW] + (size_t)(l * 4 + v) * 512 + i0), w1 = *(const GAS f32x4*)(a.in[I_LCW] + (size_t)(l * 4 + v) * 512 + i0 + 4);
            cw[v][0] = w0[0]; cw[v][1] = w0[1]; cw[v][2] = w0[2]; cw[v][3] = w0[3]; cw[v][4] = w1[0]; cw[v][5] = w1[1]; cw[v][6] = w1[2]; cw[v][7] = w1[3]; }
        { const f32x4 b0 = *(const GAS f32x4*)(a.in[I_LCB] + l * 512 + i0), b1 = *(const GAS f32x4*)(a.in[I_LCB] + l * 512 + i0 + 4);
          cb[0] = b0[0]; cb[1] = b0[1]; cb[2] = b0[2]; cb[3] = b0[3]; cb[4] = b1[0]; cb[5] = b1[1]; cb[6] = b1[2]; cb[7] = b1[3]; }
#pragma unroll
        for (int mt = 0; mt < 4; ++mt) { const int t = 16 * mt + l15; float u[8];
#pragma unroll
            for (int q = 0; q < 8; ++q) u[q] = cb[q];
#pragma unroll
            for (int v = 0; v < 4; ++v) { const int tt = t - 3 + v; const int row = (t0 + tt) < 0 ? 0 : (t0 + tt);
                v4u raw = *(const GAS v4u*)(PR + (size_t)row * PJ + A_X + i0);
                if (!(tt >= 0 || hp)) raw = (v4u){0u, 0u, 0u, 0u};
                u[0] += cw[v][0] * bflo(raw.x); u[1] += cw[v][1] * bfhi(raw.x); u[2] += cw[v][2] * bflo(raw.y); u[3] += cw[v][3] * bfhi(raw.y);
                u[4] += cw[v][4] * bflo(raw.z); u[5] += cw[v][5] * bfhi(raw.z); u[6] += cw[v][6] * bflo(raw.w); u[7] += cw[v][7] * bfhi(raw.w); }
            v4u pk; pk.x = pk2(u[0], u[1]); pk.y = pk2(u[2], u[3]); pk.z = pk2(u[4], u[5]); pk.w = pk2(u[6], u[7]); yf[mt][ks] = __builtin_bit_cast(bf16x8, pk); }
    }
    if (conv_only) {
#pragma unroll
        for (int mt = 0; mt < 4; ++mt) { asm volatile("" :: "v"(yf[mt][0]), "v"(yf[mt][1])); }
        return; }
    const bf16* WRt = (const bf16*)(a.ws + WS_LRW) + (size_t)((l * 2 + 0) * 8 + h) * 4096; const bf16* WIt = (const bf16*)(a.ws + WS_LRW) + (size_t)((l * 2 + 1) * 8 + h) * 4096;
#define LRU_LOADS(J, XR, XI, BR, BI, LL) do { const int ch0_ = h * 64 + 16 * (J) + 4 * lq; \
        _Pragma("unroll") for (int ks = 0; ks < 2; ++ks) { XR[ks] = *(const GAS bf16x8*)(WRt + (size_t)(16 * (J) + l15) * 64 + 32 * ks + 8 * lq); XI[ks] = *(const GAS bf16x8*)(WIt + (size_t)(16 * (J) + l15) * 64 + 32 * ks + 8 * lq); } \
        BR = *(const GAS f32x4*)(a.in[I_LBR] + l * 512 + ch0_); BI = *(const GAS f32x4*)(a.in[I_LBI] + l * 512 + ch0_); LL = *(const GAS f32x4*)(a.in[I_LL] + l * 512 + ch0_); \
        } while (0)
    bf16x8 cxr[2], cxi[2], nxr[2], nxi[2]; f32x4 br4, bi4, ll4, nbr, nbi, nll;
    LRU_LOADS(0, cxr, cxi, br4, bi4, ll4);
#pragma unroll 1
    for (int jt = 0; jt < 4; ++jt) {
        const int jn = jt < 3 ? jt + 1 : 3;
        LRU_LOADS(jn, nxr, nxi, nbr, nbi, nll);
        const int ch0 = h * 64 + 16 * jt + 4 * lq;
        f32x4 hin4 = (f32x4){0.f, 0.f, 0.f, 0.f}; v2u czv[4];
#pragma unroll
        for (int mt = 0; mt < 4; ++mt) czv[mt] = (v2u){0u, 0u};
        if (fin) { hin4 = *(const GAS f32x4*)((const float*)(a.ws + WS_LRUH) + (size_t)c * 512 + ch0);
#pragma unroll
            for (int mt = 0; mt < 4; ++mt) czv[mt] = *(const GAS v2u*)(PR + (size_t)(t0 + 16 * mt + l15) * PJ + A_Z + ch0); }
        PIN_MEM();
        f32x4 ar[4], ai[4], au[4];
#pragma unroll
        for (int mt = 0; mt < 4; ++mt) { ar[mt] = (f32x4){0.f, 0.f, 0.f, 0.f}; ai[mt] = ar[mt]; au[mt] = ar[mt]; }
#pragma unroll
        for (int ks = 0; ks < 2; ++ks) {
            bf16x8 xu = (bf16x8){0, 0, 0, 0, 0, 0, 0, 0};
#pragma unroll
            for (int e = 0; e < 8; ++e) xu[e] = (32 * ks + 8 * lq + e == 16 * jt + l15) ? (short)0x3F80 : (short)0;
#pragma unroll
            for (int mt = 0; mt < 4; ++mt) { ar[mt] = mfma32(cxr[ks], yf[mt][ks], ar[mt]); ai[mt] = mfma32(cxi[ks], yf[mt][ks], ai[mt]); au[mt] = mfma32(xu, yf[mt][ks], au[mt]); }
        }
        float hv[4][4]; unsigned cpk[4][4];
#pragma unroll
        for (int r = 0; r < 4; ++r) {
            const float sp = softplus(-ll4[r]); float A[4], B[4];
#pragma unroll
            for (int mt = 0; mt < 4; ++mt) { const float rg = sigm(ar[mt][r] + br4[r]), ig = sigm(ai[mt][r] + bi4[r]); const float la = -8.0f * rg * sp;
                A[mt] = fexp(la); B[mt] = fsqrt((1.0f - A[mt]) * (1.0f + A[mt])) * ig * au[mt][r]; }
            lru_scan4(A, B);
            float Ac = 1.0f, Bc = 0.0f;
#pragma unroll
            for (int mt = 0; mt < 4; ++mt) { B[mt] = A[mt] * Bc + B[mt]; A[mt] = A[mt] * Ac; Ac = dppz<0x15F>(A[mt]); Bc = dppz<0x15F>(B[mt]); }
            if (fin) {
#pragma unroll
                for (int mt = 0; mt < 4; ++mt) hv[mt][r] = B[mt] + A[mt] * hin4[r];
            } else {
#pragma unroll
                for (int mt = 0; mt < 4; ++mt) cpk[mt][r] = pk2(A[mt], B[mt]);
                if (l15 == 15) { float* E = (float*)(a.ws + WS_LRUE) + ((size_t)c * 512 + ch0 + r) * 2; E[0] = A[3]; E[1] = B[3]; }
            }
        }
        if (!fin) {
#pragma unroll
            for (int mt = 0; mt < 4; ++mt) { v4u o; o.x = cpk[mt][0]; o.y = cpk[mt][1]; o.z = cpk[mt][2]; o.w = cpk[mt][3];
                *(GAS v4u*)((unsigned*)a.out + (size_t)8388608 + (size_t)(t0 + 16 * mt + l15) * 512 + ch0) = o; }
        }
        if (fin) {
#pragma unroll
            for (int mt = 0; mt < 4; ++mt) { GAS v2u* zp = (GAS v2u*)(PR + (size_t)(t0 + 16 * mt + l15) * PJ + A_Z + ch0); const v2u zv = czv[mt];
                v2u o; o.x = pk2(hv[mt][0] * silu(bflo(zv.x)), hv[mt][1] * silu(bfhi(zv.x))); o.y = pk2(hv[mt][2] * silu(bflo(zv.y)), hv[mt][3] * silu(bfhi(zv.y))); if (dry) asm volatile("" :: "v"(o.x), "v"(o.y)); else *zp = o; }
        }
#pragma unroll
        for (int ks = 0; ks < 2; ++ks) { cxr[ks] = nxr[ks]; cxi[ks] = nxi[ks]; }
        br4 = nbr; bi4 = nbi; ll4 = nll;
    }
#undef LRU_LOADS
}

__device__ __forceinline__ void lru_out(const Args& a, int l, int c, bool dry = false) {
    const int tid = opaque_tid(), cg = tid & 63, tq = tid >> 6; const int t0 = c * 64;
    bf16* PR = (bf16*)(a.ws + WS_PROJ); const unsigned* LC = (const unsigned*)a.out + (size_t)8388608;
    const f32x4 h0 = *(const GAS f32x4*)((const float*)(a.ws + WS_LRUH) + (size_t)c * 512 + 8 * cg), h1 = *(const GAS f32x4*)((const float*)(a.ws + WS_LRUH) + (size_t)c * 512 + 8 * cg + 4);
    v4u p0[8], p1[8], zz[8];
#pragma unroll
    for (int i = 0; i < 8; ++i) { const size_t t = (size_t)(t0 + 8 * tq + i);
        p0[i] = *(const GAS v4u*)(LC + t * 512 + 8 * cg); p1[i] = *(const GAS v4u*)(LC + t * 512 + 8 * cg + 4); zz[i] = *(const GAS v4u*)(PR + t * PJ + A_Z + 8 * cg); }
    PIN_MEM();
#pragma unroll
    for (int i = 0; i < 8; ++i) { const size_t t = (size_t)(t0 + 8 * tq + i);
        const float y0 = (bfhi(p0[i].x) + bflo(p0[i].x) * h0[0]) * silu(bflo(zz[i].x)), y1 = (bfhi(p0[i].y) + bflo(p0[i].y) * h0[1]) * silu(bfhi(zz[i].x));
        const float y2 = (bfhi(p0[i].z) + bflo(p0[i].z) * h0[2]) * silu(bflo(zz[i].y)), y3 = (bfhi(p0[i].w) + bflo(p0[i].w) * h0[3]) * silu(bfhi(zz[i].y));
        const float y4 = (bfhi(p1[i].x) + bflo(p1[i].x) * h1[0]) * silu(bflo(zz[i].z)), y5 = (bfhi(p1[i].y) + bflo(p1[i].y) * h1[1]) * silu(bfhi(zz[i].z));
        const float y6 = (bfhi(p1[i].z) + bflo(p1[i].z) * h1[2]) * silu(bflo(zz[i].w)), y7 = (bfhi(p1[i].w) + bflo(p1[i].w) * h1[3]) * silu(bfhi(zz[i].w));
        v4u o; o.x = pk2(y0, y1); o.y = pk2(y2, y3); o.z = pk2(y4, y5); o.w = pk2(y6, y7);
        if (dry) asm volatile("" :: "v"(o.x), "v"(o.y), "v"(o.z), "v"(o.w)); else *(GAS v4u*)(PR + t * PJ + A_Z + 8 * cg) = o; }
}

constexpr int UBP = 520;
__device__ __forceinline__ void s5_local(const Args& a, int l, int c) {
    const int tid = opaque_tid(), lane = tid & 63, w = __builtin_amdgcn_readfirstlane(tid >> 6), l15 = lane & 15, lq = lane >> 4;
    const int t0 = c * 64;
    const bf16* PR = (const bf16*)(a.ws + WS_PROJ);
    const unsigned char* tb = a.ws + WS_S5T + (size_t)l * S5T_LAYER;
    const bf16* BC = (const bf16*)(tb + S5T_BC); const f32x2* PW = (const f32x2*)(tb + S5T_PW);
    f32x2* ST = (f32x2*)(a.ws + WS_S5ST) + (size_t)c * 2048;
#pragma unroll 2
    for (int k = 0; k < 4; ++k) {
        const int g = 4 * w + k; bf16x4 yf[4], xr[4], xi[4]; f32x2 wb[4][4], st[4][4];
#pragma unroll
        for (int nt = 0; nt < 4; ++nt) yf[nt] = *(const GAS bf16x4*)(PR + (size_t)(t0 + 16 * nt + l15) * PJ + B_U + g * 16 + 4 * lq);
#pragma unroll
        for (int mt = 0; mt < 4; ++mt) { xr[mt] = *(const GAS bf16x4*)(BC + ((size_t)g * 128 + 16 * mt + l15) * 16 + 4 * lq); xi[mt] = *(const GAS bf16x4*)(BC + ((size_t)g * 128 + 64 + 16 * mt + l15) * 16 + 4 * lq);
#pragma unroll
            for (int r = 0; r < 4; ++r) { const int n = 16 * mt + 4 * lq + r; wb[mt][r] = PW[(g * 64 + n) * 17 + (15 - l15)]; st[mt][r] = PW[(g * 64 + n) * 17 + 16]; } }
        PIN_MEM();
#pragma unroll
        for (int mt = 0; mt < 4; ++mt) {
            f32x4 ar[4], ai[4];
#pragma unroll
            for (int nt = 0; nt < 4; ++nt) { ar[nt] = mfma16(xr[mt], yf[nt], (f32x4){0.f, 0.f, 0.f, 0.f}); ai[nt] = mfma16(xi[mt], yf[nt], (f32x4){0.f, 0.f, 0.f, 0.f}); }
#pragma unroll
            for (int r = 0; r < 4; ++r) {
                const int n = 16 * mt + 4 * lq + r; const f32x2 s16 = st[mt][r];
                float er = 0.f, ei = 0.f, wr = wb[mt][r].x, wi = wb[mt][r].y;
#pragma unroll
                for (int nt = 3; nt >= 0; --nt) { const float br = ar[nt][r], bi = ai[nt][r]; er += wr * br - wi * bi; ei += wr * bi + wi * br;
                    const float nwr = wr * s16.x - wi * s16.y, nwi = wr * s16.y + wi * s16.x; wr = nwr; wi = nwi; }
                er += dppz<0x111>(er); ei += dppz<0x111>(ei); er += dppz<0x112>(er); ei += dppz<0x112>(ei);
                er += dppz<0x114>(er); ei += dppz<0x114>(ei); er += dppz<0x118>(er); ei += dppz<0x118>(ei);
                if (l15 == 15) { const f32x2 v = {er, ei}; ST[g * 64 + n] = v; }
            }
        }
    }
}
__device__ __forceinline__ void s5_out(const Args& a, int l, int c, LAS unsigned char* lds, bool dry = false) {
    const int tid = opaque_tid(), lane = tid & 63, w = __builtin_amdgcn_readfirstlane(tid >> 6), l15 = lane & 15, lq = lane >> 4;
    const int t0 = c * 64;
    LAS bf16* ub = (LAS bf16*)lds;
    bf16* PR = (bf16*)(a.ws + WS_PROJ);
    { v4u ut[8];
#pragma unroll
      for (int i = 0; i < 8; ++i) { const int idx = tid + NTHR * i, row = idx >> 6, c8 = idx & 63; ut[i] = *(const GAS v4u*)(PR + (size_t)(t0 + row) * PJ + B_U + c8 * 8); }
      PIN_MEM();
      for (int idx = tid; idx < 16 * 65; idx += NTHR) { const int row = idx / 65, c8 = idx % 65; *(LAS v4u*)(ub + row * UBP + c8 * 8) = (v4u){0u, 0u, 0u, 0u}; }
#pragma unroll
      for (int i = 0; i < 8; ++i) { const int idx = tid + NTHR * i, row = idx >> 6, c8 = idx & 63; *(LAS v4u*)(ub + (16 + row) * UBP + c8 * 8) = ut[i]; } }
    __syncthreads();
    const unsigned char* tb = a.ws + WS_S5T + (size_t)l * S5T_LAYER;
    const bf16* KT = (const bf16*)(tb + S5T_KT); const bf16* CC = (const bf16*)(tb + S5T_CC); const f32x2* PW = (const f32x2*)(tb + S5T_PW);
    const f32x2* ST = (const f32x2*)(a.ws + WS_S5ST) + (size_t)c * 2048;
#define S5_KLOAD(dst, kb) do { _Pragma("unroll") for (int k8 = 0; k8 < 8; ++k8) dst[k8] = *(const GAS bf16x8*)(kp + (size_t)(2 * ((kb) * 8 + k8)) * 256); } while (0)
#define S5_KMMA(src, kb) do { _Pragma("unroll") for (int k8 = 0; k8 < 8; ++k8) { _Pragma("unroll") for (int it = (kb); it < 4; ++it) { \
        const bf16x8 yf = *(const LAS bf16x8*)(up + (16 * it - 2 * ((kb) * 8 + k8)) * UBP); acc[it] = mfma32(src[k8], yf, acc[it]); } } } while (0)
#pragma unroll 1
    for (int k = 0; k < 4; ++k) {
        const int g = 4 * w + k; f32x4 acc[4];
#pragma unroll
        for (int it = 0; it < 4; ++it) acc[it] = (f32x4){0.f, 0.f, 0.f, 0.f};
        const bf16* kp = KT + ((size_t)(g * 64 + (lq >> 1)) * 16 + l15) * 16 + 8 * (lq & 1);
        const LAS bf16* up = ub + (16 + l15 - (lq >> 1)) * UBP + g * 16 + 8 * (lq & 1);
        bf16x8 ka[8], kc[8];
        S5_KLOAD(ka, 0); S5_KLOAD(kc, 1); PIN_MEM();
        S5_KMMA(ka, 0);
        S5_KLOAD(ka, 2); PIN_MEM();
        S5_KMMA(kc, 1);
        bf16x8 xfc[4]; f32x2 pb[4][4], ps[4][4], sv[4][4];
        S5_KLOAD(kc, 3);
#pragma unroll
        for (int ks2 = 0; ks2 < 4; ++ks2) { xfc[ks2] = *(const GAS bf16x8*)(CC + ((size_t)g * 16 + l15) * 128 + 32 * ks2 + 8 * lq);
#pragma unroll
            for (int m = 0; m < 4; ++m) { const int n = 16 * ks2 + 4 * lq + m; pb[ks2][m] = PW[(g * 64 + n) * 17 + l15 + 1]; ps[ks2][m] = PW[(g * 64 + n) * 17 + 16]; sv[ks2][m] = ST[g * 64 + n]; } }
        const f32x4 dsk = *(const GAS f32x4*)(a.in[I_SD] + l * 512 + g * 16 + 4 * lq);
        PIN_MEM();
        S5_KMMA(ka, 2);
        S5_KMMA(kc, 3);
#pragma unroll
        for (int ks2 = 0; ks2 < 4; ++ks2) {
            float pr[4], pi[4];
#pragma unroll
            for (int m = 0; m < 4; ++m) { pr[m] = pb[ks2][m].x; pi[m] = pb[ks2][m].y; }
#pragma unroll
            for (int it = 0; it < 4; ++it) {
                v4u zz; unsigned zw[4];
#pragma unroll
                for (int m = 0; m < 4; ++m) { const float sr = sv[ks2][m].x, si = sv[ks2][m].y, qr = ps[ks2][m].x, qi = ps[ks2][m].y;
                    const float zr = pr[m] * sr - pi[m] * si, zi = pr[m] * si + pi[m] * sr; zw[m] = pk2(zr, zi);
                    const float nr = pr[m] * qr - pi[m] * qi, ni = pr[m] * qi + pi[m] * qr; pr[m] = nr; pi[m] = ni; }
                zz.x = zw[0]; zz.y = zw[1]; zz.z = zw[2]; zz.w = zw[3];
                acc[it] = mfma32(xfc[ks2], __builtin_bit_cast(bf16x8, zz), acc[it]);
            }
        }
#pragma unroll
        for (int it = 0; it < 4; ++it) { LAS v2u* p = (LAS v2u*)(ub + (16 + 16 * it + l15) * UBP + g * 16 + 4 * lq); const v2u uv = *p;
            const float y0 = gelu_tanh(acc[it][0] + dsk[0] * bflo(uv.x)), y1 = gelu_tanh(acc[it][1] + dsk[1] * bfhi(uv.x)), y2 = gelu_tanh(acc[it][2] + dsk[2] * bflo(uv.y)), y3 = gelu_tanh(acc[it][3] + dsk[3] * bfhi(uv.y));
            v2u o; o.x = pk2(y0, y1); o.y = pk2(y2, y3); *p = o; }
    }
#undef S5_KLOAD
#undef S5_KMMA
    {
        f32x4 acc[4][4]; v2u zv[4][4]; f32x4 gb[4];
        const bf16* wp = (const bf16*)(a.ws + WS_GLUT) + (size_t)l * 512 * 512 + (size_t)(64 * w + l15) * 512 + 8 * lq;
        bf16x8 xa[4], xb[4];
#pragma unroll
        for (int jt = 0; jt < 4; ++jt) { xa[jt] = *(const GAS bf16x8*)(wp + (size_t)(16 * jt) * 512); gb[jt] = *(const GAS f32x4*)(a.in[I_SGB] + l * 512 + 64 * w + 16 * jt + 4 * lq);
#pragma unroll
            for (int tt = 0; tt < 4; ++tt) { zv[jt][tt] = *(const GAS v2u*)(PR + (size_t)(t0 + 16 * tt + l15) * PJ + B_Z + 64 * w + 16 * jt + 4 * lq); acc[jt][tt] = (f32x4){0.f, 0.f, 0.f, 0.f}; } }
        PIN_MEM();
        __syncthreads();
        const LAS bf16* yp = ub + (16 + l15) * UBP + 8 * lq;
#define S5_GMMA(xf, ks) do { bf16x8 yf[4]; _Pragma("unroll") for (int tt = 0; tt < 4; ++tt) yf[tt] = *(const LAS bf16x8*)(yp + (16 * tt) * UBP + 32 * (ks)); \
        _Pragma("unroll") for (int jt = 0; jt < 4; ++jt) _Pragma("unroll") for (int tt = 0; tt < 4; ++tt) acc[jt][tt] = mfma32(xf[jt], yf[tt], acc[jt][tt]); } while (0)
#pragma unroll 1
        for (int k2 = 0; k2 < 8; ++k2) {
#pragma unroll
            for (int jt = 0; jt < 4; ++jt) xb[jt] = *(const GAS bf16x8*)(wp + (size_t)(16 * jt) * 512 + 32 * (2 * k2 + 1));
            PIN_MEM();
            S5_GMMA(xa, 2 * k2);
            const int kn = k2 < 7 ? 2 * k2 + 2 : 15;
#pragma unroll
            for (int jt = 0; jt < 4; ++jt) xa[jt] = *(const GAS bf16x8*)(wp + (size_t)(16 * jt) * 512 + 32 * kn);
            PIN_MEM();
            S5_GMMA(xb, 2 * k2 + 1);
        }
#undef S5_GMMA
#pragma unroll
        for (int jt = 0; jt < 4; ++jt) { const int j0 = 64 * w + 16 * jt + 4 * lq;
#pragma unroll
            for (int tt = 0; tt < 4; ++tt) { const int t = 16 * tt + l15; const v2u yv = *(const LAS v2u*)(ub + (16 + t) * UBP + j0);
                GAS v2u* zp = (GAS v2u*)(PR + (size_t)(t0 + t) * PJ + B_Z + j0); const v2u zz = zv[jt][tt];
                const float o0 = bflo(yv.x) * sigm(acc[jt][tt][0] + gb[jt][0]) * silu(bflo(zz.x)), o1 = bfhi(yv.x) * sigm(acc[jt][tt][1] + gb[jt][1]) * silu(bfhi(zz.x));
                const float o2 = bflo(yv.y) * sigm(acc[jt][tt][2] + gb[jt][2]) * silu(bflo(zz.y)), o3 = bfhi(yv.y) * sigm(acc[jt][tt][3] + gb[jt][3]) * silu(bfhi(zz.y));
                v2u o; o.x = pk2(o0, o1); o.y = pk2(o2, o3); if (dry) asm volatile("" :: "v"(o.x), "v"(o.y)); else *zp = o; } }
    }
    __syncthreads();
}

__device__ __forceinline__ void s5_chunk(const Args& a, int l, int c, bool fin, LAS unsigned char* lds, bool dry = false) { if (fin) s5_out(a, l, c, lds, dry); else s5_local(a, l, c); }

constexpr int QP = 264, VPF = 520, SPP = 72;
constexpr int GLA_QD = 0, GLA_KI = 33792, GLA_VV = 67584, GLA_SS = 134144, GLA_GT = 134144, GLA_GLW = 136192;
__device__ __forceinline__ void gla_chunk(const Args& a, int l, int c, bool fin, LAS unsigned char* lds, bool dry = false) {
    const int tid = opaque_tid(), lane = tid & 63, w = __builtin_amdgcn_readfirstlane(tid >> 6), l15 = lane & 15, lq = lane >> 4; const int t0 = c * 64;
    LAS bf16* QD = (LAS bf16*)(lds + GLA_QD); LAS bf16* KI = (LAS bf16*)(lds + GLA_KI); LAS bf16* VV = (LAS bf16*)(lds + GLA_VV); LAS bf16* SS = (LAS bf16*)(lds + GLA_SS);
    LAS float* GT = (LAS float*)(lds + GLA_GT); LAS float* GLW = (LAS float*)(lds + GLA_GLW);
    bf16* PR = (bf16*)(a.ws + WS_PROJ); const float* EX = (const float*)(a.ws + WS_EX);
    bf16* KV = (bf16*)(a.ws + WS_GLA) + (size_t)c * 32768;
    const int d = tid & 255, half = tid >> 8; float g[32]; unsigned short kraw[32], qraw[32];
    { float wg[16]; v4u vt[8];
      const f32x2 glr = *(const GAS f32x2*)(EX + (size_t)(t0 + (tid >> 3)) * 32 + 2 * (tid & 7));
#pragma unroll
      for (int r = 0; r < 16; ++r) wg[r] = a.in[I_GWG][(size_t)(l * 16 + r) * 256 + d];
      const float bg = a.in[I_GBG][l * 256 + d];
#pragma unroll
      for (int i = 0; i < 8; ++i) { const int idx = tid + NTHR * i, row = idx >> 6, c8 = idx & 63; vt[i] = *(const GAS v4u*)(PR + (size_t)(t0 + row) * PJ + C_V + c8 * 8); }
#pragma unroll
      for (int tt = 0; tt < 32; ++tt) { kraw[tt] = PR[(size_t)(t0 + 32 * half + tt) * PJ + C_K + d]; qraw[tt] = PR[(size_t)(t0 + 32 * half + tt) * PJ + C_Q + d]; }
      PIN_MEM();
      *(LAS f32x2*)(GLW + (tid >> 3) * 16 + 2 * (tid & 7)) = glr;
#pragma unroll
      for (int i = 0; i < 8; ++i) { const int idx = tid + NTHR * i, row = idx >> 6, c8 = idx & 63; *(LAS v4u*)(VV + row * VPF + c8 * 8) = vt[i]; }
      __syncthreads();
      float run = 0.f;
#pragma unroll
      for (int tt = 0; tt < 32; ++tt) { const LAS f32x4* gl = (const LAS f32x4*)(GLW + (32 * half + tt) * 16); const f32x4 g0 = gl[0], g1 = gl[1], g2 = gl[2], g3 = gl[3];
          float lg = bg + ((g0[0] * wg[0] + g0[1] * wg[1]) + (g0[2] * wg[2] + g0[3] * wg[3])) + ((g1[0] * wg[4] + g1[1] * wg[5]) + (g1[2] * wg[6] + g1[3] * wg[7]))
                        + ((g2[0] * wg[8] + g2[1] * wg[9]) + (g2[2] * wg[10] + g2[3] * wg[11])) + ((g3[0] * wg[12] + g3[1] * wg[13]) + (g3[2] * wg[14] + g3[3] * wg[15]));
          run += -softplus(-lg) * (1.0f / 16.0f); g[tt] = run; }
      GT[half * 256 + d] = run; }
    __syncthreads();
    { const float tot0 = GT[d], tot1 = GT[256 + d], off = half ? tot0 : 0.f, glast = tot0 + tot1;
      const float kofs = fin ? 0.f : glast;
#pragma unroll
      for (int tt = 0; tt < 32; ++tt) { const int t = 32 * half + tt; const float gc = g[tt] + off; const float kx = bf2f(kraw[tt]), qx = bf2f(qraw[tt]);
          QD[t * QP + d] = (bf16)f2bf(qx * 0.125f * fexp(gc)); KI[t * QP + d] = (bf16)f2bf(kx * fexp(kofs - gc)); }
      if (!fin && half == 0) ((float*)(a.ws + WS_GDEC))[(size_t)c * 256 + d] = fexp(glast); }
    __syncthreads();
    if (!fin) {
        const int h = w >> 1, eh = w & 1; f32x4 acc[4][4];
#pragma unroll
        for (int dt = 0; dt < 4; ++dt)
#pragma unroll
            for (int et = 0; et < 4; ++et) acc[dt][et] = (f32x4){0.f, 0.f, 0.f, 0.f};
#pragma unroll
        for (int ks = 0; ks < 2; ++ks) { bf16x8 xf[4], yf[4];
#pragma unroll
            for (int dt = 0; dt < 4; ++dt) xf[dt] = tr_frag(KI + (32 * ks + 8 * lq + (l15 >> 2)) * QP + h * 64 + 16 * dt + 4 * (l15 & 3), QP);
#pragma unroll
            for (int et = 0; et < 4; ++et) yf[et] = tr_frag(VV + (32 * ks + 8 * lq + (l15 >> 2)) * VPF + h * 128 + 64 * eh + 16 * et + 4 * (l15 & 3), VPF);
#pragma unroll
            for (int dt = 0; dt < 4; ++dt)
#pragma unroll
                for (int et = 0; et < 4; ++et) acc[dt][et] = mfma32(xf[dt], yf[et], acc[dt][et]); }
#pragma unroll
        for (int dt = 0; dt < 4; ++dt)
#pragma unroll
            for (int et = 0; et < 4; ++et) { v2u o; o.x = pk2(acc[dt][et][0], acc[dt][et][1]); o.y = pk2(acc[dt][et][2], acc[dt][et][3]);
                *(GAS v2u*)(KV + ((size_t)h * 128 + 64 * eh + 16 * et + l15) * 64 + 16 * dt + 4 * lq) = o; }
    } else {
#pragma unroll 1
        for (int rd = 0; rd < 2; ++rd) {
            const int hl = w >> 2, it = w & 3, h = 2 * rd + hl, i = 16 * it + l15; LAS bf16* SSw = SS + w * 16 * SPP;
            bf16x8 pf[2][8]; v2u zv[8]; f32x4 nw[8];
#pragma unroll
            for (int ks = 0; ks < 2; ++ks)
#pragma unroll
                for (int et = 0; et < 8; ++et) pf[ks][et] = *(const GAS bf16x8*)(KV + ((size_t)h * 128 + 16 * et + l15) * 64 + 32 * ks + 8 * lq);
#pragma unroll
            for (int et = 0; et < 8; ++et) { zv[et] = *(const GAS v2u*)(PR + (size_t)(t0 + i) * PJ + C_Z + h * 128 + 16 * et + 4 * lq); nw[et] = *(const GAS f32x4*)(a.in[I_GNW] + l * 128 + 16 * et + 4 * lq); }
            PIN_MEM();
#pragma unroll
            for (int jt = 0; jt < 4; ++jt) { v2u o = (v2u){0u, 0u};
                if (jt <= it) { f32x4 s = (f32x4){0.f, 0.f, 0.f, 0.f};
#pragma unroll
                    for (int ks = 0; ks < 2; ++ks) { const bf16x8 xf = *(const LAS bf16x8*)(KI + (16 * jt + l15) * QP + h * 64 + 32 * ks + 8 * lq), yf = *(const LAS bf16x8*)(QD + (16 * it + l15) * QP + h * 64 + 32 * ks + 8 * lq);
                        s = mfma32(xf, yf, s); }
                    const int j0 = 16 * jt + 4 * lq;
                    o.x = pk2(j0 <= i ? s[0] : 0.f, j0 + 1 <= i ? s[1] : 0.f); o.y = pk2(j0 + 2 <= i ? s[2] : 0.f, j0 + 3 <= i ? s[3] : 0.f); }
                *(LAS v2u*)(SSw + l15 * SPP + 16 * jt + 4 * lq) = o; }
            f32x4 oa[8];
#pragma unroll
            for (int et = 0; et < 8; ++et) oa[et] = (f32x4){0.f, 0.f, 0.f, 0.f};
#pragma unroll
            for (int ks = 0; ks < 2; ++ks) { if (32 * ks <= 16 * it + 15) { const bf16x8 yf = *(const LAS bf16x8*)(SSw + l15 * SPP + 32 * ks + 8 * lq);
#pragma unroll
                for (int et = 0; et < 8; ++et) { const bf16x8 xf = tr_frag(VV + (32 * ks + 8 * lq + (l15 >> 2)) * VPF + h * 128 + 16 * et + 4 * (l15 & 3), VPF); oa[et] = mfma32(xf, yf, oa[et]); } } }
#pragma unroll
            for (int ks = 0; ks < 2; ++ks) { const bf16x8 yf = *(const LAS bf16x8*)(QD + (16 * it + l15) * QP + h * 64 + 32 * ks + 8 * lq);
#pragma unroll
                for (int et = 0; et < 8; ++et) oa[et] = mfma32(pf[ks][et], yf, oa[et]); }
            float ss = 0.f;
#pragma unroll
            for (int et = 0; et < 8; ++et) ss += (oa[et][0] * oa[et][0] + oa[et][1] * oa[et][1]) + (oa[et][2] * oa[et][2] + oa[et][3] * oa[et][3]);
            ss += __shfl_xor(ss, 16); ss += __shfl_xor(ss, 32);
            const float rstd = frsq(ss * (1.0f / 128.0f) + EPS);
#pragma unroll
            for (int et = 0; et < 8; ++et) { GAS v2u* zp = (GAS v2u*)(PR + (size_t)(t0 + i) * PJ + C_Z + h * 128 + 16 * et + 4 * lq);
                v2u o; o.x = pk2(oa[et][0] * rstd * nw[et][0] * silu(bflo(zv[et].x)), oa[et][1] * rstd * nw[et][1] * silu(bfhi(zv[et].x)));
                o.y = pk2(oa[et][2] * rstd * nw[et][2] * silu(bflo(zv[et].y)), oa[et][3] * rstd * nw[et][3] * silu(bfhi(zv[et].y)));
                if (dry) asm volatile("" :: "v"(o.x), "v"(o.y)); else *zp = o; }
        }
    }
    __syncthreads();
}

constexpr int XSP = 520, BMP = 264, MP = 72;
constexpr int SSD_XS = 0, SSD_CM = 66560, SSD_BM = 100352, SSD_M = 100352, SSD_DT = 137216, SSD_AC = 139264, SSD_SQ = 141312;
__device__ __forceinline__ void ssd_chunk(const Args& a, int l, int c, bool fin, LAS unsigned char* lds, bool dry = false) {
    const int tid = opaque_tid(), lane = tid & 63, w = __builtin_amdgcn_readfirstlane(tid >> 6), l15 = lane & 15, lq = lane >> 4; const int t0 = c * 64;
    const bool hp = (c % CPB) != 0;
    LAS bf16* XS = (LAS bf16*)(lds + SSD_XS); LAS bf16* CM = (LAS bf16*)(lds + SSD_CM); LAS bf16* BM = (LAS bf16*)(lds + SSD_BM); LAS bf16* MM = (LAS bf16*)(lds + SSD_M);
    LAS float* dtl = (LAS float*)(lds + SSD_DT); LAS float* acl = (LAS float*)(lds + SSD_AC); LAS float* ssq = (LAS float*)(lds + SSD_SQ);
    bf16* PR = (bf16*)(a.ws + WS_PROJ); const float* EX = (const float*)(a.ws + WS_EX);
    bf16* STT = (bf16*)(a.ws + WS_SSD) + (size_t)c * 65536;
    { const int h = w; const float bias = a.in[I_DDTB][l * 8 + h], av = -expf(a.in[I_DALOG][l * 8 + h]);
      const float dt = softplus(EX[(size_t)(t0 + lane) * 32 + 16 + h] + bias); float cum = dt * av;
#pragma unroll
      for (int off = 1; off < 64; off <<= 1) { const float pv = __shfl_up(cum, off); if (lane >= off) cum += pv; }
      dtl[lane * 8 + h] = dt; acl[lane * 8 + h] = cum; }
    __syncthreads();
    { const int cg = tid & 127, seg = tid >> 7; int mycol, wch, pitch; LAS bf16* dst;
      if (cg < 64) { mycol = D_XS + 8 * cg; wch = 8 * cg; dst = XS + 8 * cg; pitch = XSP; }
      else if (cg < 96) { mycol = D_BM + 8 * (cg - 64); wch = 512 + 8 * (cg - 64); dst = BM + 8 * (cg - 64); pitch = BMP; }
      else { mycol = D_CM + 8 * (cg - 96); wch = 768 + 8 * (cg - 96); dst = CM + 8 * (cg - 96); pitch = BMP; }
      if (fin || cg < 96) {
          float wgt[4][8], cb[8];
          const float* cw = a.in[I_DCW] + (size_t)l * 4 * 1024 + wch;
#pragma unroll
          for (int v = 0; v < 4; ++v) { const f32x4 w0 = *(const GAS f32x4*)(cw + v * 1024), w1 = *(const GAS f32x4*)(cw + v * 1024 + 4);
              wgt[v][0] = w0[0]; wgt[v][1] = w0[1]; wgt[v][2] = w0[2]; wgt[v][3] = w0[3]; wgt[v][4] = w1[0]; wgt[v][5] = w1[1]; wgt[v][6] = w1[2]; wgt[v][7] = w1[3]; }
          { const f32x4 b0 = *(const GAS f32x4*)(a.in[I_DCB] + l * 1024 + wch), b1 = *(const GAS f32x4*)(a.in[I_DCB] + l * 1024 + wch + 4);
            cb[0] = b0[0]; cb[1] = b0[1]; cb[2] = b0[2]; cb[3] = b0[3]; cb[4] = b1[0]; cb[5] = b1[1]; cb[6] = b1[2]; cb[7] = b1[3]; }
          const int hh = cg >> 3; const float aL = acl[63 * 8 + (hh & 7)];
          v4u raws[19];
#pragma unroll
          for (int r = 0; r < 19; ++r) { const int t = 16 * seg - 3 + r; const int row = (t0 + t) < 0 ? 0 : (t0 + t); raws[r] = *(const GAS v4u*)(PR + (size_t)row * PJ + mycol); }
          PIN_MEM();
          float x3[8], x2[8], x1[8];
#pragma unroll
          for (int q = 0; q < 8; ++q) { x3[q] = 0.f; x2[q] = 0.f; x1[q] = 0.f; }
#pragma unroll
          for (int r = 0; r < 19; ++r) {
              const int t = 16 * seg - 3 + r; v4u raw = raws[r];
              if (!(t >= 0 || hp)) raw = (v4u){0u, 0u, 0u, 0u};
              float x0[8]; x0[0] = bflo(raw.x); x0[1] = bfhi(raw.x); x0[2] = bflo(raw.y); x0[3] = bfhi(raw.y); x0[4] = bflo(raw.z); x0[5] = bfhi(raw.z); x0[6] = bflo(raw.w); x0[7] = bfhi(raw.w);
              if (r >= 3) {
                  float sc = 1.0f; if (!fin && cg < 64) sc = fexp(aL - acl[t * 8 + hh]) * dtl[t * 8 + hh];
                  float o[8];
#pragma unroll
                  for (int q = 0; q < 8; ++q) o[q] = silu(cb[q] + wgt[0][q] * x3[q] + wgt[1][q] * x2[q] + wgt[2][q] * x1[q] + wgt[3][q] * x0[q]) * sc;
                  v4u pk; pk.x = pk2(o[0], o[1]); pk.y = pk2(o[2], o[3]); pk.z = pk2(o[4], o[5]); pk.w = pk2(o[6], o[7]);
                  *(LAS v4u*)(dst + t * pitch) = pk;
              }
#pragma unroll
              for (int q = 0; q < 8; ++q) { x3[q] = x2[q]; x2[q] = x1[q]; x1[q] = x0[q]; }
          }
      } }
    __syncthreads();
    if (!fin) {
        const int h = w, g = h >> 2;
#pragma unroll 1
        for (int sh = 0; sh < 2; ++sh) {
            f32x4 acc[4][4];
#pragma unroll
            for (int st = 0; st < 4; ++st)
#pragma unroll
                for (int pt = 0; pt < 4; ++pt) acc[st][pt] = (f32x4){0.f, 0.f, 0.f, 0.f};
#pragma unroll
            for (int ks = 0; ks < 2; ++ks) {
                bf16x8 xf[4], yf[4];
#pragma unroll
                for (int st = 0; st < 4; ++st) xf[st] = tr_frag(BM + (32 * ks + 8 * lq + (l15 >> 2)) * BMP + g * 128 + 64 * sh + 16 * st + 4 * (l15 & 3), BMP);
#pragma unroll
                for (int pt = 0; pt < 4; ++pt) yf[pt] = tr_frag(XS + (32 * ks + 8 * lq + (l15 >> 2)) * XSP + h * 64 + 16 * pt + 4 * (l15 & 3), XSP);
#pragma unroll
                for (int st = 0; st < 4; ++st)
#pragma unroll
                    for (int pt = 0; pt < 4; ++pt) acc[st][pt] = mfma32(xf[st], yf[pt], acc[st][pt]);
            }
#pragma unroll
            for (int st = 0; st < 4; ++st)
#pragma unroll
                for (int pt = 0; pt < 4; ++pt) { v2u o; o.x = pk2(acc[st][pt][0], acc[st][pt][1]); o.y = pk2(acc[st][pt][2], acc[st][pt][3]);
                    *(GAS v2u*)(STT + ((size_t)h * 64 + 16 * pt + l15) * 128 + 64 * sh + 16 * st + 4 * lq) = o; }
        }
        if (lane == 0) ((float*)(a.ws + WS_SDEC))[(size_t)c * 8 + h] = fexp(acl[63 * 8 + h]);
    } else {
        const int gC = w >> 2, itC = w & 3; f32x4 cbt[4];
#pragma unroll
        for (int jt = 0; jt < 4; ++jt) cbt[jt] = (f32x4){0.f, 0.f, 0.f, 0.f};
#pragma unroll
        for (int ks = 0; ks < 4; ++ks) {
            const bf16x8 yf = *(const LAS bf16x8*)(CM + (16 * itC + l15) * BMP + gC * 128 + 32 * ks + 8 * lq);
#pragma unroll
            for (int jt = 0; jt < 4; ++jt) { const bf16x8 xf = *(const LAS bf16x8*)(BM + (16 * jt + l15) * BMP + gC * 128 + 32 * ks + 8 * lq); cbt[jt] = mfma32(xf, yf, cbt[jt]); }
        }
        __syncthreads();
        f32x4 yv[2][4][2];
#pragma unroll 1
        for (int rd = 0; rd < 2; ++rd) {
            bf16x8 pfr[4][4]; v2u zvr[2][4];
            { const int ms_ = w >> 1, half_ = w & 1, g_ = ms_ >> 1, h_ = g_ * 4 + 2 * rd + (ms_ & 1);
#pragma unroll
              for (int ks = 0; ks < 4; ++ks)
#pragma unroll
                  for (int pt = 0; pt < 4; ++pt) pfr[ks][pt] = *(const GAS bf16x8*)(STT + ((size_t)h_ * 64 + 16 * pt + l15) * 128 + 32 * ks + 8 * lq);
#pragma unroll
              for (int i2 = 0; i2 < 2; ++i2)
#pragma unroll
                  for (int pt = 0; pt < 4; ++pt) zvr[i2][pt] = *(const GAS v2u*)(PR + (size_t)(t0 + 16 * (2 * half_ + i2) + l15) * PJ + D_Z + h_ * 64 + 16 * pt + 4 * lq);
              PIN_MEM(); }
            { const int i = 16 * itC + l15;
#pragma unroll
              for (int hh = 0; hh < 2; ++hh) { const int h = gC * 4 + 2 * rd + hh; const float ai = acl[i * 8 + h];
#pragma unroll
                  for (int jt = 0; jt < 4; ++jt) { float mv[4];
#pragma unroll
                      for (int r = 0; r < 4; ++r) { const int j = 16 * jt + 4 * lq + r; mv[r] = (j <= i) ? cbt[jt][r] * fexp(ai - acl[j * 8 + h]) * dtl[j * 8 + h] : 0.f; }
                      v2u o; o.x = pk2(mv[0], mv[1]); o.y = pk2(mv[2], mv[3]); *(LAS v2u*)(MM + ((gC * 2 + hh) * 64 + i) * MP + 16 * jt + 4 * lq) = o; } } }
            __syncthreads();
            { const int ms = w >> 1, half = w & 1, g = ms >> 1, h = g * 4 + 2 * rd + (ms & 1);
              f32x4 a1[4][2], a2[4][2];
#pragma unroll
              for (int pt = 0; pt < 4; ++pt)
#pragma unroll
                  for (int i2 = 0; i2 < 2; ++i2) { a1[pt][i2] = (f32x4){0.f, 0.f, 0.f, 0.f}; a2[pt][i2] = (f32x4){0.f, 0.f, 0.f, 0.f}; }
#pragma unroll
              for (int ks = 0; ks < 2; ++ks) { if (ks <= half) {
                  bf16x8 xf[4];
#pragma unroll
                  for (int pt = 0; pt < 4; ++pt) xf[pt] = tr_frag(XS + (32 * ks + 8 * lq + (l15 >> 2)) * XSP + h * 64 + 16 * pt + 4 * (l15 & 3), XSP);
#pragma unroll
                  for (int i2 = 0; i2 < 2; ++i2) { const bf16x8 yf = *(const LAS bf16x8*)(MM + (ms * 64 + 16 * (2 * half + i2) + l15) * MP + 32 * ks + 8 * lq);
#pragma unroll
                      for (int pt = 0; pt < 4; ++pt) a1[pt][i2] = mfma32(xf[pt], yf, a1[pt][i2]); } } }
#pragma unroll
              for (int ks = 0; ks < 4; ++ks) {
#pragma unroll
                  for (int i2 = 0; i2 < 2; ++i2) { const bf16x8 yf = *(const LAS bf16x8*)(CM + (16 * (2 * half + i2) + l15) * BMP + g * 128 + 32 * ks + 8 * lq);
#pragma unroll
                      for (int pt = 0; pt < 4; ++pt) a2[pt][i2] = mfma32(pfr[ks][pt], yf, a2[pt][i2]); } }
              const float Dh = a.in[I_DD][l * 8 + h];
#pragma unroll
              for (int i2 = 0; i2 < 2; ++i2) { const int i = 16 * (2 * half + i2) + l15; const float ea = fexp(acl[i * 8 + h]); float s2 = 0.f;
#pragma unroll
                  for (int pt = 0; pt < 4; ++pt) { const int ch = h * 64 + 16 * pt + 4 * lq;
                      const v2u xv = *(const LAS v2u*)(XS + i * XSP + ch); const v2u zv = zvr[i2][pt];
                      f32x4 y; y[0] = (a1[pt][i2][0] + ea * a2[pt][i2][0] + Dh * bflo(xv.x)) * silu(bflo(zv.x)); y[1] = (a1[pt][i2][1] + ea * a2[pt][i2][1] + Dh * bfhi(xv.x)) * silu(bfhi(zv.x));
                      y[2] = (a1[pt][i2][2] + ea * a2[pt][i2][2] + Dh * bflo(xv.y)) * silu(bflo(zv.y)); y[3] = (a1[pt][i2][3] + ea * a2[pt][i2][3] + Dh * bfhi(xv.y)) * silu(bfhi(zv.y));
                      if (rd == 0) yv[0][pt][i2] = y; else yv[1][pt][i2] = y;
                      s2 += (y[0] * y[0] + y[1] * y[1]) + (y[2] * y[2] + y[3] * y[3]); }
                  s2 += __shfl_xor(s2, 16); s2 += __shfl_xor(s2, 32);
                  if (lq == 0) ssq[i * 8 + h] = s2; } }
            __syncthreads();
        }
        { const int ms = w >> 1, half = w & 1, g = ms >> 1;
#pragma unroll
          for (int rd = 0; rd < 2; ++rd) { const int h = g * 4 + 2 * rd + (ms & 1);
#pragma unroll
              for (int i2 = 0; i2 < 2; ++i2) { const int i = 16 * (2 * half + i2) + l15; const LAS float* sq = ssq + i * 8;
                  const float rstd = frsq((((sq[0] + sq[1]) + (sq[2] + sq[3])) + ((sq[4] + sq[5]) + (sq[6] + sq[7]))) * (1.0f / 512.0f) + EPS);
#pragma unroll
                  for (int pt = 0; pt < 4; ++pt) { const int ch = h * 64 + 16 * pt + 4 * lq; const f32x4 nw = *(const GAS f32x4*)(a.in[I_DNW] + l * 512 + ch); const f32x4 y = yv[rd][pt][i2];
                      v2u o; o.x = pk2(y[0] * rstd * nw[0], y[1] * rstd * nw[1]); o.y = pk2(y[2] * rstd * nw[2], y[3] * rstd * nw[3]);
                      if (dry) asm volatile("" :: "v"(o.x), "v"(o.y)); else *(GAS v2u*)(PR + (size_t)(t0 + i) * PJ + D_Z + ch) = o; } } } }
    }
    __syncthreads();
}

__device__ __forceinline__ void scan_phase(const Args& a, int l, int vcu, int G, LAS unsigned char* lds) {
    const int tid = opaque_tid();
    LAS float* dl = (LAS float*)lds;
    for (int j = vcu; j < 202; j += G) {
        if (j < 192) {
            const bool isS = j < 128; const int jj = isS ? j : j - 128;
            const int b = isS ? (jj >> 6) : (jj >> 5), r0 = (isS ? (jj & 63) : (jj & 31)) * 1024, h = r0 >> 13, r = r0 + 2 * tid;
            if (isS) { if (tid < CPB) dl[tid] = ((const float*)(a.ws + WS_SDEC))[(size_t)(b * CPB + tid) * 8 + h]; }
            else { for (int i = tid; i < CPB * 64; i += NTHR) dl[i] = ((const float*)(a.ws + WS_GDEC))[(size_t)(b * CPB + (i >> 6)) * 256 + h * 64 + (i & 63)]; }
            const int cstride = isS ? 131072 : 65536;
            const __amdgpu_buffer_rsrc_t rs = __builtin_amdgcn_make_buffer_rsrc((void*)(a.ws + (isS ? WS_SSD : WS_GLA) + (size_t)b * CPB * cstride), (short)0, CPB * cstride, 0x00020000);
            __syncthreads();
            float s0 = 0.f, s1 = 0.f; const int d = r & 63;
#pragma unroll 1
            for (int n0 = 0; n0 < CPB; n0 += 64) { unsigned kv[64];
#pragma unroll
                for (int q = 0; q < 64; ++q) kv[q] = __builtin_amdgcn_raw_buffer_load_b32(rs, r * 2, (n0 + q) * cstride, 0);
                asm volatile("s_waitcnt vmcnt(0)" ::: "memory");
#pragma unroll
                for (int q = 0; q < 64; ++q) { float d0, d1; if (isS) { d0 = dl[n0 + q]; d1 = d0; } else { const f32x2 dd = *(const LAS f32x2*)(dl + (n0 + q) * 64 + d); d0 = dd.x; d1 = dd.y; }
                    __builtin_amdgcn_raw_buffer_store_b32(pk2(s0, s1), rs, r * 2, (n0 + q) * cstride, 0); s0 = d0 * s0 + bflo(kv[q]); s1 = d1 * s1 + bfhi(kv[q]);
                    if ((q & 15) == 15) PIN_MEM(); } }
            __syncthreads();
        } else if (j < 200) {
            const int e2 = (j - 192) * NTHR + tid, b = e2 >> 11, gn = e2 & 2047;
            const float* A64 = (const float*)(a.ws + WS_S5T + (size_t)l * S5T_LAYER + S5T_A64); const float ar = A64[gn * 2], ai = A64[gn * 2 + 1];
            f32x2* p = (f32x2*)(a.ws + WS_S5ST) + (size_t)b * CPB * 2048 + gn; float sr = 0.f, si = 0.f;
#pragma unroll 1
            for (int n0 = 0; n0 < CPB; n0 += 32) { f32x2 ev[32];
#pragma unroll
                for (int q = 0; q < 32; ++q) ev[q] = p[(size_t)(n0 + q) * 2048];
                asm volatile("s_waitcnt vmcnt(0)" ::: "memory");
#pragma unroll
                for (int q = 0; q < 32; ++q) { const f32x2 o = {sr, si}; p[(size_t)(n0 + q) * 2048] = o; const float nr = ar * sr - ai * si + ev[q].x, ni = ar * si + ai * sr + ev[q].y; sr = nr; si = ni; } }
        } else {
            const int e2 = (j - 200) * NTHR + tid, b = e2 >> 9, ch = e2 & 511;
            const f32x2* E = (const f32x2*)(a.ws + WS_LRUE) + (size_t)b * CPB * 512 + ch; float* H = (float*)(a.ws + WS_LRUH) + (size_t)b * CPB * 512 + ch; float hs = 0.f;
#pragma unroll 1
            for (int n0 = 0; n0 < CPB; n0 += 32) { f32x2 ev[32];
#pragma unroll
                for (int q = 0; q < 32; ++q) ev[q] = E[(size_t)(n0 + q) * 512];
#pragma unroll
                for (int q = 0; q < 32; ++q) { H[(size_t)(n0 + q) * 512] = hs; hs = ev[q].x * hs + ev[q].y; } }
        }
    }
}

__device__ __forceinline__ void final_norm(const Args& a, int vcu, int G) {
    const int tid = opaque_tid(), lane = tid & 63, wave = tid >> 6; const int gw = vcu * NWAVES + wave, NGW = G * NWAVES;
    const float* rowss = (const float*)(a.ws + WS_PART) + (size_t)DEPTH * T * 16;
    for (int m = gw; m < T; m += NGW) {
        float rsum = 0.f;
#pragma unroll
        for (int q = 0; q < 16; ++q) rsum += rowss[(size_t)m * 16 + q];
        const float rstd = 1.0f / sqrtf(rsum * (1.0f / 1024.0f) + EPS);
        const GAS v2u* xr = (const GAS v2u*)((const bf16*)(a.ws + WS_XBF) + (size_t)m * DM) + lane; GAS f32x4* orow = (GAS f32x4*)(a.out + (size_t)m * DM) + lane; const GAS f32x4* wr = (const GAS f32x4*)(a.in[I_NFW]) + lane;
        v2u xv[4];
#pragma unroll
        for (int j = 0; j < 4; ++j) xv[j] = xr[64 * j];
#pragma unroll
        for (int j = 0; j < 4; ++j) { const f32x4 w = wr[64 * j]; f32x4 v = (f32x4){bflo(xv[j].x), bfhi(xv[j].x), bflo(xv[j].y), bfhi(xv[j].y)}; v = v * rstd * w; orow[64 * j] = v; }
    }
}

#define XB_TMO      128
#define XB_XCNT(j)  (256  + 64 * (j))
#define XB_XSUB(j)  (1280 + 64 * (j))
#define XB_XGEN(j)  (2304 + 64 * (j))
#define XB_TOP      3328
#define XB_TOPGEN   3392
#define XCD_BAR_WORDS 3456
#define XB_SPIN_CAP (1u << 22)
__device__ __forceinline__ unsigned xb_ld(unsigned* p)              { return __hip_atomic_load(p, __ATOMIC_RELAXED, __HIP_MEMORY_SCOPE_AGENT); }
__device__ __forceinline__ unsigned xb_add(unsigned* p, unsigned v) { return __hip_atomic_fetch_add(p, v, __ATOMIC_RELAXED, __HIP_MEMORY_SCOPE_AGENT); }
__device__ __forceinline__ unsigned xb_xcc_id() { return (unsigned)__builtin_amdgcn_s_getreg((3 << 11) | 20) & 0xFu; }
#define XB_SPIN(cond, bar) do { unsigned _sp = 0; while (cond) { __builtin_amdgcn_s_sleep(1); \
    if ((++_sp & 255u) == 0u) { if (xb_ld(&(bar)[XB_TMO])) break; if (_sp > XB_SPIN_CAP) { atomicAdd(&(bar)[XB_TMO], 1u); break; } } } } while (0)
struct XcdBarrier { unsigned* bar; unsigned x; volatile LAS unsigned* st; };
__device__ __forceinline__ XcdBarrier xcd_barrier_post(unsigned* bar, volatile LAS unsigned* st) {
    XcdBarrier b; b.bar = bar; b.x = xb_xcc_id(); b.st = st;
    if (threadIdx.x == 0) (void)xb_add(&bar[XB_XCNT(b.x)], 1u);
    return b;
}
__device__ __forceinline__ void xcd_barrier_complete(unsigned* bar, unsigned x, unsigned& nloc, unsigned& nx) {
    const unsigned G = gridDim.x * gridDim.y * gridDim.z;
    unsigned sum, cnt, mine, sp = 0u;
    for (;;) {
        sum = 0u; cnt = 0u; mine = 0u;
#pragma unroll
        for (unsigned j = 0; j < 16; ++j) { const unsigned c = xb_ld(&bar[XB_XCNT(j)]); sum += c; cnt += (c > 0u) ? 1u : 0u; mine = (j == x) ? c : mine; }
        if (sum == G) break;
        __builtin_amdgcn_s_sleep(1);
        if ((++sp & 255u) == 0u) { if (xb_ld(&bar[XB_TMO])) break; if (sp > XB_SPIN_CAP) { atomicAdd(&bar[XB_TMO], 1u); break; } }
    }
    nloc = mine > 0u ? mine : 1u; nx = cnt > 0u ? cnt : 1u;
}
__device__ __forceinline__ void xcd_barrier(const XcdBarrier& b) {
    asm volatile("s_waitcnt vmcnt(0)" ::: "memory");
    __syncthreads();
    if (threadIdx.x == 0) {
        unsigned* bar = b.bar;
        __builtin_amdgcn_s_waitcnt(0);
        unsigned nloc = b.st[0], nx = b.st[1];
        if (nloc == 0u) { xcd_barrier_complete(bar, b.x, nloc, nx); b.st[0] = nloc; b.st[1] = nx; }
        const unsigned old = xb_add(&bar[XB_XSUB(b.x)], 1u);
        const unsigned gen = old / nloc;
        if (old + 1u == (gen + 1u) * nloc) {
            __builtin_amdgcn_fence(__ATOMIC_RELEASE, "agent");
            asm volatile("s_waitcnt vmcnt(0)" ::: "memory");
            const unsigned og = xb_add(&bar[XB_TOP], 1u);
            const unsigned tg = og / nx;
            if (og + 1u == (tg + 1u) * nx) xb_add(&bar[XB_TOPGEN], 1u);
            else XB_SPIN(xb_ld(&bar[XB_TOPGEN]) == tg, bar);
            __builtin_amdgcn_fence(__ATOMIC_ACQUIRE, "agent");
            xb_add(&bar[XB_XGEN(b.x)], 1u);
            asm volatile("s_waitcnt vmcnt(0)" ::: "memory");
        } else {
            XB_SPIN(xb_ld(&bar[XB_XGEN(b.x)]) == gen, bar);
            __builtin_amdgcn_fence(__ATOMIC_ACQUIRE, "agent");
            asm volatile("s_waitcnt vmcnt(0)" ::: "memory");
        }
    }
    __syncthreads();
}

constexpr int N_PHASES = 2 + 5 * DEPTH;
__global__ void __launch_bounds__(NTHR, 2) mega_fwd(Args args) {
    extern __shared__ __attribute__((aligned(16))) unsigned char lds_raw[];
    LAS unsigned char* lds = (LAS unsigned char*)lds_raw;
    const int G = gridDim.x, bx = blockIdx.x; const int vcu = (G % 8 == 0) ? (bx % 8) * (G / 8) + bx / 8 : bx;
    const int lo = args.ph_lo, hi = args.ph_hi;
    float* rowss = (float*)(args.ws + WS_PART);
    volatile LAS unsigned* bst = (volatile LAS unsigned*)(lds + LDS_BYTES - 64);
    if (threadIdx.x < 2) bst[threadIdx.x] = 0u;
    __syncthreads();
    XcdBarrier xbar = xcd_barrier_post((unsigned*)(args.ws + WS_CTL), bst);
    constexpr int N_EXTRA = PROBE_DUP == 0 ? 0 : (PROBE_DUP == 3 ? 4 : 1);
    for (int sq = lo; sq < hi + N_EXTRA; ++sq) {
        int ph = sq;
        if (PROBE_DUP == 1) ph = sq <= 1 ? sq : sq - 1;
        if (PROBE_DUP == 2) ph = sq <= 2 ? sq : sq - 1;
        if (PROBE_DUP == 3) ph = sq <= 4 ? sq : sq - 4;
        if (PROBE_DUP == 4) ph = sq <= 5 ? sq : sq - 1;
        if (PROBE_DUP == 5) ph = sq <= 0 ? sq : sq - 1;
        if (PROBE_DUP == 6) ph = sq <= N_PHASES - 1 ? sq : sq - 1;
        if (ph == 0) { if (DBG_MASK & 1) p0_prologue(args, lds, vcu, G); }
        else if (ph == N_PHASES - 1) { if (DBG_MASK & 256) final_norm(args, vcu, G); }
        else {
            const int l = (ph - 1) / 5, sub = (ph - 1) % 5;
            if (sub == 0) { if (DBG_MASK & 2) {
                pg8::Gemm g{(const bf16*)args.out, (const bf16*)(args.ws + WS_WIN) + (size_t)l * NPAD * DM, T, PJ, DM, DM, 512};
                pg8::StaticOrder S; S.init(T, PJ, G, bx);
                LAS float* rsl = (LAS float*)(lds + 131072); int pm0 = -1;
                { pg8::Unit u0; if (S.next(0, u0)) { pm0 = u0.pm; const int t_ = opaque_tid(), r_ = t_ >> 1, h_ = t_ & 1;
                    const f32x4* pp = (const f32x4*)(rowss + (size_t)l * T * 16 + (size_t)(pm0 * 256 + r_) * 16 + h_ * 8); const f32x4 p0 = pp[0], p1 = pp[1];
                    float sm = ((p0[0] + p0[1]) + (p0[2] + p0[3])) + ((p1[0] + p1[1]) + (p1[2] + p1[3])); sm += __shfl_xor(sm, 1);
                    if (h_ == 0) rsl[r_] = 1.0f / sqrtf(sm * (1.0f / 1024.0f) + 1e-6f); }
                  __syncthreads(); }
                pg8::EpiProj E{(bf16*)(args.ws + WS_PROJ), (float*)(args.ws + WS_EX), rowss + (size_t)l * T * 16, PJ, rsl, pm0};
                pg8::gemm_phase<pg8::EpiProj, pg8::StaticOrder, true, true>(lds, g, S, E);
                for (int c = vcu; c < NCHUNK; c += G) ex_chunk(args, l, c); }
            } else if (sub == 1 || sub == 3) {
                const bool fin = (sub == 3);
                for (int c = vcu; c < NCHUNK; c += G) {
                    if (PROBE_MIX == 1 && !fin) lru_chunk(args, l, c, false, lds); if (PROBE_MIX == 9 && !fin) lru_chunk(args, l, c, false, lds, false, true); if (PROBE_MIX == 5 && fin) lru_chunk(args, l, c, true, lds, true);
                    if (fin) lru_out(args, l, c); else lru_chunk(args, l, c, false, lds);
                    if (PROBE_MIX == 2 && !fin) s5_chunk(args, l, c, false, lds); if (PROBE_MIX == 6 && fin) s5_chunk(args, l, c, true, lds, true);
                    s5_chunk(args, l, c, fin, lds);
                    if (PROBE_MIX == 3 && !fin) gla_chunk(args, l, c, false, lds); if (PROBE_MIX == 7 && fin) gla_chunk(args, l, c, true, lds, true);
                    gla_chunk(args, l, c, fin, lds);
                    if (PROBE_MIX == 4 && !fin) ssd_chunk(args, l, c, false, lds); if (PROBE_MIX == 8 && fin) ssd_chunk(args, l, c, true, lds, true);
                    ssd_chunk(args, l, c, fin, lds); }
            } else if (sub == 2) { if (DBG_MASK & 64) scan_phase(args, l, vcu, G, lds); }
            else if (DBG_MASK & 128) {
                pg8::Gemm g{(const bf16*)(args.ws + WS_PROJ), (const bf16*)(args.ws + WS_WOUT) + (size_t)l * DM * 2048, T, DM, 2048, PJ, 1280};
                pg8::StaticOrder S; S.init(T, DM, G, bx);
                pg8::EpiOut E{l == 0 ? args.in[I_X] : nullptr, (const bf16*)args.out, l == DEPTH - 1 ? (bf16*)(args.ws + WS_XBF) : (bf16*)args.out, rowss + (size_t)(l + 1) * T * 16};
                pg8::gemm_phase<pg8::EpiOut, pg8::StaticOrder, true, true>(lds, g, S, E);
            }
        }
        if (sq + 1 < hi + N_EXTRA) { xcd_barrier(xbar); }
    }
}

extern "C" void kernel_launch(void* const* d_in, const int* in_sizes, int n_in, void* d_out, int out_size, void* d_ws, size_t ws_size, hipStream_t stream) {
    static int grid = 0;
    if (grid == 0) {
        if (n_in != 31 || out_size != T * DM || ws_size < WS_END) { fprintf(stderr, "kernel_launch: unexpected shapes (n_in %d out %d ws %zu need %zu)\n", n_in, out_size, ws_size, (size_t)WS_END); grid = -1; return; }
        int dev = 0, cus = 0, per_cu = 0;
        if (hipGetDevice(&dev) != hipSuccess || hipDeviceGetAttribute(&cus, hipDeviceAttributeMultiprocessorCount, dev) != hipSuccess) { grid = -1; return; }
        if (hipFuncSetAttribute((const void*)mega_fwd, hipFuncAttributeMaxDynamicSharedMemorySize, LDS_BYTES) != hipSuccess) { fprintf(stderr, "kernel_launch: hipFuncSetAttribute failed\n"); grid = -1; return; }
        if (hipOccupancyMaxActiveBlocksPerMultiprocessor(&per_cu, (const void*)mega_fwd, NTHR, LDS_BYTES) != hipSuccess || per_cu < 1) { fprintf(stderr, "kernel_launch: occupancy query says %d blocks/CU\n", per_cu); (void)hipGetLastError(); per_cu = 1; }
        grid = cus;
        fprintf(stderr, "kernel_launch: grid %d (per_cu %d)\n", grid, per_cu);
    }
    if (grid < 0) return;
    (void)hipMemsetAsync((char*)d_ws + WS_CTL, 0, CTL_ZERO_BYTES, stream);
    Args a{};
    for (int i = 0; i < 31; ++i) a.in[i] = (const float*)d_in[i];
    a.out = (float*)d_out; a.ws = (unsigned char*)d_ws;
#if MK_PER_PHASE
    for (int ph = 0; ph < N_PHASES; ++ph) { a.ph_lo = ph; a.ph_hi = ph + 1; hipLaunchKernelGGL(mega_fwd, dim3(grid), dim3(NTHR), LDS_BYTES, stream, a); }
#else
    a.ph_lo = 0; a.ph_hi = N_PHASES;
    void* kargs[] = {&a};
    hipError_t e = hipLaunchCooperativeKernel((const void*)mega_fwd, dim3(grid), dim3(NTHR), kargs, LDS_BYTES, stream);
    if (e != hipSuccess) fprintf(stderr, "kernel_launch: cooperative launch failed: %s\n", hipGetErrorString(e));
#endif
}
```
